# Optimizing an MI355X kernel written in HIP

```python
import math
import jax, jax.numpy as jnp
from jax import lax
import numpy as np

D_MODEL = 1024
BATCH = 8
SEQ = 8192
DEPTH = 1

CHUNK = 64
Q_BLOCK = 128
SB_HEADS = 8
SB_HEAD_DIM = 64
SB_WIDTH = SB_HEADS * SB_HEAD_DIM
DA_HEADS = 4
DA_HEAD_DIM = 64
DA_V_DIM = 2 * DA_HEAD_DIM
DA_QK_WIDTH = DA_HEADS * 2 * DA_HEAD_DIM
DA_V_WIDTH = DA_HEADS * DA_V_DIM
D_FF = 2816
N_SUB = 3
EPS = 1e-6
NEG = -1e30
IN_SIZES = (SB_WIDTH, SB_WIDTH, SB_WIDTH, DA_QK_WIDTH, DA_QK_WIDTH, DA_V_WIDTH, D_MODEL, D_MODEL)
IN_WIDTH = sum(IN_SIZES)
IN_SPLITS = tuple(int(v) for v in np.cumsum(IN_SIZES)[:-1])

kernel_name = "hybrid_stickbreak_diffattn_macaron_block"


def rms_norm(x, g):
    x32 = x.astype(jnp.float32)
    y = x32 * lax.rsqrt(jnp.mean(x32 * x32, axis=-1, keepdims=True) + EPS)
    return (y * g.astype(jnp.float32)).astype(x.dtype)


def swiglu(u, w_gate, w_up, w_down):
    return (jax.nn.silu(u @ w_gate) * (u @ w_up)) @ w_down


def to_blocks(t):
    b, h, s, d = t.shape
    return t.reshape(b, h, s // Q_BLOCK, Q_BLOCK, d).transpose(2, 0, 1, 3, 4)


def from_blocks(t):
    nb, b, h, qb, d = t.shape
    return t.transpose(1, 2, 0, 3, 4).reshape(b, h, nb * qb, d)


def stick_breaking_attention(q, k, v):
    s_len = q.shape[2]
    scale = 1.0 / math.sqrt(q.shape[-1])
    spos = jnp.arange(s_len)
    tpos = spos.reshape(s_len // Q_BLOCK, Q_BLOCK)

    def block(args):
        qi, ti = args
        z = jnp.einsum('bhqd,bhkd->bhqk', qi, k).astype(jnp.float32) * scale
        before = spos[None, :] < ti[:, None]
        log_fail = jnp.where(before, jax.nn.log_sigmoid(-z), 0.0)
        later = lax.cumsum(log_fail, axis=3, reverse=True) - log_fail
        w = jnp.where(before, jnp.exp(jax.nn.log_sigmoid(z) + later), 0.0)
        return jnp.einsum('bhqk,bhkd->bhqd', w.astype(v.dtype), v)

    return from_blocks(lax.map(block, (to_blocks(q), tpos)))


def differential_attention(q1, q2, k1, k2, v, lam):
    s_len = q1.shape[2]
    n_heads = q1.shape[1]
    scale = 1.0 / math.sqrt(q1.shape[-1])
    slopes = jnp.asarray(2.0 ** (-8.0 * (np.arange(n_heads) + 1) / n_heads), dtype=jnp.float32)
    spos = jnp.arange(s_len)
    tpos = spos.reshape(s_len // Q_BLOCK, Q_BLOCK)

    def block(args):
        qi1, qi2, ti = args
        allowed = (spos[None, :] // CHUNK) <= (ti[:, None] // CHUNK)
        dist = jnp.abs(ti[:, None] - spos[None, :]).astype(jnp.float32)
        bias = -slopes[:, None, None] * dist
        s1 = jnp.einsum('bhqd,bhkd->bhqk', qi1, k1).astype(jnp.float32) * scale + bias
        s2 = jnp.einsum('bhqd,bhkd->bhqk', qi2, k2).astype(jnp.float32) * scale + bias
        p = (jax.nn.softmax(jnp.where(allowed, s1, NEG), axis=-1)
             - lam * jax.nn.softmax(jnp.where(allowed, s2, NEG), axis=-1))
        return jnp.einsum('bhqk,bhkd->bhqd', p.astype(v.dtype), v)

    return from_blocks(lax.map(block, (to_blocks(q1), to_blocks(q2), tpos)))


def token_mixer(u, w_in, lq1, lk1, lq2, lk2, subln, w_branch_sb, w_branch_da, w_out, lambda_init):
    b, s, _ = u.shape
    proj = u @ w_in
    qa, ka, va, qd, kd, vd, ga, gd = jnp.split(proj, IN_SPLITS, axis=-1)

    def heads(t, h):
        return t.reshape(b, s, h, -1).transpose(0, 2, 1, 3)

    ya = stick_breaking_attention(heads(qa, SB_HEADS), heads(ka, SB_HEADS), heads(va, SB_HEADS))
    ya = ya.transpose(0, 2, 1, 3).reshape(b, s, SB_WIDTH)

    qd = qd.reshape(b, s, DA_HEADS, 2, DA_HEAD_DIM).transpose(0, 2, 3, 1, 4)
    kd = kd.reshape(b, s, DA_HEADS, 2, DA_HEAD_DIM).transpose(0, 2, 3, 1, 4)
    f32 = jnp.float32
    lam = (jnp.exp(jnp.sum(lq1.astype(f32) * lk1.astype(f32)))
           - jnp.exp(jnp.sum(lq2.astype(f32) * lk2.astype(f32))) + lambda_init)
    yd = differential_attention(qd[:, :, 0], qd[:, :, 1], kd[:, :, 0], kd[:, :, 1],
                                heads(vd, DA_HEADS), lam)
    yd = rms_norm(yd, subln) * (1.0 - lambda_init)
    yd = yd.transpose(0, 2, 1, 3).reshape(b, s, DA_V_WIDTH)

    merged = jax.nn.sigmoid(ga) * (ya @ w_branch_sb) + jax.nn.sigmoid(gd) * (yd @ w_branch_da)
    return merged @ w_out


def setup_inputs(seed: int = 0) -> dict:
    key = jax.random.key(seed)
    ks = jax.random.split(key, 24)
    f32 = jnp.float32

    def dense(k, shape, fan_in):
        return jax.random.normal(k, shape, f32) * fan_in ** -0.5

    L, D, F = DEPTH, D_MODEL, D_FF
    return {
        "x": jax.random.normal(ks[0], (BATCH, SEQ, D), f32),
        "c": jax.random.normal(ks[1], (BATCH, D), f32),
        "w_ada": dense(ks[2], (L, D, N_SUB * 3 * D), D),
        "b_ada": 0.01 * jax.random.normal(ks[3], (L, N_SUB * 3 * D), f32),
        "norm_pre": 1.0 + 0.05 * jax.random.normal(ks[4], (L, N_SUB, D), f32),
        "norm_post": 1.0 + 0.05 * jax.random.normal(ks[5], (L, N_SUB, D), f32),
        "ffn1_w_gate": dense(ks[6], (L, D, F), D),
        "ffn1_w_up": dense(ks[7], (L, D, F), D),
        "ffn1_w_down": dense(ks[8], (L, F, D), F),
        "w_in": dense(ks[9], (L, D, IN_WIDTH), D),
        "da_lambda_q1": 0.1 * jax.random.normal(ks[10], (L, DA_HEAD_DIM), f32),
        "da_lambda_k1": 0.1 * jax.random.normal(ks[11], (L, DA_HEAD_DIM), f32),
        "da_lambda_q2": 0.1 * jax.random.normal(ks[12], (L, DA_HEAD_DIM), f32),
        "da_lambda_k2": 0.1 * jax.random.normal(ks[13], (L, DA_HEAD_DIM), f32),
        "da_subln": 1.0 + 0.05 * jax.random.normal(ks[14], (L, DA_V_DIM), f32),
        "w_branch_sb": dense(ks[15], (L, SB_WIDTH, D), SB_WIDTH),
        "w_branch_da": dense(ks[16], (L, DA_V_WIDTH, D), DA_V_WIDTH),
        "w_out": dense(ks[17], (L, D, D), D),
        "ffn2_w_gate": dense(ks[18], (L, D, F), D),
        "ffn2_w_up": dense(ks[19], (L, D, F), D),
        "ffn2_w_down": dense(ks[20], (L, F, D), F),
    }


def reference(x, c, w_ada, b_ada, norm_pre, norm_post, ffn1_w_gate, ffn1_w_up, ffn1_w_down,
              w_in, da_lambda_q1, da_lambda_k1, da_lambda_q2, da_lambda_k2, da_subln,
              w_branch_sb, w_branch_da, w_out, ffn2_w_gate, ffn2_w_up, ffn2_w_down):
    b = x.shape[0]
    h = x
    for l in range(DEPTH):
        lambda_init = 0.8 - 0.6 * math.exp(-0.3 * l)
        mod = (jax.nn.silu(c) @ w_ada[l] + b_ada[l]).reshape(b, N_SUB, 3, D_MODEL)

        def sublayer(h, i, fn, resid_w):
            shift = mod[:, i, 0, None, :]
            scale = mod[:, i, 1, None, :]
            gate = mod[:, i, 2, None, :]
            u = rms_norm(h, norm_pre[l, i]) * (1.0 + scale) + shift
            return h + resid_w * gate * rms_norm(fn(u), norm_post[l, i])

        h = sublayer(h, 0, lambda u: swiglu(u, ffn1_w_gate[l], ffn1_w_up[l], ffn1_w_down[l]), 0.5)
        h = sublayer(h, 1, lambda u: token_mixer(u, w_in[l], da_lambda_q1[l], da_lambda_k1[l],
                                                 da_lambda_q2[l], da_lambda_k2[l], da_subln[l],
                                                 w_branch_sb[l], w_branch_da[l], w_out[l],
                                                 lambda_init), 1.0)
        h = sublayer(h, 2, lambda u: swiglu(u, ffn2_w_gate[l], ffn2_w_up[l], ffn2_w_down[l]), 0.5)
    return h
```

```cpp
#include <hip/hip_runtime.h>
#include <hip/hip_cooperative_groups.h>
#include <cstdio>
#include <cstdint>
namespace cg = cooperative_groups;

#define LAS __attribute__((address_space(3)))
typedef unsigned short bf16_t;
typedef short bf16x8 __attribute__((ext_vector_type(8)));
typedef short s16x4 __attribute__((ext_vector_type(4)));
typedef float f32x4 __attribute__((ext_vector_type(4)));
typedef float f32x16 __attribute__((ext_vector_type(16)));
typedef unsigned u32x4 __attribute__((ext_vector_type(4)));
typedef unsigned u32x2 __attribute__((ext_vector_type(2)));

constexpr int DM = 1024, NB = 8, SEQ = 8192, MT = NB * SEQ, DFF = 2816, NGU = 2 * DFF, INW = 5120, NMOD = 9216;
constexpr float EPS = 1e-6f, LOG2E = 1.4426950408889634f, LN2 = 0.6931471805599453f;
constexpr float LAMBDA_INIT = 0.2f;

constexpr size_t MiB = 1u << 20;
constexpr size_t WS_MODP = 1 * MiB;
constexpr size_t WS_SS = 6 * MiB;
constexpr size_t WS_WGU1 = 10 * MiB, WS_WD1 = 21 * MiB, WS_WIN = 27 * MiB, WS_WSB = 37 * MiB, WS_WDA = 38 * MiB, WS_WOUT = 39 * MiB, WS_WGU2 = 41 * MiB, WS_WD2 = 52 * MiB;
constexpr size_t WS_U = 64 * MiB;
constexpr size_t WS_Y = 192 * MiB;
constexpr size_t WS_BIG = 320 * MiB;
constexpr size_t WS_END = 960 * MiB;

__device__ __forceinline__ unsigned cvt_pk_bf16(float lo, float hi) { unsigned r; asm volatile("v_cvt_pk_bf16_f32 %0, %1, %2" : "=v"(r) : "v"(lo), "v"(hi)); return r; }
__device__ __forceinline__ float bf_lo(unsigned u) { return __uint_as_float(u << 16); }
__device__ __forceinline__ float bf_hi(unsigned u) { return __uint_as_float(u & 0xffff0000u); }
__device__ __forceinline__ float fast_exp2(float x) { return __builtin_amdgcn_exp2f(x); }
__device__ __forceinline__ float fast_log2(float x) { return __builtin_amdgcn_logf(x); }
__device__ __forceinline__ float fast_rcp(float x) { return __builtin_amdgcn_rcpf(x); }
__device__ __forceinline__ float sigmoidf_(float x) { return fast_rcp(1.0f + fast_exp2(-x * LOG2E)); }
__device__ __forceinline__ float wave_sum(float v) {
#pragma unroll
    for (int o = 1; o < 64; o <<= 1) v += __shfl_xor(v, o);
    return v;
}

__device__ __forceinline__ void glds_s(const void* sbase, unsigned voff, unsigned lds_dst) {
    unsigned keep;
    asm volatile("s_mov_b32 %0, m0\n\ts_mov_b32 m0, %3\n\ts_nop 0\n\tglobal_load_lds_dwordx4 %1, %2\n\ts_mov_b32 m0, %0" : "=&s"(keep) : "v"(voff), "s"(sbase), "s"(lds_dst) : "memory");
}

namespace pg8 {
constexpr int BM = 256, BK = 64, HALF = 128, HTB = HALF * BK * 2, STAGE_BYTES = 8 * HTB, NXCD = 8, WGM = 8;
__host__ __device__ __forceinline__ int lds_byte(int r, int c) { const int st = (r >> 4) * 2 + (c >> 5), rr = r & 15, cc = c & 31, ob = rr * 64 + cc * 2; return st * 1024 + (ob ^ (((ob >> 9) & 1) << 5)); }
__host__ __device__ __forceinline__ void stage_rc(int b, int& R, int& C) { const int st = b / 1024, sb = b % 1024, swz = sb ^ (((sb >> 9) & 1) << 5); R = (st >> 1) * 16 + swz / 64; C = (st & 1) * 32 + (swz % 64) / 2; }
__host__ __device__ __forceinline__ int perm32(int rho) { const int n = rho >> 4, i = rho & 15; return 8 * (i >> 2) + 4 * n + (i & 3); }

struct Unit { int pm, pn; };
struct Gemm { const bf16_t* A; const bf16_t* Bt; int M, N, K, lda; };

struct StaticOrder {
    int nM, nN, nwg, G, c;
    __device__ void init(int M, int N, int G_, int c_) { nM = M / BM; nN = N / BM; nwg = nM * nN; G = G_; c = c_; }
    __device__ bool next(int i, Unit& u) const {
        const long L = (long)i * G + c; if (L >= nwg) return false;
        int wgid = (int)L; { const int q = nwg / NXCD, r = nwg % NXCD, xcd = wgid % NXCD, off = wgid / NXCD; wgid = (xcd < r ? xcd * (q + 1) : r * (q + 1) + (xcd - r) * q) + off; }
        const int nig = WGM * nN, gid = wgid / nig, fm = gid * WGM, gsz = (nM - fm) < WGM ? (nM - fm) : WGM;
        u.pm = fm + ((wgid % nig) % gsz); u.pn = (wgid % nig) / gsz; return true;
    }
};

template <class Epi>
__device__ __forceinline__ void gemm_phase(LAS unsigned char* lds, const Gemm g, const StaticOrder& S, const Epi& E) {
    int tid_ = threadIdx.x; asm volatile("" : "+v"(tid_));
    const int tid = tid_, wid = __builtin_amdgcn_readfirstlane(tid >> 6), lane = tid & 63, wr = wid >> 2, wc = wid & 3, fr = lane & 15, fq = lane >> 4;
    const int K = g.K, nt = K / BK, lda = g.lda;
    unsigned voffA[2], voffB[2];
#pragma unroll
    for (int i = 0; i < 2; ++i) { int R, C; stage_rc(tid * 16 + i * 8192, R, C); const int Rb = (R & ~31) + perm32(R & 31);
        voffA[i] = (unsigned)(R * lda + C) * 2u; voffB[i] = (unsigned)(Rb * K + C) * 2u; }
    const size_t kstep = (size_t)(BK * 2);
    const size_t hstepA = (size_t)HALF * lda * 2, hstepB = (size_t)HALF * K * 2;
    const size_t tstepA = 2 * hstepA, tstepB = 2 * hstepB;
    const unsigned ldsbase = (unsigned)(uintptr_t)lds + (unsigned)wid * 1024u;
    const int aoff = lds_byte(wr * 64 + fr, fq * 8), boff = lds_byte(wc * 32 + fr, fq * 8);
#define PG8_SA(b, h) (((b) * 2 + (h)) * HTB)
#define PG8_SB(b, h) ((4 + (b) * 2 + (h)) * HTB)
#define PG8_STAGE(bufoff, gbase, voff) do { _Pragma("unroll") for (int _i = 0; _i < 2; ++_i) \
        glds_s((const void*)(gbase), (voff)[_i], ldsbase + (unsigned)((bufoff) + _i * 8192)); } while (0)
#define PG8_LDA(dst, b, h) do { _Pragma("unroll") for (int m = 0; m < 4; ++m) _Pragma("unroll") for (int k = 0; k < 2; ++k) dst[m][k] = *(const LAS bf16x8*)(lds + PG8_SA(b, h) + aoff + m * 2048 + k * 1024); } while (0)
#define PG8_LDB(dst, b, h) do { _Pragma("unroll") for (int n = 0; n < 2; ++n) _Pragma("unroll") for (int k = 0; k < 2; ++k) dst[n][k] = *(const LAS bf16x8*)(lds + PG8_SB(b, h) + boff + n * 2048 + k * 1024); } while (0)
#define PG8_MMA(ai, bj, At, Bt) do { __builtin_amdgcn_s_setprio(1); _Pragma("unroll") for (int m = 0; m < 4; ++m) _Pragma("unroll") for (int n = 0; n < 2; ++n) _Pragma("unroll") for (int k = 0; k < 2; ++k) \
        acc[ai][bj][m][n] = __builtin_amdgcn_mfma_f32_16x16x32_bf16(Bt[n][k], At[m][k], acc[ai][bj][m][n], 0, 0, 0); __builtin_amdgcn_s_setprio(0); } while (0)
#define PG8_WAIT_V(n) asm volatile("s_waitcnt vmcnt(" #n ")" ::: "memory")
#define PG8_WAIT_L(n) asm volatile("s_waitcnt lgkmcnt(" #n ")" ::: "memory")
#define PG8_BAR __builtin_amdgcn_s_barrier()
#define PG8_SCHED __builtin_amdgcn_sched_barrier(0)
    Unit cur, nxt; int ui = 0;
    if (!S.next(0, cur)) return;
    f32x4 acc[2][2][4][2];
#pragma unroll
    for (int a = 0; a < 2; ++a)
#pragma unroll
        for (int b = 0; b < 2; ++b)
#pragma unroll
            for (int m = 0; m < 4; ++m)
#pragma unroll
                for (int n = 0; n < 2; ++n) acc[a][b][m][n] = (f32x4){0.f, 0.f, 0.f, 0.f};
    bf16x8 At[4][2], B0[2][2], B1[2][2];
    const char* cA = (const char*)g.A + (size_t)cur.pm * tstepA; const char* cB = (const char*)g.Bt + (size_t)cur.pn * tstepB;
    PG8_STAGE(PG8_SB(0, 0), cB, voffB); PG8_STAGE(PG8_SB(0, 1), cB + hstepB, voffB); PG8_STAGE(PG8_SA(0, 0), cA, voffA); PG8_STAGE(PG8_SA(0, 1), cA + hstepA, voffA);
    if (wr == 1) PG8_BAR;
    PG8_WAIT_V(2); PG8_BAR;
    PG8_STAGE(PG8_SB(1, 0), cB + kstep, voffB); PG8_STAGE(PG8_SA(1, 0), cA + kstep, voffA); PG8_STAGE(PG8_SB(1, 1), cB + hstepB + kstep, voffB);
    PG8_WAIT_V(6); PG8_BAR;
    for (;;) {
        const bool has_next = S.next(ui + 1, nxt);
        const char* nA = has_next ? (const char*)g.A + (size_t)nxt.pm * tstepA : cA; const char* nB = has_next ? (const char*)g.Bt + (size_t)nxt.pn * tstepB : cB;
        for (int t = 0; t < nt; t += 2) {
            const bool last = (t == nt - 2);
            const char* a1 = cA + (size_t)(t + 1) * kstep;
            const char* a2 = last ? nA : cA + (size_t)(t + 2) * kstep; const char* b2 = last ? nB : cB + (size_t)(t + 2) * kstep;
            const char* a3 = a2 + kstep; const char* b3 = b2 + kstep;
            PG8_LDB(B0, 0, 0); PG8_LDB(B1, 0, 1); PG8_SCHED; PG8_LDA(At, 0, 0); PG8_STAGE(PG8_SA(1, 1), a1 + hstepA, voffA);
            PG8_WAIT_V(8); PG8_WAIT_L(0); PG8_BAR; PG8_MMA(0, 0, At, B0); PG8_MMA(0, 1, At, B1); PG8_BAR; PG8_SCHED;
            PG8_LDA(At, 0, 1); PG8_STAGE(PG8_SB(0, 0), b2, voffB); PG8_STAGE(PG8_SB(0, 1), b2 + hstepB, voffB); PG8_STAGE(PG8_SA(0, 0), a2, voffA);
            PG8_WAIT_V(8); PG8_WAIT_L(0); PG8_BAR; PG8_MMA(1, 0, At, B0); PG8_MMA(1, 1, At, B1); PG8_BAR; PG8_SCHED;
            PG8_LDB(B0, 1, 0); PG8_LDB(B1, 1, 1); PG8_SCHED; PG8_LDA(At, 1, 0); PG8_STAGE(PG8_SA(0, 1), a2 + hstepA, voffA);
            PG8_WAIT_V(8); PG8_WAIT_L(0); PG8_BAR; PG8_MMA(0, 0, At, B0); PG8_MMA(0, 1, At, B1); PG8_BAR; PG8_SCHED;
            PG8_LDA(At, 1, 1); PG8_STAGE(PG8_SB(1, 0), b3, voffB); PG8_STAGE(PG8_SB(1, 1), b3 + hstepB, voffB); PG8_STAGE(PG8_SA(1, 0), a3, voffA);
            PG8_WAIT_V(8); PG8_WAIT_L(0); PG8_BAR; PG8_MMA(1, 0, At, B0); PG8_MMA(1, 1, At, B1); PG8_BAR; PG8_SCHED;
        }
        if (wr == 0) PG8_BAR;
        E(acc, cur, wr, wc, fr, fq);
        if (!has_next) break;
#pragma unroll
        for (int a = 0; a < 2; ++a)
#pragma unroll
            for (int b = 0; b < 2; ++b)
#pragma unroll
                for (int m = 0; m < 4; ++m)
#pragma unroll
                    for (int n = 0; n < 2; ++n) acc[a][b][m][n] = (f32x4){0.f, 0.f, 0.f, 0.f};
        cur = nxt; cA = nA; cB = nB; ++ui;
        if (wr == 1) PG8_BAR;
    }
    PG8_WAIT_V(0);
    PG8_BAR;
#undef PG8_SA
#undef PG8_SB
#undef PG8_STAGE
#undef PG8_LDA
#undef PG8_LDB
#undef PG8_MMA
#undef PG8_WAIT_V
#undef PG8_WAIT_L
#undef PG8_BAR
#undef PG8_SCHED
}

struct EpiSwiGLU {
    bf16_t* H;
    __device__ __forceinline__ void operator()(const f32x4 (&acc)[2][2][4][2], const Unit& u, int wr, int wc, int fr, int fq) const {
        const int row0 = u.pm * BM + wr * 64 + fr, col0 = u.pn * HALF + wc * 32 + 8 * fq;
#pragma unroll
        for (int ai = 0; ai < 2; ++ai)
#pragma unroll
            for (int m = 0; m < 4; ++m) {
                float o[8];
#pragma unroll
                for (int n = 0; n < 2; ++n)
#pragma unroll
                    for (int e = 0; e < 4; ++e) { const float gv = acc[ai][0][m][n][e], uv = acc[ai][1][m][n][e]; o[n * 4 + e] = gv * sigmoidf_(gv) * uv; }
                u32x4 w; w.x = cvt_pk_bf16(o[0], o[1]); w.y = cvt_pk_bf16(o[2], o[3]); w.z = cvt_pk_bf16(o[4], o[5]); w.w = cvt_pk_bf16(o[6], o[7]);
                *(u32x4*)(H + (size_t)(row0 + ai * HALF + m * 16) * DFF + col0) = w;
                asm volatile("" ::: "memory");
            }
    }
};
struct EpiProj {
    bf16_t* P;
    __device__ __forceinline__ void operator()(const f32x4 (&acc)[2][2][4][2], const Unit& u, int wr, int wc, int fr, int fq) const {
        const int row0 = u.pm * BM + wr * 64 + fr, col0 = u.pn * BM + wc * 32 + 8 * fq; const bool sg = (u.pn * BM >= 3072);
#pragma unroll
        for (int ai = 0; ai < 2; ++ai)
#pragma unroll
            for (int m = 0; m < 4; ++m) { bf16_t* rowp = P + (size_t)(row0 + ai * HALF + m * 16) * INW + col0;
#pragma unroll
                for (int bj = 0; bj < 2; ++bj) { f32x4 v0 = acc[ai][bj][m][0], v1 = acc[ai][bj][m][1];
                    if (sg) {
#pragma unroll
                        for (int e = 0; e < 4; ++e) { v0[e] = sigmoidf_(v0[e]); v1[e] = sigmoidf_(v1[e]); } }
                    u32x4 w; w.x = cvt_pk_bf16(v0[0], v0[1]); w.y = cvt_pk_bf16(v0[2], v0[3]); w.z = cvt_pk_bf16(v1[0], v1[1]); w.w = cvt_pk_bf16(v1[2], v1[3]);
                    *(u32x4*)(rowp + bj * HALF) = w; }
                asm volatile("" ::: "memory"); }
    }
};
struct EpiY {
    bf16_t* Y; float* SS;
    __device__ __forceinline__ void operator()(const f32x4 (&acc)[2][2][4][2], const Unit& u, int wr, int wc, int fr, int fq) const {
        const int row0 = u.pm * BM + wr * 64 + fr, col0 = u.pn * BM + wc * 32 + 8 * fq;
#pragma unroll
        for (int ai = 0; ai < 2; ++ai)
#pragma unroll
            for (int m = 0; m < 4; ++m) { const int row = row0 + ai * HALF + m * 16; bf16_t* rowp = Y + (size_t)row * DM + col0; float s = 0.f;
#pragma unroll
                for (int bj = 0; bj < 2; ++bj) { const f32x4 v0 = acc[ai][bj][m][0], v1 = acc[ai][bj][m][1];
                    s += (v0[0] * v0[0] + v0[1] * v0[1]) + (v0[2] * v0[2] + v0[3] * v0[3]) + (v1[0] * v1[0] + v1[1] * v1[1]) + (v1[2] * v1[2] + v1[3] * v1[3]);
                    u32x4 w; w.x = cvt_pk_bf16(v0[0], v0[1]); w.y = cvt_pk_bf16(v0[2], v0[3]); w.z = cvt_pk_bf16(v1[0], v1[1]); w.w = cvt_pk_bf16(v1[2], v1[3]);
                    *(u32x4*)(rowp + bj * HALF) = w; }
                s += __shfl_xor(s, 16); s += __shfl_xor(s, 32);
                if (fq == 0) SS[(size_t)row * 16 + u.pn * 4 + wc] = s;
                asm volatile("" ::: "memory"); }
    }
};
template <bool FIRST> struct EpiGate {
    bf16_t* Mg; const bf16_t* P; int gcol;
    __device__ __forceinline__ void operator()(const f32x4 (&acc)[2][2][4][2], const Unit& u, int wr, int wc, int fr, int fq) const {
        const int row0 = u.pm * BM + wr * 64 + fr, col0 = u.pn * BM + wc * 32 + 8 * fq;
#pragma unroll
        for (int ai = 0; ai < 2; ++ai)
#pragma unroll
            for (int m = 0; m < 4; ++m) { const size_t row = (size_t)(row0 + ai * HALF + m * 16);
#pragma unroll
                for (int bj = 0; bj < 2; ++bj) { const f32x4 v0 = acc[ai][bj][m][0], v1 = acc[ai][bj][m][1];
                    const u32x4 sgv = *(const u32x4*)(P + row * INW + gcol + col0 + bj * HALF);
                    float o[8];
                    o[0] = bf_lo(sgv.x) * v0[0]; o[1] = bf_hi(sgv.x) * v0[1]; o[2] = bf_lo(sgv.y) * v0[2]; o[3] = bf_hi(sgv.y) * v0[3];
                    o[4] = bf_lo(sgv.z) * v1[0]; o[5] = bf_hi(sgv.z) * v1[1]; o[6] = bf_lo(sgv.w) * v1[2]; o[7] = bf_hi(sgv.w) * v1[3];
                    bf16_t* dst = Mg + row * DM + col0 + bj * HALF;
                    if (!FIRST) { const u32x4 t = *(const u32x4*)dst;
                        o[0] += bf_lo(t.x); o[1] += bf_hi(t.x); o[2] += bf_lo(t.y); o[3] += bf_hi(t.y); o[4] += bf_lo(t.z); o[5] += bf_hi(t.z); o[6] += bf_lo(t.w); o[7] += bf_hi(t.w); }
                    u32x4 w; w.x = cvt_pk_bf16(o[0], o[1]); w.y = cvt_pk_bf16(o[2], o[3]); w.z = cvt_pk_bf16(o[4], o[5]); w.w = cvt_pk_bf16(o[6], o[7]);
                    *(u32x4*)dst = w; asm volatile("" ::: "memory"); } }
    }
};
}

namespace att {
template <int MODE> struct C {
    static constexpr int NMAP = MODE ? 2 : 1, KW = 64 * NMAP, VD = 64 * NMAP, KP = KW * 2 + 16, VP = 136, KBUF = 64 * KP, VBUF = VD * VP;
    static constexpr int OFF_K = 0, OFF_V = 2 * KBUF, OFF_Q = 2 * KBUF + 2 * VBUF, QP = KW * 2 + 16, QBUF = 32 * QP, TOTAL = OFF_Q + 8 * QBUF;
    static constexpr int NKT = (64 * (KW / 8)) / 512;
};
__device__ __forceinline__ int crow(int r, int hi) { return (r & 3) + 8 * (r >> 2) + 4 * hi; }

template <int MODE>
__device__ __forceinline__ void attn_unit(LAS unsigned char* lds, bf16_t* P, int b, int h, int qb, float lam, const float* subln, float slope) {
    typedef C<MODE> CF;
    constexpr int NMAP = CF::NMAP, KW = CF::KW, VD = CF::VD, KP = CF::KP, VP = CF::VP, QP = CF::QP, NDB = VD / 32;
    int tid_ = threadIdx.x; asm volatile("" : "+v"(tid_));
    const int tid = tid_, lane = tid & 63, q = lane & 31, hi = lane >> 5; const int w = __builtin_amdgcn_readfirstlane(tid >> 6);
    const int qcol = MODE ? 1536 + 128 * h : 64 * h, kcol = MODE ? 2048 + 128 * h : 512 + 64 * h, vcol = MODE ? 2560 + 128 * h : 1024 + 64 * h;
    const size_t rowbase = (size_t)b * SEQ;
    LAS unsigned char* Qw = lds + CF::OFF_Q + w * CF::QBUF;
    {
        constexpr int CPR = KW / 8, NQ = 32 * CPR / 64;
        u32x4 qv[NQ];
#pragma unroll
        for (int i = 0; i < NQ; ++i) { const int cid = lane + 64 * i, r = cid / CPR, ch = cid % CPR;
            qv[i] = *(const u32x4*)(P + (rowbase + qb * 256 + w * 32 + r) * INW + qcol + 8 * ch); }
#pragma unroll
        for (int i = 0; i < NQ; ++i) { const int cid = lane + 64 * i, r = cid / CPR, ch = cid % CPR;
            *(LAS u32x4*)(Qw + r * QP + 16 * ch) = qv[i]; }
    }
    u32x4 kreg[CF::NKT], vreg[2];
    const bool vact = (MODE == 1) || (tid < 256);
    const int vkp = tid & 31, vc = tid >> 5;
    unsigned koff[CF::NKT];
#pragma unroll
    for (int i_ = 0; i_ < CF::NKT; ++i_) { const int tk_ = tid + 512 * i_, key_ = tk_ / (KW / 8), ch_ = tk_ % (KW / 8); koff[i_] = (unsigned)(key_ * INW + kcol + 8 * ch_) * 2u; }
    const unsigned voff0 = (unsigned)(2 * vkp * INW + vcol + 8 * vc) * 2u;
    const char* const Pb = (const char*)(P + rowbase * INW);
#define ATT_LOAD(kt) do { const char* tb_ = Pb + (size_t)(kt) * (64 * INW * 2); \
        _Pragma("unroll") for (int i_ = 0; i_ < CF::NKT; ++i_) kreg[i_] = *(const u32x4*)(tb_ + koff[i_]); \
        if (vact) { vreg[0] = *(const u32x4*)(tb_ + voff0); vreg[1] = *(const u32x4*)(tb_ + voff0 + INW * 2); } } while (0)
#define ATT_STORE(buf) do { LAS unsigned char* kb_ = lds + CF::OFF_K + (buf) * CF::KBUF; LAS unsigned char* vb_ = lds + CF::OFF_V + (buf) * CF::VBUF; \
        _Pragma("unroll") for (int i_ = 0; i_ < CF::NKT; ++i_) { const int tk_ = tid + 512 * i_, key_ = tk_ / (KW / 8), ch_ = tk_ % (KW / 8); \
            *(LAS u32x4*)(kb_ + key_ * KP + 16 * ch_) = kreg[i_]; } \
        if (vact) { _Pragma("unroll") for (int e_ = 0; e_ < 4; ++e_) { const unsigned a_ = vreg[0][e_], b_ = vreg[1][e_]; \
            *(LAS unsigned*)(vb_ + (8 * vc + 2 * e_) * VP + 4 * vkp) = (a_ & 0xffffu) | (b_ << 16); \
            *(LAS unsigned*)(vb_ + (8 * vc + 2 * e_ + 1) * VP + 4 * vkp) = (a_ >> 16) | (b_ & 0xffff0000u); } } } while (0)

    const int nt = 4 * (qb + 1);
    ATT_LOAD(nt - 1);
    ATT_STORE(0);
    f32x16 o1[NDB], o2[NDB];
#pragma unroll
    for (int d = 0; d < NDB; ++d) { o1[d] = (f32x16){}; o2[d] = (f32x16){}; }
    float m1 = -INFINITY, m2 = -INFINITY, l1 = 0.f, l2 = 0.f, carry = 0.f;
    const int tpos = qb * 256 + w * 32 + q;
    bool wdone = false;
    __syncthreads();
    for (int it = 0; it < nt; ++it) {
        const int kt = nt - 1 - it, cur = it & 1;
        const bool active = (kt - 4 * qb) <= (w >> 1);
        if (active && !wdone) {
            LAS unsigned char* Kb = lds + CF::OFF_K + cur * CF::KBUF; LAS unsigned char* Vb = lds + CF::OFF_V + cur * CF::VBUF;
#pragma unroll
            for (int mp = 0; mp < NMAP; ++mp) {
#pragma unroll
                for (int kh = 1; kh >= 0; --kh) {
                    f32x16 s = (f32x16){};
#pragma unroll
                    for (int d0 = 0; d0 < 4; ++d0) {
                        const bf16x8 kf = *(const LAS bf16x8*)(Kb + (32 * kh + q) * KP + (64 * mp + 16 * d0 + 8 * hi) * 2);
                        const bf16x8 qf = *(const LAS bf16x8*)(Qw + q * QP + (64 * mp + 16 * d0 + 8 * hi) * 2);
                        s = __builtin_amdgcn_mfma_f32_32x32x16_bf16(kf, qf, s, 0, 0, 0); }
                    if (MODE == 1) {
                        const float c1 = 0.125f * LOG2E, c2 = slope * LOG2E; const float dbase = (float)(tpos - kt * 64 - 32 * kh - 4 * hi);
                        float mx = -INFINITY;
#pragma unroll
                        for (int r = 0; r < 16; ++r) { const float dist = fabsf(dbase - (float)crow(r, 0)); const float x = s[r] * c1 - c2 * dist; s[r] = x; mx = fmaxf(mx, x); }
                        mx = fmaxf(mx, __shfl_xor(mx, 32));
                        float& mref = mp ? m2 : m1; float& lref = mp ? l2 : l1;
                        const float mnew = fmaxf(mref, mx);
                        if (__any(mnew > mref)) { const float alpha = fast_exp2(mref - mnew); lref *= alpha;
#pragma unroll
                            for (int d = 0; d < NDB; ++d) { if (mp) o2[d] *= alpha; else o1[d] *= alpha; }
                            mref = mnew; }
                        float ps = 0.f;
#pragma unroll
                        for (int r = 0; r < 16; ++r) { const float p = fast_exp2(s[r] - mnew); s[r] = p; ps += p; }
                        lref += ps;
                    } else {
                        float sp[16];
#pragma unroll
                        for (int r = 0; r < 16; ++r) { const float z = s[r] * 0.125f; s[r] = z; const bool valid = (kt * 64 + 32 * kh + crow(r, hi)) < tpos;
                            const float a = fabsf(z); const float e = fast_exp2(-a * LOG2E); const float spv = fmaxf(z, 0.f) + fast_log2(1.0f + e) * LN2; sp[r] = valid ? spv : 0.f; }
                        float G[4], Gp[4];
#pragma unroll
                        for (int i = 0; i < 4; ++i) { G[i] = (sp[4 * i] + sp[4 * i + 1]) + (sp[4 * i + 2] + sp[4 * i + 3]); Gp[i] = __shfl_xor(G[i], 32); }
                        float after = 0.f;
#pragma unroll
                        for (int i = 3; i >= 0; --i) { float run = carry + after + (hi == 0 ? Gp[i] : 0.f);
#pragma unroll
                            for (int j = 3; j >= 0; --j) { const int r = 4 * i + j; run += sp[r]; const bool valid = (kt * 64 + 32 * kh + crow(r, hi)) < tpos;
                                const float wv = fast_exp2((s[r] - run) * LOG2E); s[r] = valid ? wv : 0.f; }
                            after += G[i] + Gp[i]; }
                        carry += after;
                    }
                    bf16x8 pk[2];
#pragma unroll
                    for (int j = 0; j < 2; ++j) { u32x4 pw; pw.x = cvt_pk_bf16(s[8 * j + 0], s[8 * j + 1]); pw.y = cvt_pk_bf16(s[8 * j + 2], s[8 * j + 3]);
                        pw.z = cvt_pk_bf16(s[8 * j + 4], s[8 * j + 5]); pw.w = cvt_pk_bf16(s[8 * j + 6], s[8 * j + 7]);
                        pk[j] = __builtin_bit_cast(bf16x8, pw); }
#pragma unroll
                    for (int d = 0; d < NDB; ++d)
#pragma unroll
                        for (int j = 0; j < 2; ++j) { const LAS unsigned char* vp = Vb + (32 * d + q) * VP + 2 * (32 * kh + 16 * j + 4 * hi);
                            const s16x4 lo = *(const LAS s16x4*)vp, hh = *(const LAS s16x4*)(vp + 16);
                            const bf16x8 vf = (bf16x8){lo[0], lo[1], lo[2], lo[3], hh[0], hh[1], hh[2], hh[3]};
                            if (mp) o2[d] = __builtin_amdgcn_mfma_f32_32x32x16_bf16(vf, pk[j], o2[d], 0, 0, 0);
                            else o1[d] = __builtin_amdgcn_mfma_f32_32x32x16_bf16(vf, pk[j], o1[d], 0, 0, 0); }
                    __builtin_amdgcn_sched_barrier(0);
                }
            }
            if (MODE == 0) wdone = __all(carry > 110.0f);
        }
        if (kt > 0) { ATT_LOAD(kt - 1); ATT_STORE(cur ^ 1); }
        if (MODE == 0) { if (__syncthreads_and(wdone ? 1 : 0)) break; } else __syncthreads();
    }
#undef ATT_LOAD
#undef ATT_STORE
    bf16_t* orow = P + (rowbase + qb * 256 + w * 32 + q) * INW + qcol;
    if (MODE == 1) {
        l1 += __shfl_xor(l1, 32); l2 += __shfl_xor(l2, 32);
        const float i1 = 1.0f / l1, i2 = lam / l2; float ss = 0.f;
#pragma unroll
        for (int d = 0; d < NDB; ++d)
#pragma unroll
            for (int r = 0; r < 16; ++r) { const float v = o1[d][r] * i1 - o2[d][r] * i2; o1[d][r] = v; ss += v * v; }
        ss += __shfl_xor(ss, 32);
        const float rs = (1.0f / sqrtf(ss * (1.0f / 128.0f) + EPS)) * (1.0f - LAMBDA_INIT);
#pragma unroll
        for (int d = 0; d < NDB; ++d)
#pragma unroll
            for (int gq = 0; gq < 4; ++gq) { const int dd = 32 * d + 8 * gq + 4 * hi; const f32x4 sl = *(const f32x4*)(subln + dd);
                u32x2 wv; wv.x = cvt_pk_bf16(o1[d][4 * gq] * rs * sl[0], o1[d][4 * gq + 1] * rs * sl[1]); wv.y = cvt_pk_bf16(o1[d][4 * gq + 2] * rs * sl[2], o1[d][4 * gq + 3] * rs * sl[3]);
                *(u32x2*)(orow + dd) = wv; }
    } else {
#pragma unroll
        for (int d = 0; d < NDB; ++d)
#pragma unroll
            for (int gq = 0; gq < 4; ++gq) { const int dd = 32 * d + 8 * gq + 4 * hi;
                u32x2 wv; wv.x = cvt_pk_bf16(o1[d][4 * gq], o1[d][4 * gq + 1]); wv.y = cvt_pk_bf16(o1[d][4 * gq + 2], o1[d][4 * gq + 3]);
                *(u32x2*)(orow + dd) = wv; }
    }
}
}

constexpr int NWAVES = 8, NTHREADS = 512;
constexpr int LDS_BYTES = 143360;
static_assert(att::C<1>::TOTAL <= LDS_BYTES && att::C<0>::TOTAL <= LDS_BYTES && pg8::STAGE_BYTES <= LDS_BYTES, "LDS map");

__device__ __forceinline__ void p0_transpose_item(const float* W, int K, int N, bf16_t* WT, int il  , LAS float* scr, int item, int lane) {
    const int nblk = N / 32, kb = item / nblk, nb = item % nblk, k0 = 64 * kb, n0 = 32 * nb;
#pragma unroll 8
    for (int i = 0; i < 32; ++i) { const int kk = 2 * i + (lane >> 5); scr[kk * 33 + (lane & 31)] = W[(size_t)(k0 + kk) * N + n0 + (lane & 31)]; }
    asm volatile("s_waitcnt lgkmcnt(0)" ::: "memory");
    const int c = lane & 7;
    const int rbase = il ? (256 * (n0 / 128) + 128 * (il - 1) + (n0 % 128)) : n0;
#pragma unroll
    for (int j = 0; j < 4; ++j) { const int n = (lane >> 3) + 8 * j; const LAS float* s = scr + (8 * c) * 33 + n;
        u32x4 o; o.x = cvt_pk_bf16(s[0 * 33], s[1 * 33]); o.y = cvt_pk_bf16(s[2 * 33], s[3 * 33]); o.z = cvt_pk_bf16(s[4 * 33], s[5 * 33]); o.w = cvt_pk_bf16(s[6 * 33], s[7 * 33]);
        *(u32x4*)(WT + (size_t)(rbase + n) * K + k0 + 8 * c) = o; }
    asm volatile("s_waitcnt lgkmcnt(0)" ::: "memory");
}

struct Args { const float* in[21]; float* out; float* modp; float* SS; bf16_t* Wgu[2]; bf16_t* Wd[2]; bf16_t* Win; bf16_t* Wsb; bf16_t* Wda; bf16_t* Wout; bf16_t* U; bf16_t* Y; bf16_t* BIG; };

template <bool HAS_Y, bool HAS_NEXT>
__device__ __forceinline__ void rowwise_phase(LAS unsigned char* lds, int vcu, int G, const float* hin, float* hout, const bf16_t* Y, const float* SS,
                                              const float* modp, const float* npost, const float* npre, int isub, float rw, bf16_t* U) {
    int tid_ = threadIdx.x; asm volatile("" : "+v"(tid_));
    const int tid = tid_, lane = tid & 63, wave = __builtin_amdgcn_readfirstlane(tid >> 6);
    LAS float* vA = (LAS float*)lds; LAS float* vB = vA + 1024; LAS float* vC = vB + 1024;
    for (int rb = vcu; rb < MT / 256; rb += G) {
        const int b = rb >> 5;
        for (int n = tid; n < DM; n += NTHREADS) {
            if (HAS_Y) { float gsum = 0.f;
#pragma unroll
                for (int kc = 0; kc < 16; ++kc) gsum += modp[(size_t)(kc * 8 + b) * NMOD + (isub * 3 + 2) * DM + n];
                vA[n] = rw * gsum * npost[isub * DM + n]; }
            if (HAS_NEXT) { const int jn = isub + 1; float sc = 0.f, sh = 0.f;
#pragma unroll
                for (int kc = 0; kc < 16; ++kc) { sh += modp[(size_t)(kc * 8 + b) * NMOD + (jn * 3 + 0) * DM + n]; sc += modp[(size_t)(kc * 8 + b) * NMOD + (jn * 3 + 1) * DM + n]; }
                vB[n] = npre[jn * DM + n] * (1.0f + sc); vC[n] = sh; }
        }
        __syncthreads();
        f32x4 a[4], bb[4], cc[4];
#pragma unroll
        for (int j = 0; j < 4; ++j) { const int c0 = 4 * lane + 256 * j;
            a[j] = HAS_Y ? *(const LAS f32x4*)(vA + c0) : (f32x4){0.f, 0.f, 0.f, 0.f};
            bb[j] = HAS_NEXT ? *(const LAS f32x4*)(vB + c0) : (f32x4){0.f, 0.f, 0.f, 0.f};
            cc[j] = HAS_NEXT ? *(const LAS f32x4*)(vC + c0) : (f32x4){0.f, 0.f, 0.f, 0.f}; }
        for (int rr = 0; rr < 32; ++rr) {
            const size_t row = (size_t)rb * 256 + wave * 32 + rr;
            f32x4 hv[4];
#pragma unroll
            for (int j = 0; j < 4; ++j) hv[j] = *(const f32x4*)(hin + row * DM + 4 * lane + 256 * j);
            if (HAS_Y) {
                u32x2 yv[4];
#pragma unroll
                for (int j = 0; j < 4; ++j) yv[j] = *(const u32x2*)(Y + row * DM + 4 * lane + 256 * j);
                const f32x4 s0 = *(const f32x4*)(SS + row * 16), s1 = *(const f32x4*)(SS + row * 16 + 4), s2 = *(const f32x4*)(SS + row * 16 + 8), s3 = *(const f32x4*)(SS + row * 16 + 12);
                const float ssum = ((s0[0] + s0[1]) + (s0[2] + s0[3])) + ((s1[0] + s1[1]) + (s1[2] + s1[3])) + ((s2[0] + s2[1]) + (s2[2] + s2[3])) + ((s3[0] + s3[1]) + (s3[2] + s3[3]));
                const float rsy = 1.0f / sqrtf(ssum * (1.0f / DM) + EPS);
#pragma unroll
                for (int j = 0; j < 4; ++j) { hv[j][0] += a[j][0] * (bf_lo(yv[j].x) * rsy); hv[j][1] += a[j][1] * (bf_hi(yv[j].x) * rsy); hv[j][2] += a[j][2] * (bf_lo(yv[j].y) * rsy); hv[j][3] += a[j][3] * (bf_hi(yv[j].y) * rsy);
                    *(f32x4*)(hout + row * DM + 4 * lane + 256 * j) = hv[j]; }
            }
            if (HAS_NEXT) {
                float s = 0.f;
#pragma unroll
                for (int j = 0; j < 4; ++j) s += (hv[j][0] * hv[j][0] + hv[j][1] * hv[j][1]) + (hv[j][2] * hv[j][2] + hv[j][3] * hv[j][3]);
                const float rs = 1.0f / sqrtf(wave_sum(s) * (1.0f / DM) + EPS);
#pragma unroll
                for (int j = 0; j < 4; ++j) { u32x2 o; o.x = cvt_pk_bf16(hv[j][0] * rs * bb[j][0] + cc[j][0], hv[j][1] * rs * bb[j][1] + cc[j][1]);
                    o.y = cvt_pk_bf16(hv[j][2] * rs * bb[j][2] + cc[j][2], hv[j][3] * rs * bb[j][3] + cc[j][3]);
                    *(u32x2*)(U + row * DM + 4 * lane + 256 * j) = o; }
            }
        }
        __syncthreads();
    }
}

__global__ void __launch_bounds__(NTHREADS, 2) fwd_megakernel(Args args) {
    extern __shared__ __attribute__((aligned(16))) unsigned char lds_raw[];
    LAS unsigned char* lds = (LAS unsigned char*)lds_raw;
    cg::grid_group grid = cg::this_grid();
    const int tid = threadIdx.x, lane = tid & 63, wave = __builtin_amdgcn_readfirstlane(tid >> 6);
    const int G = gridDim.x, bx = blockIdx.x; const int vcu = (G % 8 == 0) ? (bx % 8) * (G / 8) + bx / 8 : bx;
    {
        LAS float* scr = (LAS float*)(lds + wave * 8448);
        const int gw = vcu * NWAVES + wave, NGW = G * NWAVES;
        constexpr int I_G = (DM / 64) * (DFF / 32), I_D = (DFF / 64) * (DM / 32), I_IN = (DM / 64) * (INW / 32), I_BR = (512 / 64) * (DM / 32), I_O = (DM / 64) * (DM / 32);
        constexpr int NITEMS = 4 * I_G + 2 * I_D + I_IN + 2 * I_BR + I_O;
        for (int it = gw; it < NITEMS; it += NGW) {
            int r = it;
            if (r < I_G) { p0_transpose_item(args.in[6], DM, DFF, args.Wgu[0], 1, scr, r, lane); continue; } r -= I_G;
            if (r < I_G) { p0_transpose_item(args.in[7], DM, DFF, args.Wgu[0], 2, scr, r, lane); continue; } r -= I_G;
            if (r < I_G) { p0_transpose_item(args.in[18], DM, DFF, args.Wgu[1], 1, scr, r, lane); continue; } r -= I_G;
            if (r < I_G) { p0_transpose_item(args.in[19], DM, DFF, args.Wgu[1], 2, scr, r, lane); continue; } r -= I_G;
            if (r < I_D) { p0_transpose_item(args.in[8], DFF, DM, args.Wd[0], 0, scr, r, lane); continue; } r -= I_D;
            if (r < I_D) { p0_transpose_item(args.in[20], DFF, DM, args.Wd[1], 0, scr, r, lane); continue; } r -= I_D;
            if (r < I_IN) { p0_transpose_item(args.in[9], DM, INW, args.Win, 0, scr, r, lane); continue; } r -= I_IN;
            if (r < I_BR) { p0_transpose_item(args.in[15], 512, DM, args.Wsb, 0, scr, r, lane); continue; } r -= I_BR;
            if (r < I_BR) { p0_transpose_item(args.in[16], 512, DM, args.Wda, 0, scr, r, lane); continue; } r -= I_BR;
            p0_transpose_item(args.in[17], DM, DM, args.Wout, 0, scr, r, lane);
        }
        LAS float* sc = (LAS float*)(lds + 69632);
        for (int i = tid; i < NB * DM; i += NTHREADS) { const float cv = args.in[1][i]; sc[i] = cv * sigmoidf_(cv); }
        __syncthreads();
        for (int task = bx * NTHREADS + tid; task < 16 * NMOD; task += G * NTHREADS) {
            const int kc = task / NMOD, n = task % NMOD;
            float acc[8];
#pragma unroll
            for (int b = 0; b < 8; ++b) acc[b] = 0.f;
            for (int k = kc * 64; k < kc * 64 + 64; ++k) { const float wv = args.in[2][(size_t)k * NMOD + n];
#pragma unroll
                for (int b = 0; b < 8; ++b) acc[b] += sc[b * DM + k] * wv; }
            if (kc == 0) { const float bv = args.in[3][n];
#pragma unroll
                for (int b = 0; b < 8; ++b) acc[b] += bv; }
#pragma unroll
            for (int b = 0; b < 8; ++b) args.modp[(size_t)(kc * 8 + b) * NMOD + n] = acc[b];
        }
    }
    grid.sync();
    rowwise_phase<false, true>(lds, vcu, G, args.in[0], nullptr, nullptr, nullptr, args.modp, args.in[5], args.in[4], -1, 0.f, args.U);
    grid.sync();

    for (int f = 0; f < 2; ++f) {
        { pg8::Gemm g{args.U, args.Wgu[f], MT, NGU, DM, DM}; pg8::StaticOrder S; S.init(MT, NGU, G, bx); pg8::EpiSwiGLU E{args.BIG}; pg8::gemm_phase(lds, g, S, E); }
        grid.sync();
        { pg8::Gemm g{args.BIG, args.Wd[f], MT, DM, DFF, DFF}; pg8::StaticOrder S; S.init(MT, DM, G, bx); pg8::EpiY E{args.Y, args.SS}; pg8::gemm_phase(lds, g, S, E); }
        grid.sync();
        if (f == 0) {
            rowwise_phase<true, true>(lds, vcu, G, args.in[0], args.out, args.Y, args.SS, args.modp, args.in[5], args.in[4], 0, 0.5f, args.U);
            grid.sync();
            { pg8::Gemm g{args.U, args.Win, MT, INW, DM, DM}; pg8::StaticOrder S; S.init(MT, INW, G, bx); pg8::EpiProj E{args.BIG}; pg8::gemm_phase(lds, g, S, E); }
            grid.sync();
            {
                float d1 = 0.f, d2 = 0.f;
                for (int i = 0; i < 64; ++i) { d1 += args.in[10][i] * args.in[11][i]; d2 += args.in[12][i] * args.in[13][i]; }
                const float lam = expf(d1) - expf(d2) + LAMBDA_INIT;
                for (int i = 0;; ++i) {
                    int bh, qb;
                    if (G == 256) { if (i >= 4) break; const int s = vcu & 7; bh = vcu >> 3; qb = (i == 0) ? 31 - s : (i == 1) ? 16 + s : (i == 2) ? 15 - s : s; }
                    else { const int L = i * G + bx; if (L >= 1024) break; bh = L & 31; qb = 31 - (L >> 5); }
                    const int hh = bh & 3; const float slope = exp2f(-2.0f * (float)(hh + 1));
                    att::attn_unit<1>(lds, args.BIG, bh >> 2, hh, qb, lam, args.in[14], slope);
                }
                for (int i = 0;; ++i) {
                    const int L = i * G + vcu; if (L >= 2048) break;
                    const int bh = L >> 5, qb = L & 31;
                    att::attn_unit<0>(lds, args.BIG, bh >> 3, bh & 7, qb, 0.f, nullptr, 0.f);
                }
            }
            grid.sync();
            { pg8::Gemm g{args.BIG, args.Wsb, MT, DM, 512, INW}; pg8::StaticOrder S; S.init(MT, DM, G, bx); pg8::EpiGate<true> E{args.U, args.BIG, 3072}; pg8::gemm_phase(lds, g, S, E); }
            __syncthreads();
            { pg8::Gemm g{args.BIG + 1536, args.Wda, MT, DM, 512, INW}; pg8::StaticOrder S; S.init(MT, DM, G, bx); pg8::EpiGate<false> E{args.U, args.BIG, 4096}; pg8::gemm_phase(lds, g, S, E); }
            grid.sync();
            { pg8::Gemm g{args.U, args.Wout, MT, DM, DM, DM}; pg8::StaticOrder S; S.init(MT, DM, G, bx); pg8::EpiY E{args.Y, args.SS}; pg8::gemm_phase(lds, g, S, E); }
            grid.sync();
            rowwise_phase<true, true>(lds, vcu, G, args.out, args.out, args.Y, args.SS, args.modp, args.in[5], args.in[4], 1, 1.0f, args.U);
            grid.sync();
        } else {
            rowwise_phase<true, false>(lds, vcu, G, args.out, args.out, args.Y, args.SS, args.modp, args.in[5], args.in[4], 2, 0.5f, nullptr);
        }
    }
}

extern "C" void kernel_launch(void* const* d_in, const int* in_sizes, int n_in, void* d_out, int out_size, void* d_ws, size_t ws_size, hipStream_t stream) {
    static int grid = 0;
    if (grid == 0) {
        if (n_in != 21 || in_sizes[0] != MT * DM || out_size != MT * DM || ws_size < WS_END) {
            fprintf(stderr, "kernel_launch: unexpected shapes (n_in %d in0 %d out %d ws %zu); nothing launched\n", n_in, n_in > 0 ? in_sizes[0] : -1, out_size, ws_size); grid = -1; return; }
        int dev = 0, cus = 0, per_cu = 0;
        hipGetDevice(&dev);
        hipDeviceGetAttribute(&cus, hipDeviceAttributeMultiprocessorCount, dev);
        if (hipFuncSetAttribute((const void*)fwd_megakernel, hipFuncAttributeMaxDynamicSharedMemorySize, LDS_BYTES) != hipSuccess) fprintf(stderr, "kernel_launch: hipFuncSetAttribute failed\n");
        if (hipOccupancyMaxActiveBlocksPerMultiprocessor(&per_cu, (const void*)fwd_megakernel, NTHREADS, LDS_BYTES) != hipSuccess || per_cu < 1) { fprintf(stderr, "kernel_launch: occupancy query gave %d\n", per_cu); per_cu = 1; }
        (void)hipGetLastError();
        grid = cus * 1;
        if (grid <= 0) grid = 256;
    }
    if (grid < 0) return;
    Args a{};
    for (int i = 0; i < 21; ++i) a.in[i] = (const float*)d_in[i];
    unsigned char* ws = (unsigned char*)d_ws;
    a.out = (float*)d_out; a.modp = (float*)(ws + WS_MODP); a.SS = (float*)(ws + WS_SS);
    a.Wgu[0] = (bf16_t*)(ws + WS_WGU1); a.Wgu[1] = (bf16_t*)(ws + WS_WGU2); a.Wd[0] = (bf16_t*)(ws + WS_WD1); a.Wd[1] = (bf16_t*)(ws + WS_WD2);
    a.Win = (bf16_t*)(ws + WS_WIN); a.Wsb = (bf16_t*)(ws + WS_WSB); a.Wda = (bf16_t*)(ws + WS_WDA); a.Wout = (bf16_t*)(ws + WS_WOUT);
    a.U = (bf16_t*)(ws + WS_U); a.Y = (bf16_t*)(ws + WS_Y); a.BIG = (bf16_t*)(ws + WS_BIG);
    void* kargs[] = {&a};
    hipError_t e = hipLaunchCooperativeKernel((const void*)fwd_megakernel, dim3(grid), dim3(NTHREADS), kargs, LDS_BYTES, stream);
    if (e != hipSuccess) fprintf(stderr, "cooperative launch failed: %s (grid %d)\n", hipGetErrorString(e), grid);
}
```

```cpp
#include <hip/hip_runtime.h>
#include <hip/hip_cooperative_groups.h>
#include <cstdio>
#include <cstdint>
namespace cg = cooperative_groups;

#define LAS __attribute__((address_space(3)))
typedef unsigned short bf16_t;
typedef short bf16x8 __attribute__((ext_vector_type(8)));
typedef short s16x4 __attribute__((ext_vector_type(4)));
typedef float f32x4 __attribute__((ext_vector_type(4)));
typedef float f32x16 __attribute__((ext_vector_type(16)));
typedef unsigned u32x4 __attribute__((ext_vector_type(4)));
typedef unsigned u32x2 __attribute__((ext_vector_type(2)));

constexpr int DM = 1024, NB = 8, SEQ = 8192, MT = NB * SEQ, DFF = 2816, NGU = 2 * DFF, INW = 5120, NMOD = 9216;
constexpr float EPS = 1e-6f, LOG2E = 1.4426950408889634f, LN2 = 0.6931471805599453f;
constexpr float LAMBDA_INIT = 0.2f;

constexpr size_t MiB = 1u << 20;
constexpr size_t WS_MODP = 1 * MiB;
constexpr size_t WS_SS = 6 * MiB;
constexpr size_t WS_WGU1 = 10 * MiB, WS_WD1 = 21 * MiB, WS_WIN = 27 * MiB, WS_WSB = 37 * MiB, WS_WDA = 38 * MiB, WS_WOUT = 39 * MiB, WS_WGU2 = 41 * MiB, WS_WD2 = 52 * MiB;
constexpr size_t WS_U = 64 * MiB;
constexpr size_t WS_Y = 192 * MiB;
constexpr size_t WS_BIG = 320 * MiB;
constexpr size_t WS_END = 960 * MiB;

__device__ __forceinline__ unsigned cvt_pk_bf16(float lo, float hi) { unsigned r; asm volatile("v_cvt_pk_bf16_f32 %0, %1, %2" : "=v"(r) : "v"(lo), "v"(hi)); return r; }
__device__ __forceinline__ float bf_lo(unsigned u) { return __uint_as_float(u << 16); }
__device__ __forceinline__ float bf_hi(unsigned u) { return __uint_as_float(u & 0xffff0000u); }
__device__ __forceinline__ float fast_exp2(float x) { return __builtin_amdgcn_exp2f(x); }
__device__ __forceinline__ float fast_log2(float x) { return __builtin_amdgcn_logf(x); }
__device__ __forceinline__ float fast_rcp(float x) { return __builtin_amdgcn_rcpf(x); }
__device__ __forceinline__ float sigmoidf_(float x) { return fast_rcp(1.0f + fast_exp2(-x * LOG2E)); }
__device__ __forceinline__ float wave_sum(float v) {
#pragma unroll
    for (int o = 1; o < 64; o <<= 1) v += __shfl_xor(v, o);
    return v;
}

__device__ __forceinline__ void glds_s(const void* sbase, unsigned voff, unsigned lds_dst) {
    unsigned keep;
    asm volatile("s_mov_b32 %0, m0\n\ts_mov_b32 m0, %3\n\ts_nop 0\n\tglobal_load_lds_dwordx4 %1, %2\n\ts_mov_b32 m0, %0" : "=&s"(keep) : "v"(voff), "s"(sbase), "s"(lds_dst) : "memory");
}

namespace pg8 {
constexpr int BM = 256, BK = 64, HALF = 128, HTB = HALF * BK * 2, STAGE_BYTES = 8 * HTB, NXCD = 8, WGM = 8;
__host__ __device__ __forceinline__ int lds_byte(int r, int c) { const int st = (r >> 4) * 2 + (c >> 5), rr = r & 15, cc = c & 31, ob = rr * 64 + cc * 2; return st * 1024 + (ob ^ (((ob >> 9) & 1) << 5)); }
__host__ __device__ __forceinline__ void stage_rc(int b, int& R, int& C) { const int st = b / 1024, sb = b % 1024, swz = sb ^ (((sb >> 9) & 1) << 5); R = (st >> 1) * 16 + swz / 64; C = (st & 1) * 32 + (swz % 64) / 2; }
__host__ __device__ __forceinline__ int perm32(int rho) { const int n = rho >> 4, i = rho & 15; return 8 * (i >> 2) + 4 * n + (i & 3); }

struct Unit { int pm, pn; };
struct Gemm { const bf16_t* A; const bf16_t* Bt; int M, N, K, lda; };

struct StaticOrder {
    int nM, nN, nwg, G, c;
    __device__ void init(int M, int N, int G_, int c_) { nM = M / BM; nN = N / BM; nwg = nM * nN; G = G_; c = c_; }
    __device__ bool next(int i, Unit& u) const {
        const long L = (long)i * G + c; if (L >= nwg) return false;
        int wgid = (int)L; { const int q = nwg / NXCD, r = nwg % NXCD, xcd = wgid % NXCD, off = wgid / NXCD; wgid = (xcd < r ? xcd * (q + 1) : r * (q + 1) + (xcd - r) * q) + off; }
        const int nig = WGM * nN, gid = wgid / nig, fm = gid * WGM, gsz = (nM - fm) < WGM ? (nM - fm) : WGM;
        u.pm = fm + ((wgid % nig) % gsz); u.pn = (wgid % nig) / gsz; return true;
    }
};

template <class Epi>
__device__ __forceinline__ void gemm_phase(LAS unsigned char* lds, const Gemm g, const StaticOrder& S, const Epi& E) {
    int tid_ = threadIdx.x; asm volatile("" : "+v"(tid_));
    const int tid = tid_, wid = __builtin_amdgcn_readfirstlane(tid >> 6), lane = tid & 63, wr = wid >> 2, wc = wid & 3, fr = lane & 15, fq = lane >> 4;
    const int K = g.K, nt = K / BK, lda = g.lda;
    unsigned voffA[2], voffB[2];
#pragma unroll
    for (int i = 0; i < 2; ++i) { int R, C; stage_rc(tid * 16 + i * 8192, R, C); const int Rb = (R & ~31) + perm32(R & 31);
        voffA[i] = (unsigned)(R * lda + C) * 2u; voffB[i] = (unsigned)(Rb * K + C) * 2u; }
    const size_t kstep = (size_t)(BK * 2);
    const size_t hstepA = (size_t)HALF * lda * 2, hstepB = (size_t)HALF * K * 2;
    const size_t tstepA = 2 * hstepA, tstepB = 2 * hstepB;
    const unsigned ldsbase = (unsigned)(uintptr_t)lds + (unsigned)wid * 1024u;
    const int aoff = lds_byte(wr * 64 + fr, fq * 8), boff = lds_byte(wc * 32 + fr, fq * 8);
#define PG8_SA(b, h) (((b) * 2 + (h)) * HTB)
#define PG8_SB(b, h) ((4 + (b) * 2 + (h)) * HTB)
#define PG8_STAGE(bufoff, gbase, voff) do { _Pragma("unroll") for (int _i = 0; _i < 2; ++_i) \
        glds_s((const void*)(gbase), (voff)[_i], ldsbase + (unsigned)((bufoff) + _i * 8192)); } while (0)
#define PG8_LDA(dst, b, h) do { _Pragma("unroll") for (int m = 0; m < 4; ++m) _Pragma("unroll") for (int k = 0; k < 2; ++k) dst[m][k] = *(const LAS bf16x8*)(lds + PG8_SA(b, h) + aoff + m * 2048 + k * 1024); } while (0)
#define PG8_LDB(dst, b, h) do { _Pragma("unroll") for (int n = 0; n < 2; ++n) _Pragma("unroll") for (int k = 0; k < 2; ++k) dst[n][k] = *(const LAS bf16x8*)(lds + PG8_SB(b, h) + boff + n * 2048 + k * 1024); } while (0)
#define PG8_MMA(ai, bj, At, Bt) do { __builtin_amdgcn_s_setprio(1); _Pragma("unroll") for (int m = 0; m < 4; ++m) _Pragma("unroll") for (int n = 0; n < 2; ++n) _Pragma("unroll") for (int k = 0; k < 2; ++k) \
        acc[ai][bj][m][n] = __builtin_amdgcn_mfma_f32_16x16x32_bf16(Bt[n][k], At[m][k], acc[ai][bj][m][n], 0, 0, 0); __builtin_amdgcn_s_setprio(0); } while (0)
#define PG8_WAIT_V(n) asm volatile("s_waitcnt vmcnt(" #n ")" ::: "memory")
#define PG8_WAIT_L(n) asm volatile("s_waitcnt lgkmcnt(" #n ")" ::: "memory")
#define PG8_BAR __builtin_amdgcn_s_barrier()
#define PG8_SCHED __builtin_amdgcn_sched_barrier(0)
    Unit cur, nxt; int ui = 0;
    if (!S.next(0, cur)) return;
    f32x4 acc[2][2][4][2];
#pragma unroll
    for (int a = 0; a < 2; ++a)
#pragma unroll
        for (int b = 0; b < 2; ++b)
#pragma unroll
            for (int m = 0; m < 4; ++m)
#pragma unroll
                for (int n = 0; n < 2; ++n) acc[a][b][m][n] = (f32x4){0.f, 0.f, 0.f, 0.f};
    bf16x8 At[4][2], B0[2][2], B1[2][2];
    const char* cA = (const char*)g.A + (size_t)cur.pm * tstepA; const char* cB = (const char*)g.Bt + (size_t)cur.pn * tstepB;
    PG8_STAGE(PG8_SB(0, 0), cB, voffB); PG8_STAGE(PG8_SB(0, 1), cB + hstepB, voffB); PG8_STAGE(PG8_SA(0, 0), cA, voffA); PG8_STAGE(PG8_SA(0, 1), cA + hstepA, voffA);
    if (wr == 1) PG8_BAR;
    PG8_WAIT_V(2); PG8_BAR;
    PG8_STAGE(PG8_SB(1, 0), cB + kstep, voffB); PG8_STAGE(PG8_SA(1, 0), cA + kstep, voffA); PG8_STAGE(PG8_SB(1, 1), cB + hstepB + kstep, voffB);
    PG8_WAIT_V(6); PG8_BAR;
    for (;;) {
        const bool has_next = S.next(ui + 1, nxt);
        const char* nA = has_next ? (const char*)g.A + (size_t)nxt.pm * tstepA : cA; const char* nB = has_next ? (const char*)g.Bt + (size_t)nxt.pn * tstepB : cB;
        for (int t = 0; t < nt; t += 2) {
            const bool last = (t == nt - 2);
            const char* a1 = cA + (size_t)(t + 1) * kstep;
            const char* a2 = last ? nA : cA + (size_t)(t + 2) * kstep; const char* b2 = last ? nB : cB + (size_t)(t + 2) * kstep;
            const char* a3 = a2 + kstep; const char* b3 = b2 + kstep;
            PG8_LDB(B0, 0, 0); PG8_LDB(B1, 0, 1); PG8_SCHED; PG8_LDA(At, 0, 0); PG8_STAGE(PG8_SA(1, 1), a1 + hstepA, voffA);
            PG8_WAIT_V(8); PG8_WAIT_L(0); PG8_BAR; PG8_MMA(0, 0, At, B0); PG8_MMA(0, 1, At, B1); PG8_BAR; PG8_SCHED;
            PG8_LDA(At, 0, 1); PG8_STAGE(PG8_SB(0, 0), b2, voffB); PG8_STAGE(PG8_SB(0, 1), b2 + hstepB, voffB); PG8_STAGE(PG8_SA(0, 0), a2, voffA);
            PG8_WAIT_V(8); PG8_WAIT_L(0); PG8_BAR; PG8_MMA(1, 0, At, B0); PG8_MMA(1, 1, At, B1); PG8_BAR; PG8_SCHED;
            PG8_LDB(B0, 1, 0); PG8_LDB(B1, 1, 1); PG8_SCHED; PG8_LDA(At, 1, 0); PG8_STAGE(PG8_SA(0, 1), a2 + hstepA, voffA);
            PG8_WAIT_V(8); PG8_WAIT_L(0); PG8_BAR; PG8_MMA(0, 0, At, B0); PG8_MMA(0, 1, At, B1); PG8_BAR; PG8_SCHED;
            PG8_LDA(At, 1, 1); PG8_STAGE(PG8_SB(1, 0), b3, voffB); PG8_STAGE(PG8_SB(1, 1), b3 + hstepB, voffB); PG8_STAGE(PG8_SA(1, 0), a3, voffA);
            PG8_WAIT_V(8); PG8_WAIT_L(0); PG8_BAR; PG8_MMA(1, 0, At, B0); PG8_MMA(1, 1, At, B1); PG8_BAR; PG8_SCHED;
        }
        if (wr == 0) PG8_BAR;
        E(acc, cur, wr, wc, fr, fq);
        if (!has_next) break;
#pragma unroll
        for (int a = 0; a < 2; ++a)
#pragma unroll
            for (int b = 0; b < 2; ++b)
#pragma unroll
                for (int m = 0; m < 4; ++m)
#pragma unroll
                    for (int n = 0; n < 2; ++n) acc[a][b][m][n] = (f32x4){0.f, 0.f, 0.f, 0.f};
        cur = nxt; cA = nA; cB = nB; ++ui;
        if (wr == 1) PG8_BAR;
    }
    PG8_WAIT_V(0);
    PG8_BAR;
#undef PG8_SA
#undef PG8_SB
#undef PG8_STAGE
#undef PG8_LDA
#undef PG8_LDB
#undef PG8_MMA
#undef PG8_WAIT_V
#undef PG8_WAIT_L
#undef PG8_BAR
#undef PG8_SCHED
}

struct EpiSwiGLU {
    bf16_t* H;
    __device__ __forceinline__ void operator()(const f32x4 (&acc)[2][2][4][2], const Unit& u, int wr, int wc, int fr, int fq) const {
        const int row0 = u.pm * BM + wr * 64 + fr, col0 = u.pn * HALF + wc * 32 + 8 * fq;
#pragma unroll
        for (int ai = 0; ai < 2; ++ai)
#pragma unroll
            for (int m = 0; m < 4; ++m) {
                float o[8];
#pragma unroll
                for (int n = 0; n < 2; ++n)
#pragma unroll
                    for (int e = 0; e < 4; ++e) { const float gv = acc[ai][0][m][n][e], uv = acc[ai][1][m][n][e]; o[n * 4 + e] = gv * sigmoidf_(gv) * uv; }
                u32x4 w; w.x = cvt_pk_bf16(o[0], o[1]); w.y = cvt_pk_bf16(o[2], o[3]); w.z = cvt_pk_bf16(o[4], o[5]); w.w = cvt_pk_bf16(o[6], o[7]);
                *(u32x4*)(H + (size_t)(row0 + ai * HALF + m * 16) * DFF + col0) = w;
                asm volatile("" ::: "memory");
            }
    }
};
struct EpiProj {
    bf16_t *Qsb, *KVsb, *Qda, *KVda, *Gt;
    __device__ __forceinline__ void operator()(const f32x4 (&acc)[2][2][4][2], const Unit& u, int wr, int wc, int fr, int fq) const {
        const int row0 = u.pm * BM + wr * 64 + fr; const int cbase = u.pn * BM; const bool sg = (cbase >= 3072);
#pragma unroll
        for (int ai = 0; ai < 2; ++ai)
#pragma unroll
            for (int m = 0; m < 4; ++m) { const int row = row0 + ai * HALF + m * 16; const int b = row >> 13, t = row & (SEQ - 1);
#pragma unroll
                for (int bj = 0; bj < 2; ++bj) { f32x4 v0 = acc[ai][bj][m][0], v1 = acc[ai][bj][m][1];
                    const int c = cbase + bj * HALF + wc * 32 + 8 * fq;
                    bf16_t* dst;
                    if (cbase < 1536) { const int sec = c >> 9, cc = c & 511, h = cc >> 6, wv = cc & 63; const size_t ri = (size_t)(b * 8 + h) * SEQ + t;
                        dst = (sec == 0) ? Qsb + ri * 64 + wv : KVsb + ri * 128 + (sec == 2 ? 64 : 0) + wv; }
                    else if (cbase < 3072) { const int c2 = c - 1536, sec = c2 >> 9, cc = c2 & 511, h = cc >> 7, wv = cc & 127; const size_t ri = (size_t)(b * 4 + h) * SEQ + t;
                        dst = (sec == 0) ? Qda + ri * 128 + wv : KVda + ri * 256 + (sec == 2 ? 128 : 0) + wv; }
                    else dst = Gt + (size_t)row * 2048 + (c - 3072);
                    if (sg) {
#pragma unroll
                        for (int e = 0; e < 4; ++e) { v0[e] = sigmoidf_(v0[e]); v1[e] = sigmoidf_(v1[e]); } }
                    u32x4 w; w.x = cvt_pk_bf16(v0[0], v0[1]); w.y = cvt_pk_bf16(v0[2], v0[3]); w.z = cvt_pk_bf16(v1[0], v1[1]); w.w = cvt_pk_bf16(v1[2], v1[3]);
                    *(u32x4*)dst = w; }
                asm volatile("" ::: "memory"); }
    }
};
struct EpiY {
    bf16_t* Y; float* SS;
    __device__ __forceinline__ void operator()(const f32x4 (&acc)[2][2][4][2], const Unit& u, int wr, int wc, int fr, int fq) const {
        const int row0 = u.pm * BM + wr * 64 + fr, col0 = u.pn * BM + wc * 32 + 8 * fq;
#pragma unroll
        for (int ai = 0; ai < 2; ++ai)
#pragma unroll
            for (int m = 0; m < 4; ++m) { const int row = row0 + ai * HALF + m * 16; bf16_t* rowp = Y + (size_t)row * DM + col0; float s = 0.f;
#pragma unroll
                for (int bj = 0; bj < 2; ++bj) { const f32x4 v0 = acc[ai][bj][m][0], v1 = acc[ai][bj][m][1];
                    s += (v0[0] * v0[0] + v0[1] * v0[1]) + (v0[2] * v0[2] + v0[3] * v0[3]) + (v1[0] * v1[0] + v1[1] * v1[1]) + (v1[2] * v1[2] + v1[3] * v1[3]);
                    u32x4 w; w.x = cvt_pk_bf16(v0[0], v0[1]); w.y = cvt_pk_bf16(v0[2], v0[3]); w.z = cvt_pk_bf16(v1[0], v1[1]); w.w = cvt_pk_bf16(v1[2], v1[3]);
                    *(u32x4*)(rowp + bj * HALF) = w; }
                s += __shfl_xor(s, 16); s += __shfl_xor(s, 32);
                if (fq == 0) SS[(size_t)row * 16 + u.pn * 4 + wc] = s;
                asm volatile("" ::: "memory"); }
    }
};
template <bool FIRST> struct EpiGate {
    bf16_t* Mg; const bf16_t* Gt; int gcol;
    __device__ __forceinline__ void operator()(const f32x4 (&acc)[2][2][4][2], const Unit& u, int wr, int wc, int fr, int fq) const {
        const int row0 = u.pm * BM + wr * 64 + fr, col0 = u.pn * BM + wc * 32 + 8 * fq;
#pragma unroll
        for (int ai = 0; ai < 2; ++ai)
#pragma unroll
            for (int m = 0; m < 4; ++m) { const size_t row = (size_t)(row0 + ai * HALF + m * 16);
#pragma unroll
                for (int bj = 0; bj < 2; ++bj) { const f32x4 v0 = acc[ai][bj][m][0], v1 = acc[ai][bj][m][1];
                    const u32x4 sgv = *(const u32x4*)(Gt + row * 2048 + gcol + col0 + bj * HALF);
                    float o[8];
                    o[0] = bf_lo(sgv.x) * v0[0]; o[1] = bf_hi(sgv.x) * v0[1]; o[2] = bf_lo(sgv.y) * v0[2]; o[3] = bf_hi(sgv.y) * v0[3];
                    o[4] = bf_lo(sgv.z) * v1[0]; o[5] = bf_hi(sgv.z) * v1[1]; o[6] = bf_lo(sgv.w) * v1[2]; o[7] = bf_hi(sgv.w) * v1[3];
                    bf16_t* dst = Mg + row * DM + col0 + bj * HALF;
                    if (!FIRST) { const u32x4 t = *(const u32x4*)dst;
                        o[0] += bf_lo(t.x); o[1] += bf_hi(t.x); o[2] += bf_lo(t.y); o[3] += bf_hi(t.y); o[4] += bf_lo(t.z); o[5] += bf_hi(t.z); o[6] += bf_lo(t.w); o[7] += bf_hi(t.w); }
                    u32x4 w; w.x = cvt_pk_bf16(o[0], o[1]); w.y = cvt_pk_bf16(o[2], o[3]); w.z = cvt_pk_bf16(o[4], o[5]); w.w = cvt_pk_bf16(o[6], o[7]);
                    *(u32x4*)dst = w; asm volatile("" ::: "memory"); } }
    }
};
}

namespace att {
template <int MODE> struct C {
    static constexpr int NMAP = MODE ? 2 : 1, KW = 64 * NMAP, VD = 64 * NMAP, KP = KW * 2 + 16, VP = 136, KBUF = 64 * KP, VBUF = VD * VP;
    static constexpr int OFF_K = 0, OFF_V = 2 * KBUF, OFF_Q = 2 * KBUF + 2 * VBUF, QP = KW * 2 + 16, QBUF = 32 * QP, TOTAL = OFF_Q + 8 * QBUF;
    static constexpr int NKT = (64 * (KW / 8)) / 512;
};
__device__ __forceinline__ int crow(int r, int hi) { return (r & 3) + 8 * (r >> 2) + 4 * hi; }

template <int MODE>
__device__ __forceinline__ void attn_unit(LAS unsigned char* lds, const bf16_t* Qp  , const bf16_t* KVp  , bf16_t* Op  , int qb, float lam, const float* subln, float slope) {
    typedef C<MODE> CF;
    constexpr int NMAP = CF::NMAP, KW = CF::KW, VD = CF::VD, KP = CF::KP, VP = CF::VP, QP = CF::QP, NDB = VD / 32;
    int tid_ = threadIdx.x; asm volatile("" : "+v"(tid_));
    const int tid = tid_, lane = tid & 63, q = lane & 31, hi = lane >> 5; const int w = __builtin_amdgcn_readfirstlane(tid >> 6);
    constexpr int QPITCH = KW, KVPITCH = KW + VD, OPITCH = 512;
    LAS unsigned char* Qw = lds + CF::OFF_Q + w * CF::QBUF;
    {
        constexpr int CPR = KW / 8, NQ = 32 * CPR / 64;
        u32x4 qv[NQ];
#pragma unroll
        for (int i = 0; i < NQ; ++i) { const int cid = lane + 64 * i, r = cid / CPR, ch = cid % CPR;
            qv[i] = *(const u32x4*)(Qp + (size_t)(qb * 256 + w * 32 + r) * QPITCH + 8 * ch); }
#pragma unroll
        for (int i = 0; i < NQ; ++i) { const int cid = lane + 64 * i, r = cid / CPR, ch = cid % CPR;
            *(LAS u32x4*)(Qw + r * QP + 16 * ch) = qv[i]; }
    }
    u32x4 kreg[CF::NKT], vreg[2];
    const bool vact = (MODE == 1) || (tid < 256);
    const int vkp = tid & 31, vc = tid >> 5;
    unsigned koff[CF::NKT];
#pragma unroll
    for (int i_ = 0; i_ < CF::NKT; ++i_) { const int tk_ = tid + 512 * i_, key_ = tk_ / (KW / 8), ch_ = tk_ % (KW / 8); koff[i_] = (unsigned)(key_ * KVPITCH + 8 * ch_) * 2u; }
    const unsigned voff0 = (unsigned)(2 * vkp * KVPITCH + KW + 8 * vc) * 2u;
    const char* const Pb = (const char*)KVp;
#define ATT_LOAD(kt) do { const char* tb_ = Pb + (size_t)(kt) * (64 * KVPITCH * 2); \
        _Pragma("unroll") for (int i_ = 0; i_ < CF::NKT; ++i_) kreg[i_] = *(const u32x4*)(tb_ + koff[i_]); \
        if (vact) { vreg[0] = *(const u32x4*)(tb_ + voff0); vreg[1] = *(const u32x4*)(tb_ + voff0 + KVPITCH * 2); } } while (0)
#define ATT_STORE(buf) do { LAS unsigned char* kb_ = lds + CF::OFF_K + (buf) * CF::KBUF; LAS unsigned char* vb_ = lds + CF::OFF_V + (buf) * CF::VBUF; \
        _Pragma("unroll") for (int i_ = 0; i_ < CF::NKT; ++i_) { const int tk_ = tid + 512 * i_, key_ = tk_ / (KW / 8), ch_ = tk_ % (KW / 8); \
            *(LAS u32x4*)(kb_ + key_ * KP + 16 * ch_) = kreg[i_]; } \
        if (vact) { _Pragma("unroll") for (int e_ = 0; e_ < 4; ++e_) { const unsigned a_ = vreg[0][e_], b_ = vreg[1][e_]; \
            *(LAS unsigned*)(vb_ + (8 * vc + 2 * e_) * VP + 4 * vkp) = (a_ & 0xffffu) | (b_ << 16); \
            *(LAS unsigned*)(vb_ + (8 * vc + 2 * e_ + 1) * VP + 4 * vkp) = (a_ >> 16) | (b_ & 0xffff0000u); } } } while (0)

    const int nt = 4 * (qb + 1);
    ATT_LOAD(nt - 1);
    ATT_STORE(0);
    f32x16 o1[NDB], o2[NDB];
#pragma unroll
    for (int d = 0; d < NDB; ++d) { o1[d] = (f32x16){}; o2[d] = (f32x16){}; }
    float m1 = -INFINITY, m2 = -INFINITY, l1 = 0.f, l2 = 0.f, carry = 0.f;
    const int tpos = qb * 256 + w * 32 + q;
    bool wdone = false;
    __syncthreads();
    for (int it = 0; it < nt; ++it) {
        const int kt = nt - 1 - it, cur = it & 1;
        const bool active = (kt - 4 * qb) <= (w >> 1);
        if (active && !wdone) {
            LAS unsigned char* Kb = lds + CF::OFF_K + cur * CF::KBUF; LAS unsigned char* Vb = lds + CF::OFF_V + cur * CF::VBUF;
#pragma unroll
            for (int mp = 0; mp < NMAP; ++mp) {
#pragma unroll
                for (int kh = 1; kh >= 0; --kh) {
                    f32x16 s = (f32x16){};
#pragma unroll
                    for (int d0 = 0; d0 < 4; ++d0) {
                        const bf16x8 kf = *(const LAS bf16x8*)(Kb + (32 * kh + q) * KP + (64 * mp + 16 * d0 + 8 * hi) * 2);
                        const bf16x8 qf = *(const LAS bf16x8*)(Qw + q * QP + (64 * mp + 16 * d0 + 8 * hi) * 2);
                        s = __builtin_amdgcn_mfma_f32_32x32x16_bf16(kf, qf, s, 0, 0, 0); }
                    if (MODE == 1) {
                        const float c1 = 0.125f * LOG2E, c2 = slope * LOG2E; const float dbase = (float)(tpos - kt * 64 - 32 * kh - 4 * hi);
                        float mx = -INFINITY;
#pragma unroll
                        for (int r = 0; r < 16; ++r) { const float dist = fabsf(dbase - (float)crow(r, 0)); const float x = s[r] * c1 - c2 * dist; s[r] = x; mx = fmaxf(mx, x); }
                        mx = fmaxf(mx, __shfl_xor(mx, 32));
                        float& mref = mp ? m2 : m1; float& lref = mp ? l2 : l1;
                        const float mnew = fmaxf(mref, mx);
                        if (__any(mnew > mref)) { const float alpha = fast_exp2(mref - mnew); lref *= alpha;
#pragma unroll
                            for (int d = 0; d < NDB; ++d) { if (mp) o2[d] *= alpha; else o1[d] *= alpha; }
                            mref = mnew; }
                        float ps = 0.f;
#pragma unroll
                        for (int r = 0; r < 16; ++r) { const float p = fast_exp2(s[r] - mnew); s[r] = p; ps += p; }
                        lref += ps;
                    } else {
                        float sp[16];
#pragma unroll
                        for (int r = 0; r < 16; ++r) { const float z = s[r] * 0.125f; s[r] = z; const bool valid = (kt * 64 + 32 * kh + crow(r, hi)) < tpos;
                            const float a = fabsf(z); const float e = fast_exp2(-a * LOG2E); const float spv = fmaxf(z, 0.f) + fast_log2(1.0f + e) * LN2; sp[r] = valid ? spv : 0.f; }
                        float G[4], Gp[4];
#pragma unroll
                        for (int i = 0; i < 4; ++i) { G[i] = (sp[4 * i] + sp[4 * i + 1]) + (sp[4 * i + 2] + sp[4 * i + 3]); Gp[i] = __shfl_xor(G[i], 32); }
                        float after = 0.f;
#pragma unroll
                        for (int i = 3; i >= 0; --i) { float run = carry + after + (hi == 0 ? Gp[i] : 0.f);
#pragma unroll
                            for (int j = 3; j >= 0; --j) { const int r = 4 * i + j; run += sp[r]; const bool valid = (kt * 64 + 32 * kh + crow(r, hi)) < tpos;
                                const float wv = fast_exp2((s[r] - run) * LOG2E); s[r] = valid ? wv : 0.f; }
                            after += G[i] + Gp[i]; }
                        carry += after;
                    }
                    bf16x8 pk[2];
#pragma unroll
                    for (int j = 0; j < 2; ++j) { u32x4 pw; pw.x = cvt_pk_bf16(s[8 * j + 0], s[8 * j + 1]); pw.y = cvt_pk_bf16(s[8 * j + 2], s[8 * j + 3]);
                        pw.z = cvt_pk_bf16(s[8 * j + 4], s[8 * j + 5]); pw.w = cvt_pk_bf16(s[8 * j + 6], s[8 * j + 7]);
                        pk[j] = __builtin_bit_cast(bf16x8, pw); }
#pragma unroll
                    for (int d = 0; d < NDB; ++d)
#pragma unroll
                        for (int j = 0; j < 2; ++j) { const LAS unsigned char* vp = Vb + (32 * d + q) * VP + 2 * (32 * kh + 16 * j + 4 * hi);
                            const s16x4 lo = *(const LAS s16x4*)vp, hh = *(const LAS s16x4*)(vp + 16);
                            const bf16x8 vf = (bf16x8){lo[0], lo[1], lo[2], lo[3], hh[0], hh[1], hh[2], hh[3]};
                            if (mp) o2[d] = __builtin_amdgcn_mfma_f32_32x32x16_bf16(vf, pk[j], o2[d], 0, 0, 0);
                            else o1[d] = __builtin_amdgcn_mfma_f32_32x32x16_bf16(vf, pk[j], o1[d], 0, 0, 0); }
                    __builtin_amdgcn_sched_barrier(0);
                }
            }
            if (MODE == 0) wdone = __all(carry > 110.0f);
        }
        if (kt > 0) { ATT_LOAD(kt - 1); ATT_STORE(cur ^ 1); }
        if (MODE == 0) { if (__syncthreads_and(wdone ? 1 : 0)) break; } else __syncthreads();
    }
#undef ATT_LOAD
#undef ATT_STORE
    bf16_t* orow = Op + (size_t)(qb * 256 + w * 32 + q) * OPITCH;
    if (MODE == 1) {
        l1 += __shfl_xor(l1, 32); l2 += __shfl_xor(l2, 32);
        const float i1 = 1.0f / l1, i2 = lam / l2; float ss = 0.f;
#pragma unroll
        for (int d = 0; d < NDB; ++d)
#pragma unroll
            for (int r = 0; r < 16; ++r) { const float v = o1[d][r] * i1 - o2[d][r] * i2; o1[d][r] = v; ss += v * v; }
        ss += __shfl_xor(ss, 32);
        const float rs = (1.0f / sqrtf(ss * (1.0f / 128.0f) + EPS)) * (1.0f - LAMBDA_INIT);
#pragma unroll
        for (int d = 0; d < NDB; ++d)
#pragma unroll
            for (int gq = 0; gq < 4; ++gq) { const int dd = 32 * d + 8 * gq + 4 * hi; const f32x4 sl = *(const f32x4*)(subln + dd);
                u32x2 wv; wv.x = cvt_pk_bf16(o1[d][4 * gq] * rs * sl[0], o1[d][4 * gq + 1] * rs * sl[1]); wv.y = cvt_pk_bf16(o1[d][4 * gq + 2] * rs * sl[2], o1[d][4 * gq + 3] * rs * sl[3]);
                *(u32x2*)(orow + dd) = wv; }
    } else {
#pragma unroll
        for (int d = 0; d < NDB; ++d)
#pragma unroll
            for (int gq = 0; gq < 4; ++gq) { const int dd = 32 * d + 8 * gq + 4 * hi;
                u32x2 wv; wv.x = cvt_pk_bf16(o1[d][4 * gq], o1[d][4 * gq + 1]); wv.y = cvt_pk_bf16(o1[d][4 * gq + 2], o1[d][4 * gq + 3]);
                *(u32x2*)(orow + dd) = wv; }
    }
}

constexpr int DA_KB = 0, DA_VB = 32768, DA_Q = 65536, DA_QP = 272, DA_QBUF = 32 * DA_QP, DA_TOTAL = DA_Q + 8 * DA_QBUF;
typedef short v4i16_t __attribute__((ext_vector_type(4)));
__device__ __forceinline__ s16x4 vtr(const LAS unsigned char* p) { return __builtin_bit_cast(s16x4, __builtin_amdgcn_ds_read_tr16_b64_v4i16((LAS v4i16_t*)p)); }
__device__ __forceinline__ float max3f(float a, float b, float c) { return fmaxf(fmaxf(a, b), c); }

__device__ __forceinline__ void da_unit(LAS unsigned char* lds, const bf16_t* Qp  , const bf16_t* KVp  , bf16_t* Op  , int qb, float lam, const float* subln, float slope) {
    int tid_ = threadIdx.x; asm volatile("" : "+v"(tid_));
    const int tid = tid_, lane = tid & 63, q = lane & 31, hi = lane >> 5; const int w = __builtin_amdgcn_readfirstlane(tid >> 6);
    LAS unsigned char* Qw = lds + DA_Q + w * DA_QBUF;
    const unsigned ldsb = (unsigned)(uintptr_t)lds;
    unsigned voff[2];
#pragma unroll
    for (int i = 0; i < 2; ++i) { const int row = 8 * w + 4 * i + (lane >> 4); const int f = ((row & 3) << 2) | ((row >> 2) & 3); voff[i] = (unsigned)(row * 512 + 16 * ((lane & 15) ^ f)); }
    const char* const Pb = (const char*)KVp;
#define DA_DMA(kt, buf) do { const char* tb_ = Pb + (size_t)(kt) * (64 * 512); \
        _Pragma("unroll") for (int i_ = 0; i_ < 2; ++i_) { glds_s(tb_, voff[i_], ldsb + (unsigned)(DA_KB + (buf) * 16384 + (2 * w + i_) * 1024)); \
            glds_s(tb_ + 256, voff[i_], ldsb + (unsigned)(DA_VB + (buf) * 16384 + (2 * w + i_) * 1024)); } } while (0)
    const int nt = 4 * (qb + 1);
    DA_DMA(nt - 1, 0);
    {
        const float c1 = 0.125f * LOG2E;
#pragma unroll
        for (int i = 0; i < 8; ++i) { const int cid = lane + 64 * i, r = cid >> 4, ch = cid & 15;
            u32x4 v = *(const u32x4*)(Qp + (size_t)(qb * 256 + w * 32 + r) * 128 + 8 * ch);
            v.x = cvt_pk_bf16(bf_lo(v.x) * c1, bf_hi(v.x) * c1); v.y = cvt_pk_bf16(bf_lo(v.y) * c1, bf_hi(v.y) * c1);
            v.z = cvt_pk_bf16(bf_lo(v.z) * c1, bf_hi(v.z) * c1); v.w = cvt_pk_bf16(bf_lo(v.w) * c1, bf_hi(v.w) * c1);
            *(LAS u32x4*)(Qw + r * DA_QP + 16 * ch) = v; }
    }
    f32x16 o1[4], o2[4];
#pragma unroll
    for (int d = 0; d < 4; ++d) { o1[d] = (f32x16){}; o2[d] = (f32x16){}; }
    float m1 = -INFINITY, m2 = -INFINITY, l1 = 0.f, l2 = 0.f;
    const int tpos = qb * 256 + w * 32 + q;
    const float c2 = slope * LOG2E;
    const int F16 = 16 * (((q & 3) << 2) | ((q >> 2) & 3));
    const int kq = 256 * q;
    const int qq = (lane & 15) >> 2, g1 = (lane >> 4) & 1, pp = lane & 3;
    const int A0 = 256 * (4 * hi + qq) + 8 * (pp & 1);
    const int vbase0 = A0 + 16 * ((2 * g1 + (pp >> 1)) ^ hi), vbase1 = A0 + 2048 + 16 * ((2 * g1 + (pp >> 1)) ^ (hi + 2));
    asm volatile("s_waitcnt vmcnt(0)" ::: "memory");
    __syncthreads();
#define DS_RD128(dst, addr, imm) asm volatile("ds_read_b128 %0, %1 offset:%c2" : "=&v"(dst) : "v"(addr), "i"(imm) : "memory")
#define DS_RDTR(dst, addr, imm) asm volatile("ds_read_b64_tr_b16 %0, %1 offset:%c2" : "=&v"(dst) : "v"(addr), "i"(imm) : "memory")
    const unsigned FH = (unsigned)(F16 ^ (16 * hi));
    const unsigned qaddr = (unsigned)(uintptr_t)Qw + (unsigned)(q * DA_QP + 16 * hi);
    const unsigned xq = 64u * (unsigned)qq;
#define DA_ISSUE_KQ(mp, kh) do { _Pragma("unroll") for (int d0_ = 0; d0_ < 4; ++d0_) { const unsigned ka_ = kcur + ((unsigned)(128 * (mp) + 32 * d0_) ^ FH); \
        DS_RD128(kf[d0_], ka_, 8192 * (kh)); DS_RD128(qf[d0_], qaddr, 128 * (mp) + 32 * d0_); } } while (0)
    for (int it = 0; it < nt; ++it) {
        const int kt = nt - 1 - it, cur = it & 1;
        if (kt > 0) DA_DMA(kt - 1, cur ^ 1);
        if ((kt - 4 * qb) <= (w >> 1)) {
            const bool band = kt >= 4 * qb;
            const unsigned kcur = ldsb + (unsigned)(DA_KB + cur * 16384 + kq);
            const unsigned vcur = ldsb + (unsigned)(DA_VB + cur * 16384);
#pragma unroll
            for (int st = 0; st < 4; ++st) {
                const int mp = st >> 1, kh = 1 - (st & 1);
                f32x16 s = (f32x16){};
                {
                    bf16x8 kf[4], qf[4];
                    DA_ISSUE_KQ(mp, kh);
                    asm volatile("s_waitcnt lgkmcnt(0)" : "+v"(kf[0]), "+v"(kf[1]), "+v"(kf[2]), "+v"(kf[3]), "+v"(qf[0]), "+v"(qf[1]), "+v"(qf[2]), "+v"(qf[3]) :: "memory");
#pragma unroll
                    for (int d0 = 0; d0 < 4; ++d0) s = __builtin_amdgcn_mfma_f32_32x32x16_bf16(kf[d0], qf[d0], s, 0, 0, 0);
                }
                float off;
                if (band) { const float dbase = (float)(tpos - kt * 64 - 32 * kh - 4 * hi);
#pragma unroll
                    for (int r = 0; r < 16; ++r) s[r] = s[r] - c2 * fabsf(dbase - (float)crow(r, 0));
                    off = 0.f;
                } else {
#pragma unroll
                    for (int r = 0; r < 16; ++r) s[r] = fmaf(c2, (float)crow(r, 0), s[r]);
                    off = c2 * (float)(kt * 64 + 32 * kh + 4 * hi - tpos);
                }
                float mx = max3f(s[0], s[1], s[2]);
#pragma unroll
                for (int r = 3; r < 15; r += 2) mx = max3f(mx, s[r], s[r + 1]);
                mx = fmaxf(mx, s[15]) + off;
                { auto rr = __builtin_amdgcn_permlane32_swap(__float_as_uint(mx), __float_as_uint(mx), false, false); mx = fmaxf(__uint_as_float(rr[0]), __uint_as_float(rr[1])); }
                float& mref = mp ? m2 : m1; float& lref = mp ? l2 : l1;
                if (!__all(mx - mref < -160.0f)) {
                    s16x4 va_lo[4], va_hi[4], vb_lo[4], vb_hi[4];
#define DA_ISSUE_V(lo_, hi_, dbase_) do { _Pragma("unroll") for (int d_ = 0; d_ < 2; ++d_) { const unsigned xd_ = vcur + ((unsigned)(64 * ((dbase_) + d_)) ^ xq); const unsigned a0_ = xd_ + (unsigned)vbase0, a1_ = xd_ + (unsigned)vbase1; \
                        _Pragma("unroll") for (int j_ = 0; j_ < 2; ++j_) { DS_RDTR(lo_[2 * d_ + j_], a0_, 8192 * kh + 4096 * j_); DS_RDTR(hi_[2 * d_ + j_], a1_, 8192 * kh + 4096 * j_); } } } while (0)
                    DA_ISSUE_V(va_lo, va_hi, 0);
                    const float mnew = fmaxf(mref, mx);
                    if (__any(mnew > mref)) { const float alpha = fast_exp2(mref - mnew); lref *= alpha;
#pragma unroll
                        for (int d = 0; d < 4; ++d) { if (mp) o2[d] *= alpha; else o1[d] *= alpha; }
                        mref = mnew; }
                    const float dd = off - mnew; float ps = 0.f;
#pragma unroll
                    for (int r = 0; r < 16; ++r) { const float p = fast_exp2(s[r] + dd); s[r] = p; ps += p; }
                    lref += ps;
                    bf16x8 pk[2];
#pragma unroll
                    for (int j = 0; j < 2; ++j) { u32x4 pw; pw.x = cvt_pk_bf16(s[8 * j + 0], s[8 * j + 1]); pw.y = cvt_pk_bf16(s[8 * j + 2], s[8 * j + 3]);
                        pw.z = cvt_pk_bf16(s[8 * j + 4], s[8 * j + 5]); pw.w = cvt_pk_bf16(s[8 * j + 6], s[8 * j + 7]);
                        pk[j] = __builtin_bit_cast(bf16x8, pw); }
                    DA_ISSUE_V(vb_lo, vb_hi, 2);
                    asm volatile("s_waitcnt lgkmcnt(8)" : "+v"(va_lo[0]), "+v"(va_lo[1]), "+v"(va_lo[2]), "+v"(va_lo[3]), "+v"(va_hi[0]), "+v"(va_hi[1]), "+v"(va_hi[2]), "+v"(va_hi[3]) :: "memory");
#pragma unroll
                    for (int d = 0; d < 2; ++d)
#pragma unroll
                        for (int j = 0; j < 2; ++j) { const s16x4 lo = va_lo[2 * d + j], hh = va_hi[2 * d + j];
                            const bf16x8 vf = (bf16x8){lo[0], lo[1], lo[2], lo[3], hh[0], hh[1], hh[2], hh[3]};
                            if (mp) o2[d] = __builtin_amdgcn_mfma_f32_32x32x16_bf16(vf, pk[j], o2[d], 0, 0, 0);
                            else o1[d] = __builtin_amdgcn_mfma_f32_32x32x16_bf16(vf, pk[j], o1[d], 0, 0, 0); }
                    asm volatile("s_waitcnt lgkmcnt(0)" : "+v"(vb_lo[0]), "+v"(vb_lo[1]), "+v"(vb_lo[2]), "+v"(vb_lo[3]), "+v"(vb_hi[0]), "+v"(vb_hi[1]), "+v"(vb_hi[2]), "+v"(vb_hi[3]) :: "memory");
#pragma unroll
                    for (int d = 0; d < 2; ++d)
#pragma unroll
                        for (int j = 0; j < 2; ++j) { const s16x4 lo = vb_lo[2 * d + j], hh = vb_hi[2 * d + j];
                            const bf16x8 vf = (bf16x8){lo[0], lo[1], lo[2], lo[3], hh[0], hh[1], hh[2], hh[3]};
                            if (mp) o2[2 + d] = __builtin_amdgcn_mfma_f32_32x32x16_bf16(vf, pk[j], o2[2 + d], 0, 0, 0);
                            else o1[2 + d] = __builtin_amdgcn_mfma_f32_32x32x16_bf16(vf, pk[j], o1[2 + d], 0, 0, 0); }
#undef DA_ISSUE_V
                }
                __builtin_amdgcn_sched_barrier(0);
            }
        }
        asm volatile("s_waitcnt vmcnt(0)" ::: "memory");
        __syncthreads();
    }
#undef DA_ISSUE_KQ
#undef DA_DMA
    bf16_t* orow = Op + (size_t)(qb * 256 + w * 32 + q) * 512;
    l1 += __shfl_xor(l1, 32); l2 += __shfl_xor(l2, 32);
    const float i1 = 1.0f / l1, i2 = lam / l2; float ss = 0.f;
#pragma unroll
    for (int d = 0; d < 4; ++d)
#pragma unroll
        for (int r = 0; r < 16; ++r) { const float v = o1[d][r] * i1 - o2[d][r] * i2; o1[d][r] = v; ss += v * v; }
    ss += __shfl_xor(ss, 32);
    const float rs = (1.0f / sqrtf(ss * (1.0f / 128.0f) + EPS)) * (1.0f - LAMBDA_INIT);
#pragma unroll
    for (int d = 0; d < 4; ++d)
#pragma unroll
        for (int gq = 0; gq < 4; ++gq) { const int dd = 32 * d + 8 * gq + 4 * hi; const f32x4 sl = *(const f32x4*)(subln + dd);
            u32x2 wv; wv.x = cvt_pk_bf16(o1[d][4 * gq] * rs * sl[0], o1[d][4 * gq + 1] * rs * sl[1]); wv.y = cvt_pk_bf16(o1[d][4 * gq + 2] * rs * sl[2], o1[d][4 * gq + 3] * rs * sl[3]);
            *(u32x2*)(orow + dd) = wv; }
}
}

constexpr int NWAVES = 8, NTHREADS = 512;
constexpr int LDS_BYTES = 143360;
static_assert(att::DA_TOTAL <= LDS_BYTES && att::C<0>::TOTAL <= LDS_BYTES && pg8::STAGE_BYTES <= LDS_BYTES, "LDS map");

__device__ __forceinline__ void p0_transpose_item(const float* W, int K, int N, bf16_t* WT, int il  , LAS float* scr, int item, int lane) {
    const int nblk = N / 32, kb = item / nblk, nb = item % nblk, k0 = 64 * kb, n0 = 32 * nb;
#pragma unroll 8
    for (int i = 0; i < 32; ++i) { const int kk = 2 * i + (lane >> 5); scr[kk * 33 + (lane & 31)] = W[(size_t)(k0 + kk) * N + n0 + (lane & 31)]; }
    asm volatile("s_waitcnt lgkmcnt(0)" ::: "memory");
    const int c = lane & 7;
    const int rbase = il ? (256 * (n0 / 128) + 128 * (il - 1) + (n0 % 128)) : n0;
#pragma unroll
    for (int j = 0; j < 4; ++j) { const int n = (lane >> 3) + 8 * j; const LAS float* s = scr + (8 * c) * 33 + n;
        u32x4 o; o.x = cvt_pk_bf16(s[0 * 33], s[1 * 33]); o.y = cvt_pk_bf16(s[2 * 33], s[3 * 33]); o.z = cvt_pk_bf16(s[4 * 33], s[5 * 33]); o.w = cvt_pk_bf16(s[6 * 33], s[7 * 33]);
        *(u32x4*)(WT + (size_t)(rbase + n) * K + k0 + 8 * c) = o; }
    asm volatile("s_waitcnt lgkmcnt(0)" ::: "memory");
}

struct Args { const float* in[21]; float* out; float* modp; float* SS; bf16_t* Wgu[2]; bf16_t* Wd[2]; bf16_t* Win; bf16_t* Wsb; bf16_t* Wda; bf16_t* Wout; bf16_t* U; bf16_t* Y; bf16_t* BIG; bf16_t* Qsb; bf16_t* KVsb; bf16_t* Qda; bf16_t* KVda; bf16_t* Gt; bf16_t* ya; bf16_t* yd; unsigned* ctr; };

template <bool HAS_Y, bool HAS_NEXT>
__device__ __forceinline__ void rowwise_phase(LAS unsigned char* lds, int vcu, int G, const float* hin, float* hout, const bf16_t* Y, const float* SS,
                                              const float* modp, const float* npost, const float* npre, int isub, float rw, bf16_t* U) {
    int tid_ = threadIdx.x; asm volatile("" : "+v"(tid_));
    const int tid = tid_, lane = tid & 63, wave = __builtin_amdgcn_readfirstlane(tid >> 6);
    LAS float* vA = (LAS float*)lds; LAS float* vB = vA + 1024; LAS float* vC = vB + 1024;
    for (int rb = vcu; rb < MT / 256; rb += G) {
        const int b = rb >> 5;
        for (int n = tid; n < DM; n += NTHREADS) {
            if (HAS_Y) { float gsum = 0.f;
#pragma unroll
                for (int kc = 0; kc < 16; ++kc) gsum += modp[(size_t)(kc * 8 + b) * NMOD + (isub * 3 + 2) * DM + n];
                vA[n] = rw * gsum * npost[isub * DM + n]; }
            if (HAS_NEXT) { const int jn = isub + 1; float sc = 0.f, sh = 0.f;
#pragma unroll
                for (int kc = 0; kc < 16; ++kc) { sh += modp[(size_t)(kc * 8 + b) * NMOD + (jn * 3 + 0) * DM + n]; sc += modp[(size_t)(kc * 8 + b) * NMOD + (jn * 3 + 1) * DM + n]; }
                vB[n] = npre[jn * DM + n] * (1.0f + sc); vC[n] = sh; }
        }
        __syncthreads();
        f32x4 a[4], bb[4], cc[4];
#pragma unroll
        for (int j = 0; j < 4; ++j) { const int c0 = 4 * lane + 256 * j;
            a[j] = HAS_Y ? *(const LAS f32x4*)(vA + c0) : (f32x4){0.f, 0.f, 0.f, 0.f};
            bb[j] = HAS_NEXT ? *(const LAS f32x4*)(vB + c0) : (f32x4){0.f, 0.f, 0.f, 0.f};
            cc[j] = HAS_NEXT ? *(const LAS f32x4*)(vC + c0) : (f32x4){0.f, 0.f, 0.f, 0.f}; }
        for (int rr = 0; rr < 32; ++rr) {
            const size_t row = (size_t)rb * 256 + wave * 32 + rr;
            f32x4 hv[4];
#pragma unroll
            for (int j = 0; j < 4; ++j) hv[j] = *(const f32x4*)(hin + row * DM + 4 * lane + 256 * j);
            if (HAS_Y) {
                u32x2 yv[4];
#pragma unroll
                for (int j = 0; j < 4; ++j) yv[j] = *(const u32x2*)(Y + row * DM + 4 * lane + 256 * j);
                const f32x4 s0 = *(const f32x4*)(SS + row * 16), s1 = *(const f32x4*)(SS + row * 16 + 4), s2 = *(const f32x4*)(SS + row * 16 + 8), s3 = *(const f32x4*)(SS + row * 16 + 12);
                const float ssum = ((s0[0] + s0[1]) + (s0[2] + s0[3])) + ((s1[0] + s1[1]) + (s1[2] + s1[3])) + ((s2[0] + s2[1]) + (s2[2] + s2[3])) + ((s3[0] + s3[1]) + (s3[2] + s3[3]));
                const float rsy = 1.0f / sqrtf(ssum * (1.0f / DM) + EPS);
#pragma unroll
                for (int j = 0; j < 4; ++j) { hv[j][0] += a[j][0] * (bf_lo(yv[j].x) * rsy); hv[j][1] += a[j][1] * (bf_hi(yv[j].x) * rsy); hv[j][2] += a[j][2] * (bf_lo(yv[j].y) * rsy); hv[j][3] += a[j][3] * (bf_hi(yv[j].y) * rsy);
                    *(f32x4*)(hout + row * DM + 4 * lane + 256 * j) = hv[j]; }
            }
            if (HAS_NEXT) {
                float s = 0.f;
#pragma unroll
                for (int j = 0; j < 4; ++j) s += (hv[j][0] * hv[j][0] + hv[j][1] * hv[j][1]) + (hv[j][2] * hv[j][2] + hv[j][3] * hv[j][3]);
                const float rs = 1.0f / sqrtf(wave_sum(s) * (1.0f / DM) + EPS);
#pragma unroll
                for (int j = 0; j < 4; ++j) { u32x2 o; o.x = cvt_pk_bf16(hv[j][0] * rs * bb[j][0] + cc[j][0], hv[j][1] * rs * bb[j][1] + cc[j][1]);
                    o.y = cvt_pk_bf16(hv[j][2] * rs * bb[j][2] + cc[j][2], hv[j][3] * rs * bb[j][3] + cc[j][3]);
                    *(u32x2*)(U + row * DM + 4 * lane + 256 * j) = o; }
            }
        }
        __syncthreads();
    }
}

__global__ void __launch_bounds__(NTHREADS, 2) fwd_megakernel(Args args) {
    extern __shared__ __attribute__((aligned(16))) unsigned char lds_raw[];
    LAS unsigned char* lds = (LAS unsigned char*)lds_raw;
    cg::grid_group grid = cg::this_grid();
    const int tid = threadIdx.x, lane = tid & 63, wave = __builtin_amdgcn_readfirstlane(tid >> 6);
    const int G = gridDim.x, bx = blockIdx.x; const int vcu = (G % 8 == 0) ? (bx % 8) * (G / 8) + bx / 8 : bx;
    if (bx == 0 && tid == 0) __hip_atomic_store(args.ctr, 0u, __ATOMIC_RELAXED, __HIP_MEMORY_SCOPE_AGENT);
    {
        LAS float* scr = (LAS float*)(lds + wave * 8448);
        const int gw = vcu * NWAVES + wave, NGW = G * NWAVES;
        constexpr int I_G = (DM / 64) * (DFF / 32), I_D = (DFF / 64) * (DM / 32), I_IN = (DM / 64) * (INW / 32), I_BR = (512 / 64) * (DM / 32), I_O = (DM / 64) * (DM / 32);
        constexpr int NITEMS = 4 * I_G + 2 * I_D + I_IN + 2 * I_BR + I_O;
        for (int it = gw; it < NITEMS; it += NGW) {
            int r = it;
            if (r < I_G) { p0_transpose_item(args.in[6], DM, DFF, args.Wgu[0], 1, scr, r, lane); continue; } r -= I_G;
            if (r < I_G) { p0_transpose_item(args.in[7], DM, DFF, args.Wgu[0], 2, scr, r, lane); continue; } r -= I_G;
            if (r < I_G) { p0_transpose_item(args.in[18], DM, DFF, args.Wgu[1], 1, scr, r, lane); continue; } r -= I_G;
            if (r < I_G) { p0_transpose_item(args.in[19], DM, DFF, args.Wgu[1], 2, scr, r, lane); continue; } r -= I_G;
            if (r < I_D) { p0_transpose_item(args.in[8], DFF, DM, args.Wd[0], 0, scr, r, lane); continue; } r -= I_D;
            if (r < I_D) { p0_transpose_item(args.in[20], DFF, DM, args.Wd[1], 0, scr, r, lane); continue; } r -= I_D;
            if (r < I_IN) { p0_transpose_item(args.in[9], DM, INW, args.Win, 0, scr, r, lane); continue; } r -= I_IN;
            if (r < I_BR) { p0_transpose_item(args.in[15], 512, DM, args.Wsb, 0, scr, r, lane); continue; } r -= I_BR;
            if (r < I_BR) { p0_transpose_item(args.in[16], 512, DM, args.Wda, 0, scr, r, lane); continue; } r -= I_BR;
            p0_transpose_item(args.in[17], DM, DM, args.Wout, 0, scr, r, lane);
        }
        LAS float* sc = (LAS float*)(lds + 69632);
        for (int i = tid; i < NB * DM; i += NTHREADS) { const float cv = args.in[1][i]; sc[i] = cv * sigmoidf_(cv); }
        __syncthreads();
        for (int task = bx * NTHREADS + tid; task < 16 * NMOD; task += G * NTHREADS) {
            const int kc = task / NMOD, n = task % NMOD;
            float acc[8];
#pragma unroll
            for (int b = 0; b < 8; ++b) acc[b] = 0.f;
            for (int k = kc * 64; k < kc * 64 + 64; ++k) { const float wv = args.in[2][(size_t)k * NMOD + n];
#pragma unroll
                for (int b = 0; b < 8; ++b) acc[b] += sc[b * DM + k] * wv; }
            if (kc == 0) { const float bv = args.in[3][n];
#pragma unroll
                for (int b = 0; b < 8; ++b) acc[b] += bv; }
#pragma unroll
            for (int b = 0; b < 8; ++b) args.modp[(size_t)(kc * 8 + b) * NMOD + n] = acc[b];
        }
    }
    grid.sync();
    rowwise_phase<false, true>(lds, vcu, G, args.in[0], nullptr, nullptr, nullptr, args.modp, args.in[5], args.in[4], -1, 0.f, args.U);
    grid.sync();

    for (int f = 0; f < 2; ++f) {
        { pg8::Gemm g{args.U, args.Wgu[f], MT, NGU, DM, DM}; pg8::StaticOrder S; S.init(MT, NGU, G, bx); pg8::EpiSwiGLU E{args.BIG}; pg8::gemm_phase(lds, g, S, E); }
        grid.sync();
        { pg8::Gemm g{args.BIG, args.Wd[f], MT, DM, DFF, DFF}; pg8::StaticOrder S; S.init(MT, DM, G, bx); pg8::EpiY E{args.Y, args.SS}; pg8::gemm_phase(lds, g, S, E); }
        grid.sync();
        if (f == 0) {
            rowwise_phase<true, true>(lds, vcu, G, args.in[0], args.out, args.Y, args.SS, args.modp, args.in[5], args.in[4], 0, 0.5f, args.U);
            grid.sync();
            { pg8::Gemm g{args.U, args.Win, MT, INW, DM, DM}; pg8::StaticOrder S; S.init(MT, INW, G, bx); pg8::EpiProj E{args.Qsb, args.KVsb, args.Qda, args.KVda, args.Gt}; pg8::gemm_phase(lds, g, S, E); }
            grid.sync();
            {
                float d1 = 0.f, d2 = 0.f;
                for (int i = 0; i < 64; ++i) { d1 += args.in[10][i] * args.in[11][i]; d2 += args.in[12][i] * args.in[13][i]; }
                const float lam = expf(d1) - expf(d2) + LAMBDA_INIT;
                LAS unsigned* slot = (LAS unsigned*)(lds + (LDS_BYTES - 16));
                for (;;) {
                    if (tid == 0) *slot = __hip_atomic_fetch_add(args.ctr, 1u, __ATOMIC_RELAXED, __HIP_MEMORY_SCOPE_AGENT);
                    __syncthreads();
                    const unsigned u = *slot;
                    __syncthreads();
                    if (u >= 3072u) break;
                    if (u < 1024u) { const int qb = 31 - (int)(u >> 5), bh = (int)(u & 31u), hh = bh & 3; const float slope = exp2f(-2.0f * (float)(hh + 1));
                        att::da_unit(lds, args.Qda + (size_t)bh * SEQ * 128, args.KVda + (size_t)bh * SEQ * 256, args.yd + (size_t)(bh >> 2) * SEQ * 512 + 128 * hh, qb, lam, args.in[14], slope);
                    } else { const int v = (int)u - 1024, bh = v >> 5, qb = 31 - (v & 31);
                        att::attn_unit<0>(lds, args.Qsb + (size_t)bh * SEQ * 64, args.KVsb + (size_t)bh * SEQ * 128, args.ya + (size_t)(bh >> 3) * SEQ * 512 + 64 * (bh & 7), qb, 0.f, nullptr, 0.f); }
                }
            }
            grid.sync();
            { pg8::Gemm g{args.ya, args.Wsb, MT, DM, 512, 512}; pg8::StaticOrder S; S.init(MT, DM, G, bx); pg8::EpiGate<true> E{args.U, args.Gt, 0}; pg8::gemm_phase(lds, g, S, E); }
            __syncthreads();
            { pg8::Gemm g{args.yd, args.Wda, MT, DM, 512, 512}; pg8::StaticOrder S; S.init(MT, DM, G, bx); pg8::EpiGate<false> E{args.U, args.Gt, 1024}; pg8::gemm_phase(lds, g, S, E); }
            grid.sync();
            { pg8::Gemm g{args.U, args.Wout, MT, DM, DM, DM}; pg8::StaticOrder S; S.init(MT, DM, G, bx); pg8::EpiY E{args.Y, args.SS}; pg8::gemm_phase(lds, g, S, E); }
            grid.sync();
            rowwise_phase<true, true>(lds, vcu, G, args.out, args.out, args.Y, args.SS, args.modp, args.in[5], args.in[4], 1, 1.0f, args.U);
            grid.sync();
        } else {
            rowwise_phase<true, false>(lds, vcu, G, args.out, args.out, args.Y, args.SS, args.modp, args.in[5], args.in[4], 2, 0.5f, nullptr);
        }
    }
}

extern "C" void kernel_launch(void* const* d_in, const int* in_sizes, int n_in, void* d_out, int out_size, void* d_ws, size_t ws_size, hipStream_t stream) {
    static int grid = 0;
    if (grid == 0) {
        if (n_in != 21 || in_sizes[0] != MT * DM || out_size != MT * DM || ws_size < WS_END) {
            fprintf(stderr, "kernel_launch: unexpected shapes (n_in %d in0 %d out %d ws %zu); nothing launched\n", n_in, n_in > 0 ? in_sizes[0] : -1, out_size, ws_size); grid = -1; return; }
        int dev = 0, cus = 0, per_cu = 0;
        hipGetDevice(&dev);
        hipDeviceGetAttribute(&cus, hipDeviceAttributeMultiprocessorCount, dev);
        if (hipFuncSetAttribute((const void*)fwd_megakernel, hipFuncAttributeMaxDynamicSharedMemorySize, LDS_BYTES) != hipSuccess) fprintf(stderr, "kernel_launch: hipFuncSetAttribute failed\n");
        if (hipOccupancyMaxActiveBlocksPerMultiprocessor(&per_cu, (const void*)fwd_megakernel, NTHREADS, LDS_BYTES) != hipSuccess || per_cu < 1) { fprintf(stderr, "kernel_launch: occupancy query gave %d\n", per_cu); per_cu = 1; }
        (void)hipGetLastError();
        grid = cus * 1;
        if (grid <= 0) grid = 256;
    }
    if (grid < 0) return;
    Args a{};
    for (int i = 0; i < 21; ++i) a.in[i] = (const float*)d_in[i];
    unsigned char* ws = (unsigned char*)d_ws;
    a.out = (float*)d_out; a.modp = (float*)(ws + WS_MODP); a.SS = (float*)(ws + WS_SS);
    a.Wgu[0] = (bf16_t*)(ws + WS_WGU1); a.Wgu[1] = (bf16_t*)(ws + WS_WGU2); a.Wd[0] = (bf16_t*)(ws + WS_WD1); a.Wd[1] = (bf16_t*)(ws + WS_WD2);
    a.Win = (bf16_t*)(ws + WS_WIN); a.Wsb = (bf16_t*)(ws + WS_WSB); a.Wda = (bf16_t*)(ws + WS_WDA); a.Wout = (bf16_t*)(ws + WS_WOUT);
    a.U = (bf16_t*)(ws + WS_U); a.Y = (bf16_t*)(ws + WS_Y); a.BIG = (bf16_t*)(ws + WS_BIG);
    a.Qsb = (bf16_t*)(ws + WS_BIG); a.KVsb = (bf16_t*)(ws + WS_BIG + 64 * MiB); a.Qda = (bf16_t*)(ws + WS_BIG + 192 * MiB); a.KVda = (bf16_t*)(ws + WS_BIG + 256 * MiB); a.Gt = (bf16_t*)(ws + WS_BIG + 384 * MiB);
    a.ctr = (unsigned*)ws;
    a.ya = (bf16_t*)(ws + WS_Y); a.yd = (bf16_t*)(ws + WS_Y + 64 * MiB);
    void* kargs[] = {&a};
    hipError_t e = hipLaunchCooperativeKernel((const void*)fwd_megakernel, dim3(grid), dim3(NTHREADS), kargs, LDS_BYTES, stream);
    if (e != hipSuccess) fprintf(stderr, "cooperative launch failed: %s (grid %d)\n", hipGetErrorString(e), grid);
}
```

```cpp
#include <hip/hip_runtime.h>
#include <hip/hip_cooperative_groups.h>
#include <cstdio>
#include <cstdint>
namespace cg = cooperative_groups;

#define LAS __attribute__((address_space(3)))
typedef unsigned short bf16_t;
typedef short bf16x8 __attribute__((ext_vector_type(8)));
typedef short s16x4 __attribute__((ext_vector_type(4)));
typedef float f32x4 __attribute__((ext_vector_type(4)));
typedef float f32x16 __attribute__((ext_vector_type(16)));
typedef unsigned u32x4 __attribute__((ext_vector_type(4)));
typedef unsigned u32x2 __attribute__((ext_vector_type(2)));

constexpr int DM = 1024, NB = 8, SEQ = 8192, MT = NB * SEQ, DFF = 2816, NGU = 2 * DFF, INW = 5120, NMOD = 9216;
constexpr float EPS = 1e-6f, LOG2E = 1.4426950408889634f, LN2 = 0.6931471805599453f;
constexpr float LAMBDA_INIT = 0.2f;

constexpr size_t MiB = 1u << 20;
constexpr size_t WS_MODP = 1 * MiB;
constexpr size_t WS_SS = 6 * MiB;
constexpr size_t WS_WGU1 = 10 * MiB, WS_WD1 = 21 * MiB, WS_WIN = 27 * MiB, WS_WSB = 37 * MiB, WS_WDA = 38 * MiB, WS_WOUT = 39 * MiB, WS_WGU2 = 41 * MiB, WS_WD2 = 52 * MiB;
constexpr size_t WS_U = 64 * MiB;
constexpr size_t WS_Y = 192 * MiB;
constexpr size_t WS_BIG = 320 * MiB;
constexpr size_t WS_END = 960 * MiB;

typedef float f32x2_t __attribute__((ext_vector_type(2))); typedef __bf16 bf16x2_t __attribute__((ext_vector_type(2)));
__device__ __forceinline__ unsigned cvt_pk_bf16(float lo, float hi) { const f32x2_t v = {lo, hi}; const bf16x2_t b = __builtin_convertvector(v, bf16x2_t); return __builtin_bit_cast(unsigned, b); }
__device__ __forceinline__ float bf_lo(unsigned u) { return __uint_as_float(u << 16); }
__device__ __forceinline__ float bf_hi(unsigned u) { return __uint_as_float(u & 0xffff0000u); }
__device__ __forceinline__ float fast_exp2(float x) { return __builtin_amdgcn_exp2f(x); }
__device__ __forceinline__ float fast_log2(float x) { return __builtin_amdgcn_logf(x); }
__device__ __forceinline__ float fast_rcp(float x) { return __builtin_amdgcn_rcpf(x); }
__device__ __forceinline__ float sigmoidf_(float x) { return fast_rcp(1.0f + fast_exp2(-x * LOG2E)); }
__device__ __forceinline__ float wave_sum(float v) {
#pragma unroll
    for (int o = 1; o < 64; o <<= 1) v += __shfl_xor(v, o);
    return v;
}

__device__ __forceinline__ void glds_s(const void* sbase, unsigned voff, unsigned lds_dst) {
    unsigned keep;
    asm volatile("s_mov_b32 %0, m0\n\ts_mov_b32 m0, %3\n\ts_nop 0\n\tglobal_load_lds_dwordx4 %1, %2\n\ts_mov_b32 m0, %0" : "=&s"(keep) : "v"(voff), "s"(sbase), "s"(lds_dst) : "memory");
}

namespace pg8 {
constexpr int BM = 256, BK = 64, HALF = 128, HTB = HALF * BK * 2, STAGE_BYTES = 8 * HTB, NXCD = 8, WGM = 8;
__host__ __device__ __forceinline__ int lds_byte(int r, int c) { const int st = (r >> 4) * 2 + (c >> 5), rr = r & 15, cc = c & 31, ob = rr * 64 + cc * 2; return st * 1024 + (ob ^ (((ob >> 9) & 1) << 5)); }
__host__ __device__ __forceinline__ void stage_rc(int b, int& R, int& C) { const int st = b / 1024, sb = b % 1024, swz = sb ^ (((sb >> 9) & 1) << 5); R = (st >> 1) * 16 + swz / 64; C = (st & 1) * 32 + (swz % 64) / 2; }
__host__ __device__ __forceinline__ int perm32(int rho) { const int n = rho >> 4, i = rho & 15; return 8 * (i >> 2) + 4 * n + (i & 3); }

struct Unit { int pm, pn; };
struct Gemm { const bf16_t* A; const bf16_t* Bt; int M, N, K, lda; };

struct StaticOrder {
    int nM, nN, nwg, G, c;
    __device__ void init(int M, int N, int G_, int c_) { nM = M / BM; nN = N / BM; nwg = nM * nN; G = G_; c = c_; }
    __device__ bool next(int i, Unit& u) const {
        const long L = (long)i * G + c; if (L >= nwg) return false;
        int wgid = (int)L; { const int q = nwg / NXCD, r = nwg % NXCD, xcd = wgid % NXCD, off = wgid / NXCD; wgid = (xcd < r ? xcd * (q + 1) : r * (q + 1) + (xcd - r) * q) + off; }
        const int nig = WGM * nN, gid = wgid / nig, fm = gid * WGM, gsz = (nM - fm) < WGM ? (nM - fm) : WGM;
        u.pm = fm + ((wgid % nig) % gsz); u.pn = (wgid % nig) / gsz; return true;
    }
};

template <class Epi>
__device__ __forceinline__ void gemm_phase(LAS unsigned char* lds, const Gemm g, const StaticOrder& S, const Epi& E) {
    int tid_ = threadIdx.x; asm volatile("" : "+v"(tid_));
    const int tid = tid_, wid = __builtin_amdgcn_readfirstlane(tid >> 6), lane = tid & 63, wr = wid >> 2, wc = wid & 3, fr = lane & 15, fq = lane >> 4;
    const int K = g.K, nt = K / BK, lda = g.lda;
    unsigned voffA[2], voffB[2];
#pragma unroll
    for (int i = 0; i < 2; ++i) { int R, C; stage_rc(tid * 16 + i * 8192, R, C); const int Rb = (R & ~31) + perm32(R & 31);
        voffA[i] = (unsigned)(R * lda + C) * 2u; voffB[i] = (unsigned)(Rb * K + C) * 2u; }
    const size_t kstep = (size_t)(BK * 2);
    const size_t hstepA = (size_t)HALF * lda * 2, hstepB = (size_t)HALF * K * 2;
    const size_t tstepA = 2 * hstepA, tstepB = 2 * hstepB;
    const unsigned ldsbase = (unsigned)(uintptr_t)lds + (unsigned)wid * 1024u;
    const int aoff = lds_byte(wr * 64 + fr, fq * 8), boff = lds_byte(wc * 32 + fr, fq * 8);
#define PG8_SA(b, h) (((b) * 2 + (h)) * HTB)
#define PG8_SB(b, h) ((4 + (b) * 2 + (h)) * HTB)
#define PG8_STAGE(bufoff, gbase, voff) do { _Pragma("unroll") for (int _i = 0; _i < 2; ++_i) \
        glds_s((const void*)(gbase), (voff)[_i], ldsbase + (unsigned)((bufoff) + _i * 8192)); } while (0)
#define PG8_LDA(dst, b, h) do { _Pragma("unroll") for (int m = 0; m < 4; ++m) _Pragma("unroll") for (int k = 0; k < 2; ++k) dst[m][k] = *(const LAS bf16x8*)(lds + PG8_SA(b, h) + aoff + m * 2048 + k * 1024); } while (0)
#define PG8_LDB(dst, b, h) do { _Pragma("unroll") for (int n = 0; n < 2; ++n) _Pragma("unroll") for (int k = 0; k < 2; ++k) dst[n][k] = *(const LAS bf16x8*)(lds + PG8_SB(b, h) + boff + n * 2048 + k * 1024); } while (0)
#define PG8_MMA(ai, bj, At, Bt) do { __builtin_amdgcn_s_setprio(1); _Pragma("unroll") for (int m = 0; m < 4; ++m) _Pragma("unroll") for (int n = 0; n < 2; ++n) _Pragma("unroll") for (int k = 0; k < 2; ++k) \
        acc[ai][bj][m][n] = __builtin_amdgcn_mfma_f32_16x16x32_bf16(Bt[n][k], At[m][k], acc[ai][bj][m][n], 0, 0, 0); __builtin_amdgcn_s_setprio(0); } while (0)
#define PG8_WAIT_V(n) asm volatile("s_waitcnt vmcnt(" #n ")" ::: "memory")
#define PG8_WAIT_L(n) asm volatile("s_waitcnt lgkmcnt(" #n ")" ::: "memory")
#define PG8_BAR __builtin_amdgcn_s_barrier()
#define PG8_SCHED __builtin_amdgcn_sched_barrier(0)
    Unit cur, nxt; int ui = 0;
    if (!S.next(0, cur)) return;
    f32x4 acc[2][2][4][2];
#pragma unroll
    for (int a = 0; a < 2; ++a)
#pragma unroll
        for (int b = 0; b < 2; ++b)
#pragma unroll
            for (int m = 0; m < 4; ++m)
#pragma unroll
                for (int n = 0; n < 2; ++n) acc[a][b][m][n] = (f32x4){0.f, 0.f, 0.f, 0.f};
    bf16x8 At[4][2], B0[2][2], B1[2][2];
    const char* cA = (const char*)g.A + (size_t)cur.pm * tstepA; const char* cB = (const char*)g.Bt + (size_t)cur.pn * tstepB;
    PG8_STAGE(PG8_SB(0, 0), cB, voffB); PG8_STAGE(PG8_SB(0, 1), cB + hstepB, voffB); PG8_STAGE(PG8_SA(0, 0), cA, voffA); PG8_STAGE(PG8_SA(0, 1), cA + hstepA, voffA);
    if (wr == 1) PG8_BAR;
    PG8_WAIT_V(2); PG8_BAR;
    PG8_STAGE(PG8_SB(1, 0), cB + kstep, voffB); PG8_STAGE(PG8_SA(1, 0), cA + kstep, voffA); PG8_STAGE(PG8_SB(1, 1), cB + hstepB + kstep, voffB);
    PG8_WAIT_V(6); PG8_BAR;
    for (;;) {
        const bool has_next = S.next(ui + 1, nxt);
        const char* nA = has_next ? (const char*)g.A + (size_t)nxt.pm * tstepA : cA; const char* nB = has_next ? (const char*)g.Bt + (size_t)nxt.pn * tstepB : cB;
        for (int t = 0; t < nt; t += 2) {
            const bool last = (t == nt - 2);
            const char* a1 = cA + (size_t)(t + 1) * kstep;
            const char* a2 = last ? nA : cA + (size_t)(t + 2) * kstep; const char* b2 = last ? nB : cB + (size_t)(t + 2) * kstep;
            const char* a3 = a2 + kstep; const char* b3 = b2 + kstep;
            PG8_LDB(B0, 0, 0); PG8_LDB(B1, 0, 1); PG8_SCHED; PG8_LDA(At, 0, 0); PG8_STAGE(PG8_SA(1, 1), a1 + hstepA, voffA);
            PG8_WAIT_V(8); PG8_WAIT_L(0); PG8_BAR; PG8_MMA(0, 0, At, B0); PG8_MMA(0, 1, At, B1); PG8_BAR; PG8_SCHED;
            PG8_LDA(At, 0, 1); PG8_STAGE(PG8_SB(0, 0), b2, voffB); PG8_STAGE(PG8_SB(0, 1), b2 + hstepB, voffB); PG8_STAGE(PG8_SA(0, 0), a2, voffA);
            PG8_WAIT_V(8); PG8_WAIT_L(0); PG8_BAR; PG8_MMA(1, 0, At, B0); PG8_MMA(1, 1, At, B1); PG8_BAR; PG8_SCHED;
            PG8_LDB(B0, 1, 0); PG8_LDB(B1, 1, 1); PG8_SCHED; PG8_LDA(At, 1, 0); PG8_STAGE(PG8_SA(0, 1), a2 + hstepA, voffA);
            PG8_WAIT_V(8); PG8_WAIT_L(0); PG8_BAR; PG8_MMA(0, 0, At, B0); PG8_MMA(0, 1, At, B1); PG8_BAR; PG8_SCHED;
            PG8_LDA(At, 1, 1); PG8_STAGE(PG8_SB(1, 0), b3, voffB); PG8_STAGE(PG8_SB(1, 1), b3 + hstepB, voffB); PG8_STAGE(PG8_SA(1, 0), a3, voffA);
            PG8_WAIT_V(8); PG8_WAIT_L(0); PG8_BAR; PG8_MMA(1, 0, At, B0); PG8_MMA(1, 1, At, B1); PG8_BAR; PG8_SCHED;
        }
        if (wr == 0) PG8_BAR;
        E(acc, cur, wr, wc, fr, fq);
        if (!has_next) break;
#pragma unroll
        for (int a = 0; a < 2; ++a)
#pragma unroll
            for (int b = 0; b < 2; ++b)
#pragma unroll
                for (int m = 0; m < 4; ++m)
#pragma unroll
                    for (int n = 0; n < 2; ++n) acc[a][b][m][n] = (f32x4){0.f, 0.f, 0.f, 0.f};
        cur = nxt; cA = nA; cB = nB; ++ui;
        if (wr == 1) PG8_BAR;
    }
    PG8_WAIT_V(0);
    PG8_BAR;
#undef PG8_SA
#undef PG8_SB
#undef PG8_STAGE
#undef PG8_LDA
#undef PG8_LDB
#undef PG8_MMA
#undef PG8_WAIT_V
#undef PG8_WAIT_L
#undef PG8_BAR
#undef PG8_SCHED
}

struct EpiSwiGLU {
    bf16_t* H;
    __device__ __forceinline__ void operator()(const f32x4 (&acc)[2][2][4][2], const Unit& u, int wr, int wc, int fr, int fq) const {
        const int row0 = u.pm * BM + wr * 64 + fr, col0 = u.pn * HALF + wc * 32 + 8 * fq;
#pragma unroll
        for (int ai = 0; ai < 2; ++ai)
#pragma unroll
            for (int m = 0; m < 4; ++m) {
                float o[8];
#pragma unroll
                for (int n = 0; n < 2; ++n)
#pragma unroll
                    for (int e = 0; e < 4; ++e) { const float gv = acc[ai][0][m][n][e], uv = acc[ai][1][m][n][e]; o[n * 4 + e] = gv * sigmoidf_(gv) * uv; }
                u32x4 w; w.x = cvt_pk_bf16(o[0], o[1]); w.y = cvt_pk_bf16(o[2], o[3]); w.z = cvt_pk_bf16(o[4], o[5]); w.w = cvt_pk_bf16(o[6], o[7]);
                *(u32x4*)(H + (size_t)(row0 + ai * HALF + m * 16) * DFF + col0) = w;
                asm volatile("" ::: "memory");
            }
    }
};
struct EpiProj {
    bf16_t *Qsb, *KVsb, *Qda, *KVda, *Gt; unsigned* kmax2;
    __device__ __forceinline__ void operator()(const f32x4 (&acc)[2][2][4][2], const Unit& u, int wr, int wc, int fr, int fq) const {
        const int row0 = u.pm * BM + wr * 64 + fr; const int cbase = u.pn * BM; const bool sg = (cbase >= 3072); const bool kdt = (cbase == 2048 || cbase == 2304);
        float mxk[2] = {0.f, 0.f};
#pragma unroll
        for (int ai = 0; ai < 2; ++ai)
#pragma unroll
            for (int m = 0; m < 4; ++m) { const int row = row0 + ai * HALF + m * 16; const int b = row >> 13, t = row & (SEQ - 1);
#pragma unroll
                for (int bj = 0; bj < 2; ++bj) { f32x4 v0 = acc[ai][bj][m][0], v1 = acc[ai][bj][m][1];
                    const int c = cbase + bj * HALF + wc * 32 + 8 * fq;
                    bf16_t* dst;
                    if (cbase < 1536) { const int sec = c >> 9, cc = c & 511, h = cc >> 6, wv = cc & 63; const size_t ri = (size_t)(b * 8 + h) * SEQ + t;
                        dst = (sec == 0) ? Qsb + ri * 64 + wv : KVsb + ri * 128 + (sec == 2 ? 64 : 0) + wv; }
                    else if (cbase < 3072) { const int c2 = c - 1536, sec = c2 >> 9, cc = c2 & 511, h = cc >> 7, wv = cc & 127; const size_t ri = (size_t)(b * 4 + h) * SEQ + t;
                        dst = (sec == 0) ? Qda + ri * 128 + wv : KVda + ri * 256 + (sec == 2 ? 128 : 0) + wv; }
                    else dst = Gt + (size_t)row * 2048 + (c - 3072);
                    if (sg) {
#pragma unroll
                        for (int e = 0; e < 4; ++e) { v0[e] = sigmoidf_(v0[e]); v1[e] = sigmoidf_(v1[e]); } }
                    u32x4 w; w.x = cvt_pk_bf16(v0[0], v0[1]); w.y = cvt_pk_bf16(v0[2], v0[3]); w.z = cvt_pk_bf16(v1[0], v1[1]); w.w = cvt_pk_bf16(v1[2], v1[3]);
                    *(u32x4*)dst = w;
                    if (kdt) { float sq = (bf_lo(w.x) * bf_lo(w.x) + bf_hi(w.x) * bf_hi(w.x)) + (bf_lo(w.y) * bf_lo(w.y) + bf_hi(w.y) * bf_hi(w.y)) + (bf_lo(w.z) * bf_lo(w.z) + bf_hi(w.z) * bf_hi(w.z)) + (bf_lo(w.w) * bf_lo(w.w) + bf_hi(w.w) * bf_hi(w.w));
                        sq += __shfl_xor(sq, 16); sq += __shfl_xor(sq, 32); mxk[bj] = fmaxf(mxk[bj], sq); } }
                asm volatile("" ::: "memory"); }
        if (kdt) {
#pragma unroll
            for (int bj = 0; bj < 2; ++bj) { float v = mxk[bj];
#pragma unroll
                for (int o = 1; o < 16; o <<= 1) v = fmaxf(v, __shfl_xor(v, o));
                const int b = (u.pm * BM) >> 13, h = ((cbase - 2048) >> 7) + bj, idx = ((b * 4 + h) * 2 + (wc >> 1)) * 2 + (wc & 1);
                if ((threadIdx.x & 63) == 0) atomicMax(kmax2 + idx, __float_as_uint(v)); }
        }
    }
};
struct EpiY {
    bf16_t* Y; float* SS;
    __device__ __forceinline__ void operator()(const f32x4 (&acc)[2][2][4][2], const Unit& u, int wr, int wc, int fr, int fq) const {
        const int row0 = u.pm * BM + wr * 64 + fr, col0 = u.pn * BM + wc * 32 + 8 * fq;
#pragma unroll
        for (int ai = 0; ai < 2; ++ai)
#pragma unroll
            for (int m = 0; m < 4; ++m) { const int row = row0 + ai * HALF + m * 16; bf16_t* rowp = Y + (size_t)row * DM + col0; float s = 0.f;
#pragma unroll
                for (int bj = 0; bj < 2; ++bj) { const f32x4 v0 = acc[ai][bj][m][0], v1 = acc[ai][bj][m][1];
                    s += (v0[0] * v0[0] + v0[1] * v0[1]) + (v0[2] * v0[2] + v0[3] * v0[3]) + (v1[0] * v1[0] + v1[1] * v1[1]) + (v1[2] * v1[2] + v1[3] * v1[3]);
                    u32x4 w; w.x = cvt_pk_bf16(v0[0], v0[1]); w.y = cvt_pk_bf16(v0[2], v0[3]); w.z = cvt_pk_bf16(v1[0], v1[1]); w.w = cvt_pk_bf16(v1[2], v1[3]);
                    *(u32x4*)(rowp + bj * HALF) = w; }
                s += __shfl_xor(s, 16); s += __shfl_xor(s, 32);
                if (fq == 0) SS[(size_t)row * 16 + u.pn * 4 + wc] = s;
                asm volatile("" ::: "memory"); }
    }
};
template <bool FIRST> struct EpiGate {
    static constexpr bool PANEL = false;
    bf16_t* Mg; const bf16_t* Gt; int gcol;
    __device__ __forceinline__ void operator()(const f32x4 (&acc)[2][2][4][2], const Unit& u, int wr, int wc, int fr, int fq) const {
        const int row0 = u.pm * BM + wr * 64 + fr, col0 = u.pn * BM + wc * 32 + 8 * fq;
#pragma unroll
        for (int ai = 0; ai < 2; ++ai) {
            u32x4 sg[4][2], tt[4][2];
#pragma unroll
            for (int m = 0; m < 4; ++m)
#pragma unroll
                for (int bj = 0; bj < 2; ++bj) { const size_t row = (size_t)(row0 + ai * HALF + m * 16);
                    sg[m][bj] = *(const u32x4*)(Gt + row * 2048 + gcol + col0 + bj * HALF);
                    if (!FIRST) tt[m][bj] = *(const u32x4*)(Mg + row * DM + col0 + bj * HALF); }
#pragma unroll
            for (int m = 0; m < 4; ++m)
#pragma unroll
                for (int bj = 0; bj < 2; ++bj) { const size_t row = (size_t)(row0 + ai * HALF + m * 16);
                    const f32x4 v0 = acc[ai][bj][m][0], v1 = acc[ai][bj][m][1]; const u32x4 sgv = sg[m][bj];
                    float o[8];
                    o[0] = bf_lo(sgv.x) * v0[0]; o[1] = bf_hi(sgv.x) * v0[1]; o[2] = bf_lo(sgv.y) * v0[2]; o[3] = bf_hi(sgv.y) * v0[3];
                    o[4] = bf_lo(sgv.z) * v1[0]; o[5] = bf_hi(sgv.z) * v1[1]; o[6] = bf_lo(sgv.w) * v1[2]; o[7] = bf_hi(sgv.w) * v1[3];
                    if (!FIRST) { const u32x4 t = tt[m][bj];
                        o[0] += bf_lo(t.x); o[1] += bf_hi(t.x); o[2] += bf_lo(t.y); o[3] += bf_hi(t.y); o[4] += bf_lo(t.z); o[5] += bf_hi(t.z); o[6] += bf_lo(t.w); o[7] += bf_hi(t.w); }
                    u32x4 w; w.x = cvt_pk_bf16(o[0], o[1]); w.y = cvt_pk_bf16(o[2], o[3]); w.z = cvt_pk_bf16(o[4], o[5]); w.w = cvt_pk_bf16(o[6], o[7]);
                    *(u32x4*)(Mg + row * DM + col0 + bj * HALF) = w; }
            asm volatile("" ::: "memory");
        }
    }
};
}

namespace att {
__device__ __forceinline__ int crow(int r, int hi) { return (r & 3) + 8 * (r >> 2) + 4 * hi; }

#define DS_RD128(dst, addr, imm) asm volatile("ds_read_b128 %0, %1 offset:%c2" : "=&v"(dst) : "v"(addr), "i"(imm) : "memory")
#define DS_RDTR(dst, addr, imm) asm volatile("ds_read_b64_tr_b16 %0, %1 offset:%c2" : "=&v"(dst) : "v"(addr), "i"(imm) : "memory")
constexpr int DA_KB = 0, DA_VB = 32768, DA_Q = 65536, DA_QP = 272, DA_QBUF = 32 * DA_QP, DA_TOTAL = DA_Q + 8 * DA_QBUF;
typedef short v4i16_t __attribute__((ext_vector_type(4)));
__device__ __forceinline__ s16x4 vtr(const LAS unsigned char* p) { return __builtin_bit_cast(s16x4, __builtin_amdgcn_ds_read_tr16_b64_v4i16((LAS v4i16_t*)p)); }
__device__ __forceinline__ float max3f(float a, float b, float c) { return fmaxf(fmaxf(a, b), c); }

__device__ __forceinline__ void da_unit(LAS unsigned char* lds, const bf16_t* Qp  , const bf16_t* KVp  , bf16_t* Op  , int qb, float lam, const float* subln, float slope, const unsigned* kmax2  ) {
    int tid_ = threadIdx.x; asm volatile("" : "+v"(tid_));
    const int tid = tid_, lane = tid & 63, q = lane & 31, hi = lane >> 5; const int w = __builtin_amdgcn_readfirstlane(tid >> 6);
    LAS unsigned char* Qw = lds + DA_Q + w * DA_QBUF;
    const unsigned ldsb = (unsigned)(uintptr_t)lds;
    unsigned voff[2];
#pragma unroll
    for (int i = 0; i < 2; ++i) { const int row = 8 * w + 4 * i + (lane >> 4); const int f = ((row & 3) << 2) | ((row >> 2) & 3); voff[i] = (unsigned)(row * 512 + 16 * ((lane & 15) ^ f)); }
    const char* const Pb = (const char*)KVp;
#define DA_DMA(kt, buf) do { const char* tb_ = Pb + (size_t)(kt) * (64 * 512); \
        _Pragma("unroll") for (int i_ = 0; i_ < 2; ++i_) { glds_s(tb_, voff[i_], ldsb + (unsigned)(DA_KB + (buf) * 16384 + (2 * w + i_) * 1024)); \
            glds_s(tb_ + 256, voff[i_], ldsb + (unsigned)(DA_VB + (buf) * 16384 + (2 * w + i_) * 1024)); } } while (0)
    const int nt = 4 * (qb + 1);
    DA_DMA(nt - 1, 0);
    {
        const float c1 = 0.125f * LOG2E;
#pragma unroll
        for (int i = 0; i < 8; ++i) { const int cid = lane + 64 * i, r = cid >> 4, ch = cid & 15;
            u32x4 v = *(const u32x4*)(Qp + (size_t)(qb * 256 + w * 32 + r) * 128 + 8 * ch);
            v.x = cvt_pk_bf16(bf_lo(v.x) * c1, bf_hi(v.x) * c1); v.y = cvt_pk_bf16(bf_lo(v.y) * c1, bf_hi(v.y) * c1);
            v.z = cvt_pk_bf16(bf_lo(v.z) * c1, bf_hi(v.z) * c1); v.w = cvt_pk_bf16(bf_lo(v.w) * c1, bf_hi(v.w) * c1);
            *(LAS u32x4*)(Qw + r * DA_QP + 16 * ch) = v; }
    }
    f32x16 o1[4], o2[4];
#pragma unroll
    for (int d = 0; d < 4; ++d) { o1[d] = (f32x16){}; o2[d] = (f32x16){}; }
    float m1 = -INFINITY, m2 = -INFINITY, l1 = 0.f, l2 = 0.f;
    const int tpos = qb * 256 + w * 32 + q;
    const float c2 = slope * LOG2E;
    const int F16 = 16 * (((q & 3) << 2) | ((q >> 2) & 3));
    const int kq = 256 * q;
    const int qq = (lane & 15) >> 2, g1 = (lane >> 4) & 1, pp = lane & 3;
    const int A0 = 256 * (4 * hi + qq) + 8 * (pp & 1);
    const int vbase0 = A0 + 16 * ((2 * g1 + (pp >> 1)) ^ hi), vbase1 = A0 + 2048 + 16 * ((2 * g1 + (pp >> 1)) ^ (hi + 2));
    asm volatile("s_waitcnt vmcnt(0)" ::: "memory");
    __syncthreads();
    float qb_[2];
#pragma unroll
    for (int mp = 0; mp < 2; ++mp) { float sq = 0.f;
#pragma unroll
        for (int d0 = 0; d0 < 4; ++d0) { const u32x4 f = *(const LAS u32x4*)(Qw + q * DA_QP + (64 * mp + 16 * d0 + 8 * hi) * 2);
            sq += (bf_lo(f.x) * bf_lo(f.x) + bf_hi(f.x) * bf_hi(f.x)) + (bf_lo(f.y) * bf_lo(f.y) + bf_hi(f.y) * bf_hi(f.y)) + (bf_lo(f.z) * bf_lo(f.z) + bf_hi(f.z) * bf_hi(f.z)) + (bf_lo(f.w) * bf_lo(f.w) + bf_hi(f.w) * bf_hi(f.w)); }
        sq += __shfl_xor(sq, 32);
        const float k2 = __uint_as_float(kmax2[2 * mp]) + __uint_as_float(kmax2[2 * mp + 1]);
        qb_[mp] = sqrtf(sq) * sqrtf(k2) * 1.001f + 0.01f; }
    const unsigned FH = (unsigned)(F16 ^ (16 * hi));
    const unsigned qaddr = (unsigned)(uintptr_t)Qw + (unsigned)(q * DA_QP + 16 * hi);
    const unsigned xq = 64u * (unsigned)qq;
#define DA_ISSUE_KQ(mp, kh) do { _Pragma("unroll") for (int d0_ = 0; d0_ < 4; ++d0_) { const unsigned ka_ = kcur + ((unsigned)(128 * (mp) + 32 * d0_) ^ FH); \
        DS_RD128(kf[d0_], ka_, 8192 * (kh)); DS_RD128(qf[d0_], qaddr, 128 * (mp) + 32 * d0_); } } while (0)
    for (int it = 0; it < nt; ++it) {
        const int kt = nt - 1 - it, cur = it & 1;
        if (kt > 0) DA_DMA(kt - 1, cur ^ 1);
        if ((kt - 4 * qb) <= (w >> 1)) {
            const bool band = kt >= 4 * qb;
            const unsigned kcur = ldsb + (unsigned)(DA_KB + cur * 16384 + kq);
            const unsigned vcur = ldsb + (unsigned)(DA_VB + cur * 16384);
#pragma unroll
            for (int kh = 1; kh >= 0; --kh) {
                f32x16 s[2];
#pragma unroll
                for (int mp = 0; mp < 2; ++mp) {
                    bf16x8 kf[4], qf[4];
                    DA_ISSUE_KQ(mp, kh);
                    asm volatile("s_waitcnt lgkmcnt(0)" : "+v"(kf[0]), "+v"(kf[1]), "+v"(kf[2]), "+v"(kf[3]), "+v"(qf[0]), "+v"(qf[1]), "+v"(qf[2]), "+v"(qf[3]) :: "memory");
                    s[mp] = (f32x16){};
#pragma unroll
                    for (int d0 = 0; d0 < 4; ++d0) s[mp] = __builtin_amdgcn_mfma_f32_32x32x16_bf16(kf[d0], qf[d0], s[mp], 0, 0, 0);
                }
                float off, mx[2]; bool doit[2];
                if (band) off = 0.f; else off = c2 * (float)(kt * 64 + 32 * kh + 4 * hi - tpos);
#pragma unroll
                for (int mp = 0; mp < 2; ++mp) {
                    if (band) { const float dbase = (float)(tpos - kt * 64 - 32 * kh - 4 * hi);
#pragma unroll
                        for (int r = 0; r < 16; ++r) s[mp][r] = s[mp][r] - c2 * fabsf(dbase - (float)crow(r, 0));
                    } else {
#pragma unroll
                        for (int r = 0; r < 16; ++r) s[mp][r] = fmaf(c2, (float)crow(r, 0), s[mp][r]);
                    }
                    float m_ = max3f(s[mp][0], s[mp][1], s[mp][2]);
#pragma unroll
                    for (int r = 3; r < 15; r += 2) m_ = max3f(m_, s[mp][r], s[mp][r + 1]);
                    m_ = fmaxf(m_, s[mp][15]) + off;
                    { auto rr = __builtin_amdgcn_permlane32_swap(__float_as_uint(m_), __float_as_uint(m_), false, false); m_ = fmaxf(__uint_as_float(rr[0]), __uint_as_float(rr[1])); }
                    mx[mp] = m_;
                    doit[mp] = !__all(m_ - (mp ? m2 : m1) < -160.0f);
                }
                if (doit[0] || doit[1]) {
                    s16x4 va_lo[4], va_hi[4], vb_lo[4], vb_hi[4];
#define DA_ISSUE_V(lo_, hi_, dbase_) do { _Pragma("unroll") for (int d_ = 0; d_ < 2; ++d_) { const unsigned xd_ = vcur + ((unsigned)(64 * ((dbase_) + d_)) ^ xq); const unsigned a0_ = xd_ + (unsigned)vbase0, a1_ = xd_ + (unsigned)vbase1; \
                        _Pragma("unroll") for (int j_ = 0; j_ < 2; ++j_) { DS_RDTR(lo_[2 * d_ + j_], a0_, 8192 * kh + 4096 * j_); DS_RDTR(hi_[2 * d_ + j_], a1_, 8192 * kh + 4096 * j_); } } } while (0)
                    DA_ISSUE_V(va_lo, va_hi, 0);
                    bf16x8 pk[2][2];
#pragma unroll
                    for (int mp = 0; mp < 2; ++mp) {
                        float& mref = mp ? m2 : m1; float& lref = mp ? l2 : l1;
                        if (doit[mp]) {
                            const float mnew = fmaxf(mref, mx[mp]);
                            if (__any(mnew > mref)) { const float alpha = fast_exp2(mref - mnew); lref *= alpha;
#pragma unroll
                                for (int d = 0; d < 4; ++d) { if (mp) o2[d] *= alpha; else o1[d] *= alpha; }
                                mref = mnew; }
                            const float dd = off - mnew;
                            s[mp] = s[mp] + dd;
#pragma unroll
                            for (int r = 0; r < 16; ++r) s[mp][r] = fast_exp2(s[mp][r]);
                            { typedef float f32x8 __attribute__((ext_vector_type(8))); typedef float f32x2v __attribute__((ext_vector_type(2)));
                              const f32x8 h8 = __builtin_shufflevector(s[mp], s[mp], 0, 1, 2, 3, 4, 5, 6, 7) + __builtin_shufflevector(s[mp], s[mp], 8, 9, 10, 11, 12, 13, 14, 15);
                              const f32x4 h4 = __builtin_shufflevector(h8, h8, 0, 1, 2, 3) + __builtin_shufflevector(h8, h8, 4, 5, 6, 7);
                              const f32x2v h2 = __builtin_shufflevector(h4, h4, 0, 1) + __builtin_shufflevector(h4, h4, 2, 3);
                              lref += h2[0] + h2[1]; }
#pragma unroll
                            for (int j = 0; j < 2; ++j) { u32x4 pw; pw.x = cvt_pk_bf16(s[mp][8 * j + 0], s[mp][8 * j + 1]); pw.y = cvt_pk_bf16(s[mp][8 * j + 2], s[mp][8 * j + 3]);
                                pw.z = cvt_pk_bf16(s[mp][8 * j + 4], s[mp][8 * j + 5]); pw.w = cvt_pk_bf16(s[mp][8 * j + 6], s[mp][8 * j + 7]);
                                pk[mp][j] = __builtin_bit_cast(bf16x8, pw); }
                        } else { pk[mp][0] = (bf16x8){}; pk[mp][1] = (bf16x8){}; }
                    }
                    DA_ISSUE_V(vb_lo, vb_hi, 2);
                    asm volatile("s_waitcnt lgkmcnt(8)" : "+v"(va_lo[0]), "+v"(va_lo[1]), "+v"(va_lo[2]), "+v"(va_lo[3]), "+v"(va_hi[0]), "+v"(va_hi[1]), "+v"(va_hi[2]), "+v"(va_hi[3]) :: "memory");
#pragma unroll
                    for (int d = 0; d < 2; ++d)
#pragma unroll
                        for (int j = 0; j < 2; ++j) { const s16x4 lo = va_lo[2 * d + j], hh = va_hi[2 * d + j];
                            const bf16x8 vf = (bf16x8){lo[0], lo[1], lo[2], lo[3], hh[0], hh[1], hh[2], hh[3]};
                            o1[d] = __builtin_amdgcn_mfma_f32_32x32x16_bf16(vf, pk[0][j], o1[d], 0, 0, 0);
                            o2[d] = __builtin_amdgcn_mfma_f32_32x32x16_bf16(vf, pk[1][j], o2[d], 0, 0, 0); }
                    asm volatile("s_waitcnt lgkmcnt(0)" : "+v"(vb_lo[0]), "+v"(vb_lo[1]), "+v"(vb_lo[2]), "+v"(vb_lo[3]), "+v"(vb_hi[0]), "+v"(vb_hi[1]), "+v"(vb_hi[2]), "+v"(vb_hi[3]) :: "memory");
#pragma unroll
                    for (int d = 0; d < 2; ++d)
#pragma unroll
                        for (int j = 0; j < 2; ++j) { const s16x4 lo = vb_lo[2 * d + j], hh = vb_hi[2 * d + j];
                            const bf16x8 vf = (bf16x8){lo[0], lo[1], lo[2], lo[3], hh[0], hh[1], hh[2], hh[3]};
                            o1[2 + d] = __builtin_amdgcn_mfma_f32_32x32x16_bf16(vf, pk[0][j], o1[2 + d], 0, 0, 0);
                            o2[2 + d] = __builtin_amdgcn_mfma_f32_32x32x16_bf16(vf, pk[1][j], o2[2 + d], 0, 0, 0); }
#undef DA_ISSUE_V
                }
                __builtin_amdgcn_sched_barrier(0);
            }
        }
        asm volatile("s_waitcnt vmcnt(0)" ::: "memory");
        bool okw = false;
        if (kt >= 1 && kt - 1 < 4 * qb) { const float bias = -c2 * (float)(tpos - (64 * (kt - 1) + 63));
            okw = __all((qb_[0] + bias - m1 < -160.0f) && (qb_[1] + bias - m2 < -160.0f)); }
        if (__syncthreads_and(okw ? 1 : 0)) break;
    }
#undef DA_ISSUE_KQ
#undef DA_DMA
    bf16_t* orow = Op + (size_t)(qb * 256 + w * 32 + q) * 512;
    l1 += __shfl_xor(l1, 32); l2 += __shfl_xor(l2, 32);
    const float i1 = 1.0f / l1, i2 = lam / l2; float ss = 0.f;
#pragma unroll
    for (int d = 0; d < 4; ++d)
#pragma unroll
        for (int r = 0; r < 16; ++r) { const float v = o1[d][r] * i1 - o2[d][r] * i2; o1[d][r] = v; ss += v * v; }
    ss += __shfl_xor(ss, 32);
    const float rs = (1.0f / sqrtf(ss * (1.0f / 128.0f) + EPS)) * (1.0f - LAMBDA_INIT);
#pragma unroll
    for (int d = 0; d < 4; ++d)
#pragma unroll
        for (int gq = 0; gq < 4; ++gq) { const int dd = 32 * d + 8 * gq + 4 * hi; const f32x4 sl = *(const f32x4*)(subln + dd);
            u32x2 wv; wv.x = cvt_pk_bf16(o1[d][4 * gq] * rs * sl[0], o1[d][4 * gq + 1] * rs * sl[1]); wv.y = cvt_pk_bf16(o1[d][4 * gq + 2] * rs * sl[2], o1[d][4 * gq + 3] * rs * sl[3]);
            *(u32x2*)(orow + dd) = wv; }
}

__device__ __forceinline__ void sb_unit(LAS unsigned char* lds, const bf16_t* Qp  , const bf16_t* KVp  , bf16_t* Op  , int qb) {
    int tid_ = threadIdx.x; asm volatile("" : "+v"(tid_));
    const int tid = tid_, lane = tid & 63, q = lane & 31, hi = lane >> 5; const int w = __builtin_amdgcn_readfirstlane(tid >> 6);
    const int t0 = qb * 256 + w * 32, tpos = t0 + q;
    const unsigned vbuf = (unsigned)(uintptr_t)lds + (unsigned)w * 16384u;
    bf16x8 qf[4];
#pragma unroll
    for (int d0 = 0; d0 < 4; ++d0) { u32x4 v = *(const u32x4*)(Qp + (size_t)tpos * 64 + 16 * d0 + 8 * hi);
        v.x = cvt_pk_bf16(bf_lo(v.x) * 0.125f, bf_hi(v.x) * 0.125f); v.y = cvt_pk_bf16(bf_lo(v.y) * 0.125f, bf_hi(v.y) * 0.125f);
        v.z = cvt_pk_bf16(bf_lo(v.z) * 0.125f, bf_hi(v.z) * 0.125f); v.w = cvt_pk_bf16(bf_lo(v.w) * 0.125f, bf_hi(v.w) * 0.125f);
        qf[d0] = __builtin_bit_cast(bf16x8, v); }
    const unsigned voffV = (unsigned)((lane >> 3) * 256 + 16 * ((lane & 7) ^ (lane >> 3)));
    const unsigned voffK = (unsigned)(q * 256 + 16 * hi);
    const char* const Pb = (const char*)KVp;
#define SB_DMA_V(kt, buf) do { const char* tb_ = Pb + (size_t)(kt) * (64 * 256) + 128; \
        _Pragma("unroll") for (int I_ = 0; I_ < 8; ++I_) glds_s(tb_ + 2048 * I_, voffV, vbuf + (unsigned)((buf) * 8192 + 1024 * I_)); } while (0)
#define SB_LOAD_K(dst, kt) do { const char* tb_ = Pb + (size_t)(kt) * (64 * 256); \
        _Pragma("unroll") for (int kh_ = 0; kh_ < 2; ++kh_) _Pragma("unroll") for (int d0_ = 0; d0_ < 4; ++d0_) dst[kh_ * 4 + d0_] = *(const u32x4*)(tb_ + voffK + 8192 * kh_ + 32 * d0_); } while (0)
    const int kt_first = t0 >> 6;
    int kt = kt_first, buf = 0;
    u32x4 kf[8], kfn[8];
    SB_LOAD_K(kf, kt); SB_DMA_V(kt, 0);
#pragma unroll
    for (int i = 0; i < 8; ++i) kfn[i] = kf[i];
    f32x16 o[2]; o[0] = (f32x16){}; o[1] = (f32x16){};
    float carry = 0.f;
    const int qq = (lane & 15) >> 2, g1 = (lane >> 4) & 1, pp = lane & 3;
    const unsigned vb = (unsigned)(128 * (4 * hi + qq) + 16 * ((2 * g1 + (pp >> 1)) ^ qq) + 8 * (pp & 1));
    const unsigned vb0 = vb + 64u * (unsigned)hi, vb1 = vb + 64u - 64u * (unsigned)hi;
    for (;;) {
        asm volatile("s_waitcnt vmcnt(0)" ::: "memory");
        if (kt > 0) { SB_LOAD_K(kfn, kt - 1); SB_DMA_V(kt - 1, buf ^ 1); }
        const unsigned vcur = vbuf + (unsigned)(buf * 8192);
#pragma unroll
        for (int kh = 1; kh >= 0; --kh) {
            if (kh == 1 && kt == kt_first && !(t0 & 32)) continue;
            f32x16 s = (f32x16){};
#pragma unroll
            for (int d0 = 0; d0 < 4; ++d0) s = __builtin_amdgcn_mfma_f32_32x32x16_bf16(__builtin_bit_cast(bf16x8, kf[kh * 4 + d0]), qf[d0], s, 0, 0, 0);
            s16x4 vlo[4], vhi[4];
#pragma unroll
            for (int d = 0; d < 2; ++d) { const unsigned a_ = vcur + (d ? vb1 : vb0);
#pragma unroll
                for (int j = 0; j < 2; ++j) { DS_RDTR(vlo[2 * d + j], a_, 4096 * kh + 2048 * j); DS_RDTR(vhi[2 * d + j], a_, 4096 * kh + 2048 * j + 1024); } }
            float sp[16];
#pragma unroll
            for (int r = 0; r < 16; ++r) { const float z = s[r]; const bool valid = (kt * 64 + 32 * kh + crow(r, hi)) < tpos;
                const float a = fabsf(z); const float e = fast_exp2(-a * LOG2E); const float spv = fmaxf(z, 0.f) + fast_log2(1.0f + e) * LN2; sp[r] = valid ? spv : 0.f; }
            float G[4], Gp[4], Gs[4];
#pragma unroll
            for (int i = 0; i < 4; ++i) { G[i] = (sp[4 * i] + sp[4 * i + 1]) + (sp[4 * i + 2] + sp[4 * i + 3]);
                auto rr = __builtin_amdgcn_permlane32_swap(__float_as_uint(G[i]), __float_as_uint(G[i]), false, false);
                Gp[i] = __uint_as_float(hi ? rr[0] : rr[1]); Gs[i] = __uint_as_float(rr[0]) + __uint_as_float(rr[1]); }
            float after = 0.f;
#pragma unroll
            for (int i = 3; i >= 0; --i) { float run = carry + after + (hi == 0 ? Gp[i] : 0.f);
#pragma unroll
                for (int j = 3; j >= 0; --j) { const int r = 4 * i + j; run += sp[r]; const bool valid = (kt * 64 + 32 * kh + crow(r, hi)) < tpos;
                    const float wv = fast_exp2((s[r] - run) * LOG2E); s[r] = valid ? wv : 0.f; }
                after += Gs[i]; }
            carry += after;
            bf16x8 pk[2];
#pragma unroll
            for (int j = 0; j < 2; ++j) { u32x4 pw; pw.x = cvt_pk_bf16(s[8 * j + 0], s[8 * j + 1]); pw.y = cvt_pk_bf16(s[8 * j + 2], s[8 * j + 3]);
                pw.z = cvt_pk_bf16(s[8 * j + 4], s[8 * j + 5]); pw.w = cvt_pk_bf16(s[8 * j + 6], s[8 * j + 7]);
                pk[j] = __builtin_bit_cast(bf16x8, pw); }
            asm volatile("s_waitcnt lgkmcnt(0)" : "+v"(vlo[0]), "+v"(vlo[1]), "+v"(vlo[2]), "+v"(vlo[3]), "+v"(vhi[0]), "+v"(vhi[1]), "+v"(vhi[2]), "+v"(vhi[3]) :: "memory");
#pragma unroll
            for (int d = 0; d < 2; ++d)
#pragma unroll
                for (int j = 0; j < 2; ++j) { const s16x4 lo = vlo[2 * d + j], hh = vhi[2 * d + j];
                    const bf16x8 vf = (bf16x8){lo[0], lo[1], lo[2], lo[3], hh[0], hh[1], hh[2], hh[3]};
                    o[d] = __builtin_amdgcn_mfma_f32_32x32x16_bf16(vf, pk[j], o[d], 0, 0, 0); }
        }
        if (kt == 0 || __all(carry > 110.0f)) break;
#pragma unroll
        for (int i = 0; i < 8; ++i) kf[i] = kfn[i];
        --kt; buf ^= 1;
    }
    asm volatile("s_waitcnt vmcnt(0)" ::: "memory");
#undef SB_DMA_V
#undef SB_LOAD_K
    bf16_t* orow = Op + (size_t)tpos * 512;
#pragma unroll
    for (int d = 0; d < 2; ++d)
#pragma unroll
        for (int gq = 0; gq < 4; ++gq) { const int dd = 32 * d + 8 * gq + 4 * hi;
            u32x2 wv; wv.x = cvt_pk_bf16(o[d][4 * gq], o[d][4 * gq + 1]); wv.y = cvt_pk_bf16(o[d][4 * gq + 2], o[d][4 * gq + 3]);
            *(u32x2*)(orow + dd) = wv; }
}
}

constexpr int NWAVES = 8, NTHREADS = 512;
constexpr int LDS_BYTES = 143360;
static_assert(att::DA_TOTAL <= LDS_BYTES - 64 && pg8::STAGE_BYTES <= LDS_BYTES - 64, "LDS map");

__device__ __forceinline__ void p0_transpose_item(const float* W, int K, int N, bf16_t* WT, int il  , LAS float* scr, int item, int lane) {
    const int nblk = N / 32, kb = item / nblk, nb = item % nblk, k0 = 64 * kb, n0 = 32 * nb;
    f32x4 v[8];
#pragma unroll
    for (int i = 0; i < 8; ++i) v[i] = *(const f32x4*)(W + (size_t)(k0 + 8 * i + (lane >> 3)) * N + n0 + 4 * (lane & 7));
#pragma unroll
    for (int i = 0; i < 8; ++i) { LAS float* d = scr + (8 * i + (lane >> 3)) * 33 + 4 * (lane & 7); d[0] = v[i][0]; d[1] = v[i][1]; d[2] = v[i][2]; d[3] = v[i][3]; }
    asm volatile("s_waitcnt lgkmcnt(0)" ::: "memory");
    const int c = lane & 7;
    const int rbase = il ? (256 * (n0 / 128) + 128 * (il - 1) + (n0 % 128)) : n0;
#pragma unroll
    for (int j = 0; j < 4; ++j) { const int n = (lane >> 3) + 8 * j; const LAS float* s = scr + (8 * c) * 33 + n;
        u32x4 o; o.x = cvt_pk_bf16(s[0 * 33], s[1 * 33]); o.y = cvt_pk_bf16(s[2 * 33], s[3 * 33]); o.z = cvt_pk_bf16(s[4 * 33], s[5 * 33]); o.w = cvt_pk_bf16(s[6 * 33], s[7 * 33]);
        *(u32x4*)(WT + (size_t)(rbase + n) * K + k0 + 8 * c) = o; }
    asm volatile("s_waitcnt lgkmcnt(0)" ::: "memory");
}

#ifndef PROBE_MASK
#define PROBE_MASK 0
#endif
#define TSTART() unsigned long long t0_ = (PROBE_MASK != 0) ? __builtin_amdgcn_s_memrealtime() : 0ull
#define TEND(k) do { if (PROBE_MASK & (1 << (k))) { const unsigned long long t1_ = __builtin_amdgcn_s_memrealtime(); const unsigned long long dt_ = t1_ - t0_; while (__builtin_amdgcn_s_memrealtime() - t1_ < dt_) __builtin_amdgcn_s_sleep(8); } if (PROBE_MASK != 0) t0_ = __builtin_amdgcn_s_memrealtime(); } while (0)
struct Args { const float* in[21]; float* out; float* modp; float* SS; bf16_t* Wgu[2]; bf16_t* Wd[2]; bf16_t* Win; bf16_t* Wsb; bf16_t* Wda; bf16_t* Wout; bf16_t* U; bf16_t* Y; bf16_t* BIG; bf16_t* Qsb; bf16_t* KVsb; bf16_t* Qda; bf16_t* KVda; bf16_t* Gt; bf16_t* ya; bf16_t* yd; unsigned* ctr; unsigned* kmax2; unsigned* bar; bf16_t* Mg; bf16_t* Y2; bf16_t* Y3; };

template <bool HAS_Y, bool HAS_NEXT, bool HIN_BF16, bool HOUT_BF16>
__device__ __forceinline__ void rowwise_phase(LAS unsigned char* lds, int vcu, int G, const void* hin_, void* hout_, const bf16_t* Y, const float* SS,
                                              const float* modp, const float* npost, const float* npre, int isub, float rw, bf16_t* U) {
    int tid_ = threadIdx.x; asm volatile("" : "+v"(tid_));
    const int tid = tid_, lane = tid & 63, wave = __builtin_amdgcn_readfirstlane(tid >> 6);
    LAS float* vA = (LAS float*)lds; LAS float* vB = vA + 1024; LAS float* vC = vB + 1024;
    for (int rb = vcu; rb < MT / 256; rb += G) {
        const int b = rb >> 5;
        for (int n = tid; n < DM; n += NTHREADS) {
            if (HAS_Y) { float gsum = 0.f;
#pragma unroll
                for (int kc = 0; kc < 16; ++kc) gsum += modp[(size_t)(kc * 8 + b) * NMOD + (isub * 3 + 2) * DM + n];
                vA[n] = rw * gsum * npost[isub * DM + n]; }
            if (HAS_NEXT) { const int jn = isub + 1; float sc = 0.f, sh = 0.f;
#pragma unroll
                for (int kc = 0; kc < 16; ++kc) { sh += modp[(size_t)(kc * 8 + b) * NMOD + (jn * 3 + 0) * DM + n]; sc += modp[(size_t)(kc * 8 + b) * NMOD + (jn * 3 + 1) * DM + n]; }
                vB[n] = npre[jn * DM + n] * (1.0f + sc); vC[n] = sh; }
        }
        __syncthreads();
        f32x4 a[4], bb[4], cc[4];
#pragma unroll
        for (int j = 0; j < 4; ++j) { const int c0 = 4 * lane + 256 * j;
            a[j] = HAS_Y ? *(const LAS f32x4*)(vA + c0) : (f32x4){0.f, 0.f, 0.f, 0.f};
            bb[j] = HAS_NEXT ? *(const LAS f32x4*)(vB + c0) : (f32x4){0.f, 0.f, 0.f, 0.f};
            cc[j] = HAS_NEXT ? *(const LAS f32x4*)(vC + c0) : (f32x4){0.f, 0.f, 0.f, 0.f}; }
        for (int rr = 0; rr < 32; rr += 2) {
            f32x4 hv[2][4]; u32x2 yv[2][4]; float rsy[2];
#pragma unroll
            for (int u = 0; u < 2; ++u) { const size_t row = (size_t)rb * 256 + wave * 32 + rr + u;
#pragma unroll
                for (int j = 0; j < 4; ++j) {
                    if (HIN_BF16) { const u32x2 t = *(const u32x2*)((const bf16_t*)hin_ + row * DM + 4 * lane + 256 * j); hv[u][j] = (f32x4){bf_lo(t.x), bf_hi(t.x), bf_lo(t.y), bf_hi(t.y)}; }
                    else hv[u][j] = *(const f32x4*)((const float*)hin_ + row * DM + 4 * lane + 256 * j);
                    if (HAS_Y) yv[u][j] = *(const u32x2*)(Y + row * DM + 4 * lane + 256 * j); }
                if (HAS_Y) { const f32x4 s0 = *(const f32x4*)(SS + row * 16), s1 = *(const f32x4*)(SS + row * 16 + 4), s2 = *(const f32x4*)(SS + row * 16 + 8), s3 = *(const f32x4*)(SS + row * 16 + 12);
                    const float ssum = ((s0[0] + s0[1]) + (s0[2] + s0[3])) + ((s1[0] + s1[1]) + (s1[2] + s1[3])) + ((s2[0] + s2[1]) + (s2[2] + s2[3])) + ((s3[0] + s3[1]) + (s3[2] + s3[3]));
                    rsy[u] = 1.0f / sqrtf(ssum * (1.0f / DM) + EPS); } }
            asm volatile("" ::: "memory");
#pragma unroll
            for (int u = 0; u < 2; ++u) { const size_t row = (size_t)rb * 256 + wave * 32 + rr + u;
                if (HAS_Y) {
#pragma unroll
                    for (int j = 0; j < 4; ++j) { hv[u][j][0] += a[j][0] * (bf_lo(yv[u][j].x) * rsy[u]); hv[u][j][1] += a[j][1] * (bf_hi(yv[u][j].x) * rsy[u]);
                        hv[u][j][2] += a[j][2] * (bf_lo(yv[u][j].y) * rsy[u]); hv[u][j][3] += a[j][3] * (bf_hi(yv[u][j].y) * rsy[u]);
                        if (HOUT_BF16) { u32x2 o; o.x = cvt_pk_bf16(hv[u][j][0], hv[u][j][1]); o.y = cvt_pk_bf16(hv[u][j][2], hv[u][j][3]);
                            *(u32x2*)((bf16_t*)hout_ + row * DM + 4 * lane + 256 * j) = o;
                            hv[u][j] = (f32x4){bf_lo(o.x), bf_hi(o.x), bf_lo(o.y), bf_hi(o.y)}; }
                        else *(f32x4*)((float*)hout_ + row * DM + 4 * lane + 256 * j) = hv[u][j]; }
                }
                if (HAS_NEXT) {
                    float s = 0.f;
#pragma unroll
                    for (int j = 0; j < 4; ++j) s += (hv[u][j][0] * hv[u][j][0] + hv[u][j][1] * hv[u][j][1]) + (hv[u][j][2] * hv[u][j][2] + hv[u][j][3] * hv[u][j][3]);
                    const float rs = 1.0f / sqrtf(wave_sum(s) * (1.0f / DM) + EPS);
#pragma unroll
                    for (int j = 0; j < 4; ++j) { u32x2 o; o.x = cvt_pk_bf16(hv[u][j][0] * rs * bb[j][0] + cc[j][0], hv[u][j][1] * rs * bb[j][1] + cc[j][1]);
                        o.y = cvt_pk_bf16(hv[u][j][2] * rs * bb[j][2] + cc[j][2], hv[u][j][3] * rs * bb[j][3] + cc[j][3]);
                        *(u32x2*)(U + row * DM + 4 * lane + 256 * j) = o; }
                }
            }
        }
        __syncthreads();
    }
}

#define XB_TMO      128
#define XB_XCNT(j)  (256  + 64 * (j))
#define XB_XSUB(j)  (1280 + 64 * (j))
#define XB_XGEN(j)  (2304 + 64 * (j))
#define XB_TOP      3328
#define XB_TOPGEN   3392
#define XCD_BAR_WORDS 3456
#define XB_SPIN_CAP (1u << 18)

__device__ __forceinline__ unsigned xb_ld(unsigned* p)              { return __hip_atomic_load(p, __ATOMIC_RELAXED, __HIP_MEMORY_SCOPE_AGENT); }
__device__ __forceinline__ unsigned xb_add(unsigned* p, unsigned v) { return __hip_atomic_fetch_add(p, v, __ATOMIC_RELAXED, __HIP_MEMORY_SCOPE_AGENT); }
__device__ __forceinline__ unsigned xb_xcc_id() { return (unsigned)__builtin_amdgcn_s_getreg((3 << 11) | 20) & 0xFu; }
#define XB_SPIN(cond, bar) do { unsigned _sp = 0; while (cond) { __builtin_amdgcn_s_sleep(1); \
    if ((++_sp & 255u) == 0u) { if (xb_ld(&(bar)[XB_TMO])) break; if (_sp > XB_SPIN_CAP) { atomicAdd(&(bar)[XB_TMO], 1u); break; } } } } while (0)

struct XcdBarrier {
    unsigned* bar; unsigned x;
    volatile LAS unsigned* st;
};

__device__ __forceinline__ XcdBarrier xcd_barrier_post(unsigned* bar, volatile LAS unsigned* st) {
    XcdBarrier b; b.bar = bar; b.x = xb_xcc_id(); b.st = st;
    if (threadIdx.x == 0) (void)xb_add(&bar[XB_XCNT(b.x)], 1u);
    return b;
}
__device__ __forceinline__ void xcd_barrier_complete(unsigned* bar, unsigned x, unsigned& nloc, unsigned& nx) {
    const unsigned G = gridDim.x * gridDim.y * gridDim.z;
    unsigned sum, cnt, mine, sp = 0u;
    for (;;) {
        sum = 0u; cnt = 0u; mine = 0u;
#pragma unroll
        for (unsigned j = 0; j < 16; ++j) { const unsigned c = xb_ld(&bar[XB_XCNT(j)]); sum += c; cnt += (c > 0u) ? 1u : 0u; mine = (j == x) ? c : mine; }
        if (sum == G) break;
        __builtin_amdgcn_s_sleep(1);
        if ((++sp & 255u) == 0u) { if (xb_ld(&bar[XB_TMO])) break; if (sp > XB_SPIN_CAP) { atomicAdd(&bar[XB_TMO], 1u); break; } }
    }
    nloc = mine > 0u ? mine : 1u; nx = cnt > 0u ? cnt : 1u;
}

__device__ __forceinline__ void xcd_barrier(const XcdBarrier& b) {
    asm volatile("s_waitcnt vmcnt(0)" ::: "memory");
    __syncthreads();
    if (threadIdx.x == 0) {
        unsigned* bar = b.bar;
        __builtin_amdgcn_s_waitcnt(0);
        unsigned nloc = b.st[0], nx = b.st[1];
        if (nloc == 0u) { xcd_barrier_complete(bar, b.x, nloc, nx); b.st[0] = nloc; b.st[1] = nx; }
        const unsigned old = xb_add(&bar[XB_XSUB(b.x)], 1u);
        const unsigned gen = old / nloc;
        if (old + 1u == (gen + 1u) * nloc) {
            __builtin_amdgcn_fence(__ATOMIC_RELEASE, "agent");
            asm volatile("s_waitcnt vmcnt(0)" ::: "memory");
            const unsigned og = xb_add(&bar[XB_TOP], 1u);
            const unsigned tg = og / nx;
            if (og + 1u == (tg + 1u) * nx) xb_add(&bar[XB_TOPGEN], 1u);
            else XB_SPIN(xb_ld(&bar[XB_TOPGEN]) == tg, bar);
            __builtin_amdgcn_fence(__ATOMIC_ACQUIRE, "agent");
            xb_add(&bar[XB_XGEN(b.x)], 1u);
            asm volatile("s_waitcnt vmcnt(0)" ::: "memory");
        } else {
            XB_SPIN(xb_ld(&bar[XB_XGEN(b.x)]) == gen, bar);
            __builtin_amdgcn_fence(__ATOMIC_ACQUIRE, "agent");
            asm volatile("s_waitcnt vmcnt(0)" ::: "memory");
        }
    }
    __syncthreads();
}


__global__ void __launch_bounds__(NTHREADS, 2) fwd_megakernel(Args args) {
    extern __shared__ __attribute__((aligned(16))) unsigned char lds_raw[];
    LAS unsigned char* lds = (LAS unsigned char*)lds_raw;
    cg::grid_group grid = cg::this_grid();
    const int tid = threadIdx.x, lane = tid & 63, wave = __builtin_amdgcn_readfirstlane(tid >> 6);
    const int G = gridDim.x, bx = blockIdx.x; const int vcu = (G % 8 == 0) ? (bx % 8) * (G / 8) + bx / 8 : bx;
    TSTART();
    volatile LAS unsigned* xst = (volatile LAS unsigned*)(lds + (LDS_BYTES - 32));
    if (tid < 2) xst[tid] = 0u;
    if (bx == 0) for (int i = tid; i < XCD_BAR_WORDS; i += NTHREADS) __hip_atomic_store(args.bar + i, 0u, __ATOMIC_RELAXED, __HIP_MEMORY_SCOPE_AGENT);
    if (bx == 0 && tid == 0) __hip_atomic_store(args.ctr, 0u, __ATOMIC_RELAXED, __HIP_MEMORY_SCOPE_AGENT);
    if (bx == 0 && tid < 128) __hip_atomic_store(args.kmax2 + tid, 0u, __ATOMIC_RELAXED, __HIP_MEMORY_SCOPE_AGENT);
    {
        LAS float* scr = (LAS float*)(lds + wave * 8448);
        const int gw = vcu * NWAVES + wave, NGW = G * NWAVES;
        constexpr int I_G = (DM / 64) * (DFF / 32), I_D = (DFF / 64) * (DM / 32), I_IN = (DM / 64) * (INW / 32), I_BR = (512 / 64) * (DM / 32), I_O = (DM / 64) * (DM / 32);
        constexpr int NITEMS = 4 * I_G + 2 * I_D + I_IN + 2 * I_BR + I_O;
        for (int it = gw; it < NITEMS; it += NGW) {
            int r = it;
            if (r < I_G) { p0_transpose_item(args.in[6], DM, DFF, args.Wgu[0], 1, scr, r, lane); continue; } r -= I_G;
            if (r < I_G) { p0_transpose_item(args.in[7], DM, DFF, args.Wgu[0], 2, scr, r, lane); continue; } r -= I_G;
            if (r < I_G) { p0_transpose_item(args.in[18], DM, DFF, args.Wgu[1], 1, scr, r, lane); continue; } r -= I_G;
            if (r < I_G) { p0_transpose_item(args.in[19], DM, DFF, args.Wgu[1], 2, scr, r, lane); continue; } r -= I_G;
            if (r < I_D) { p0_transpose_item(args.in[8], DFF, DM, args.Wd[0], 0, scr, r, lane); continue; } r -= I_D;
            if (r < I_D) { p0_transpose_item(args.in[20], DFF, DM, args.Wd[1], 0, scr, r, lane); continue; } r -= I_D;
            if (r < I_IN) { p0_transpose_item(args.in[9], DM, INW, args.Win, 0, scr, r, lane); continue; } r -= I_IN;
            if (r < I_BR) { p0_transpose_item(args.in[15], 512, DM, args.Wsb, 0, scr, r, lane); continue; } r -= I_BR;
            if (r < I_BR) { p0_transpose_item(args.in[16], 512, DM, args.Wda, 0, scr, r, lane); continue; } r -= I_BR;
            p0_transpose_item(args.in[17], DM, DM, args.Wout, 0, scr, r, lane);
        }
        LAS float* sc = (LAS float*)(lds + 69632);
        for (int i = tid; i < NB * DM; i += NTHREADS) { const float cv = args.in[1][i]; sc[i] = cv * sigmoidf_(cv); }
        __syncthreads();
        for (int task = bx * NTHREADS + tid; task < 16 * NMOD; task += G * NTHREADS) {
            const int kc = task / NMOD, n = task % NMOD;
            float acc[8];
#pragma unroll
            for (int b = 0; b < 8; ++b) acc[b] = 0.f;
            for (int k = kc * 64; k < kc * 64 + 64; ++k) { const float wv = args.in[2][(size_t)k * NMOD + n];
#pragma unroll
                for (int b = 0; b < 8; ++b) acc[b] += sc[b * DM + k] * wv; }
            if (kc == 0) { const float bv = args.in[3][n];
#pragma unroll
                for (int b = 0; b < 8; ++b) acc[b] += bv; }
#pragma unroll
            for (int b = 0; b < 8; ++b) args.modp[(size_t)(kc * 8 + b) * NMOD + n] = acc[b];
        }
    }
    TEND(0);
    grid.sync();
    (void)xcd_barrier_post(args.bar, xst);
#define GSYNC() do { XcdBarrier b_; b_.bar = args.bar; b_.x = xb_xcc_id(); b_.st = (volatile LAS unsigned*)(lds + (LDS_BYTES - 32)); xcd_barrier(b_); } while (0)

    TEND(10);
    rowwise_phase<false, true, false, false>(lds, vcu, G, args.in[0], nullptr, nullptr, nullptr, args.modp, args.in[5], args.in[4], -1, 0.f, args.U);
    TEND(1);
    GSYNC();
    TEND(10);

    for (int f = 0; f < 2; ++f) {
        { pg8::Gemm g{args.U, args.Wgu[f], MT, NGU, DM, DM}; pg8::StaticOrder S; S.init(MT, NGU, G, bx); pg8::EpiSwiGLU E{args.BIG}; pg8::gemm_phase(lds, g, S, E); }
        TEND(2);
        GSYNC();
        TEND(10);
        { pg8::Gemm g{args.BIG, args.Wd[f], MT, DM, DFF, DFF}; pg8::StaticOrder S; S.init(MT, DM, G, bx); pg8::EpiY E{f ? args.Y3 : args.Y, args.SS}; pg8::gemm_phase(lds, g, S, E); }
        TEND(3);
        GSYNC();
        TEND(10);
        if (f == 0) {
            rowwise_phase<true, true, false, true>(lds, vcu, G, args.in[0], args.Y, args.Y, args.SS, args.modp, args.in[5], args.in[4], 0, 0.5f, args.U);
            TEND(1);
            GSYNC();
            TEND(10);
            { pg8::Gemm g{args.U, args.Win, MT, INW, DM, DM}; pg8::StaticOrder S; S.init(MT, INW, G, bx); pg8::EpiProj E{args.Qsb, args.KVsb, args.Qda, args.KVda, args.Gt, args.kmax2}; pg8::gemm_phase(lds, g, S, E); }
            TEND(4);
            GSYNC();
            TEND(10);
            {
                float d1 = 0.f, d2 = 0.f;
                for (int i = 0; i < 64; ++i) { d1 += args.in[10][i] * args.in[11][i]; d2 += args.in[12][i] * args.in[13][i]; }
                const float lam = expf(d1) - expf(d2) + LAMBDA_INIT;
                LAS unsigned* slot = (LAS unsigned*)(lds + (LDS_BYTES - 16));
                for (;;) {
                    if (tid == 0) *slot = __hip_atomic_fetch_add(args.ctr, 1u, __ATOMIC_RELAXED, __HIP_MEMORY_SCOPE_AGENT);
                    __syncthreads();
                    const unsigned u = *slot;
                    __syncthreads();
                    if (u >= 3072u) break;
                    if (u < 1024u) { const int hh = 3 - (int)(u >> 8), rem = (int)(u & 255u), qb = 31 - (rem >> 3), bh = (rem & 7) * 4 + hh;
                        const float slope = exp2f(-2.0f * (float)(hh + 1));
                        att::da_unit(lds, args.Qda + (size_t)bh * SEQ * 128, args.KVda + (size_t)bh * SEQ * 256, args.yd + (size_t)(bh >> 2) * SEQ * 512 + 128 * hh, qb, lam, args.in[14], slope, args.kmax2 + bh * 4);
                    } else { const int v = (int)u - 1024, bh = v >> 5, qb = 31 - (v & 31);
                        att::sb_unit(lds, args.Qsb + (size_t)bh * SEQ * 64, args.KVsb + (size_t)bh * SEQ * 128, args.ya + (size_t)(bh >> 3) * SEQ * 512 + 64 * (bh & 7), qb); }
                }
            }
            TEND(5);
            GSYNC();
            TEND(10);
            { pg8::Gemm g{args.ya, args.Wsb, MT, DM, 512, 512}; pg8::StaticOrder S; S.init(MT, DM, G, bx); pg8::EpiGate<true> E{args.Mg, args.Gt, 0}; pg8::gemm_phase(lds, g, S, E); }
            __syncthreads();
            { pg8::Gemm g{args.yd, args.Wda, MT, DM, 512, 512}; pg8::StaticOrder S; S.init(MT, DM, G, bx); pg8::EpiGate<false> E{args.Mg, args.Gt, 1024}; pg8::gemm_phase(lds, g, S, E); }
            TEND(6);
            GSYNC();
            TEND(10);
            { pg8::Gemm g{args.Mg, args.Wout, MT, DM, DM, DM}; pg8::StaticOrder S; S.init(MT, DM, G, bx); pg8::EpiY E{args.Y2, args.SS}; pg8::gemm_phase(lds, g, S, E); }
            TEND(7);
            GSYNC();
            TEND(10);
            rowwise_phase<true, true, true, true>(lds, vcu, G, args.Y, args.Y, args.Y2, args.SS, args.modp, args.in[5], args.in[4], 1, 1.0f, args.U);
            TEND(1);
            GSYNC();
            TEND(10);
        } else {
            rowwise_phase<true, false, true, false>(lds, vcu, G, args.Y, args.out, args.Y3, args.SS, args.modp, args.in[5], args.in[4], 2, 0.5f, nullptr);
            TEND(1);
        }
    }
}

extern "C" void kernel_launch(void* const* d_in, const int* in_sizes, int n_in, void* d_out, int out_size, void* d_ws, size_t ws_size, hipStream_t stream) {
    static int grid = 0;
    if (grid == 0) {
        if (n_in != 21 || in_sizes[0] != MT * DM || out_size != MT * DM || ws_size < WS_END) {
            fprintf(stderr, "kernel_launch: unexpected shapes (n_in %d in0 %d out %d ws %zu); nothing launched\n", n_in, n_in > 0 ? in_sizes[0] : -1, out_size, ws_size); grid = -1; return; }
        int dev = 0, cus = 0, per_cu = 0;
        hipGetDevice(&dev);
        hipDeviceGetAttribute(&cus, hipDeviceAttributeMultiprocessorCount, dev);
        if (hipFuncSetAttribute((const void*)fwd_megakernel, hipFuncAttributeMaxDynamicSharedMemorySize, LDS_BYTES) != hipSuccess) fprintf(stderr, "kernel_launch: hipFuncSetAttribute failed\n");
        if (hipOccupancyMaxActiveBlocksPerMultiprocessor(&per_cu, (const void*)fwd_megakernel, NTHREADS, LDS_BYTES) != hipSuccess || per_cu < 1) { fprintf(stderr, "kernel_launch: occupancy query gave %d\n", per_cu); per_cu = 1; }
        (void)hipGetLastError();
        grid = cus * 1;
        if (grid <= 0) grid = 256;
    }
    if (grid < 0) return;
    Args a{};
    for (int i = 0; i < 21; ++i) a.in[i] = (const float*)d_in[i];
    unsigned char* ws = (unsigned char*)d_ws;
    a.out = (float*)d_out; a.modp = (float*)(ws + WS_MODP); a.SS = (float*)(ws + WS_SS);
    a.Wgu[0] = (bf16_t*)(ws + WS_WGU1); a.Wgu[1] = (bf16_t*)(ws + WS_WGU2); a.Wd[0] = (bf16_t*)(ws + WS_WD1); a.Wd[1] = (bf16_t*)(ws + WS_WD2);
    a.Win = (bf16_t*)(ws + WS_WIN); a.Wsb = (bf16_t*)(ws + WS_WSB); a.Wda = (bf16_t*)(ws + WS_WDA); a.Wout = (bf16_t*)(ws + WS_WOUT);
    a.U = (bf16_t*)(ws + WS_U); a.Y = (bf16_t*)(ws + WS_Y); a.BIG = (bf16_t*)(ws + WS_BIG);
    a.Qsb = (bf16_t*)(ws + WS_BIG); a.KVsb = (bf16_t*)(ws + WS_BIG + 64 * MiB); a.Qda = (bf16_t*)(ws + WS_BIG + 192 * MiB); a.KVda = (bf16_t*)(ws + WS_BIG + 256 * MiB); a.Gt = (bf16_t*)(ws + WS_BIG + 384 * MiB);
    a.ctr = (unsigned*)ws; a.kmax2 = (unsigned*)(ws + 4096); a.bar = (unsigned*)(ws + 16384);
    a.ya = (bf16_t*)(ws + WS_U); a.yd = (bf16_t*)(ws + WS_U + 64 * MiB);
    a.Mg = (bf16_t*)(ws + WS_BIG + 256 * MiB); a.Y2 = (bf16_t*)(ws + WS_BIG + 64 * MiB); a.Y3 = (bf16_t*)(ws + WS_BIG + 384 * MiB);
    void* kargs[] = {&a};
    hipError_t e = hipLaunchCooperativeKernel((const void*)fwd_megakernel, dim3(grid), dim3(NTHREADS), kargs, LDS_BYTES, stream);
    if (e != hipSuccess) fprintf(stderr, "cooperative launch failed: %s (grid %d)\n", hipGetErrorString(e), grid);
}
```

```cpp
#include <hip/hip_runtime.h>
#include <hip/hip_cooperative_groups.h>
#include <cstdio>
#include <cstdint>
namespace cg = cooperative_groups;

#define LAS __attribute__((address_space(3)))
typedef unsigned short bf16_t;
typedef short bf16x8 __attribute__((ext_vector_type(8)));
typedef short s16x4 __attribute__((ext_vector_type(4)));
typedef float f32x4 __attribute__((ext_vector_type(4)));
typedef float f32x16 __attribute__((ext_vector_type(16)));
typedef unsigned u32x4 __attribute__((ext_vector_type(4)));
typedef unsigned u32x2 __attribute__((ext_vector_type(2)));

constexpr int DM = 1024, NB = 8, SEQ = 8192, MT = NB * SEQ, DFF = 2816, NGU = 2 * DFF, INW = 5120, NMOD = 9216;
constexpr float EPS = 1e-6f, LOG2E = 1.4426950408889634f, LN2 = 0.6931471805599453f;
constexpr float LAMBDA_INIT = 0.2f;

constexpr size_t MiB = 1u << 20;
constexpr size_t WS_MODP = 1 * MiB;
constexpr size_t WS_SS = 6 * MiB;
constexpr size_t WS_WGU1 = 10 * MiB, WS_WD1 = 21 * MiB, WS_WIN = 27 * MiB, WS_WSB = 37 * MiB, WS_WDA = 38 * MiB, WS_WOUT = 39 * MiB, WS_WGU2 = 41 * MiB, WS_WD2 = 52 * MiB;
constexpr size_t WS_U = 64 * MiB;
constexpr size_t WS_Y = 192 * MiB;
constexpr size_t WS_BIG = 320 * MiB;
constexpr size_t WS_END = 960 * MiB;

typedef float f32x2_t __attribute__((ext_vector_type(2))); typedef __bf16 bf16x2_t __attribute__((ext_vector_type(2)));
__device__ __forceinline__ unsigned cvt_pk_bf16(float lo, float hi) { const f32x2_t v = {lo, hi}; const bf16x2_t b = __builtin_convertvector(v, bf16x2_t); return __builtin_bit_cast(unsigned, b); }
__device__ __forceinline__ float bf_lo(unsigned u) { return __uint_as_float(u << 16); }
__device__ __forceinline__ float bf_hi(unsigned u) { return __uint_as_float(u & 0xffff0000u); }
__device__ __forceinline__ float fast_exp2(float x) { return __builtin_amdgcn_exp2f(x); }
__device__ __forceinline__ float fast_log2(float x) { return __builtin_amdgcn_logf(x); }
__device__ __forceinline__ float fast_rcp(float x) { return __builtin_amdgcn_rcpf(x); }
__device__ __forceinline__ float sigmoidf_(float x) { return fast_rcp(1.0f + fast_exp2(-x * LOG2E)); }
__device__ __forceinline__ float wave_sum(float v) {
#pragma unroll
    for (int o = 1; o < 64; o <<= 1) v += __shfl_xor(v, o);
    return v;
}

__device__ __forceinline__ void glds_s(const void* sbase, unsigned voff, unsigned lds_dst) {
    unsigned keep;
    asm volatile("s_mov_b32 %0, m0\n\ts_mov_b32 m0, %3\n\ts_nop 0\n\tglobal_load_lds_dwordx4 %1, %2\n\ts_mov_b32 m0, %0" : "=&s"(keep) : "v"(voff), "s"(sbase), "s"(lds_dst) : "memory");
}

namespace pg8 {
constexpr int BM = 256, BK = 64, HALF = 128, HTB = HALF * BK * 2, STAGE_BYTES = 8 * HTB, NXCD = 8, WGM = 8;
__host__ __device__ __forceinline__ int lds_byte(int r, int c) { const int st = (r >> 4) * 2 + (c >> 5), rr = r & 15, cc = c & 31, ob = rr * 64 + cc * 2; return st * 1024 + (ob ^ (((ob >> 9) & 1) << 5)); }
__host__ __device__ __forceinline__ void stage_rc(int b, int& R, int& C) { const int st = b / 1024, sb = b % 1024, swz = sb ^ (((sb >> 9) & 1) << 5); R = (st >> 1) * 16 + swz / 64; C = (st & 1) * 32 + (swz % 64) / 2; }
__host__ __device__ __forceinline__ int perm32(int rho) { const int n = rho >> 4, i = rho & 15; return 8 * (i >> 2) + 4 * n + (i & 3); }

struct Unit { int pm, pn; };
struct Gemm { const bf16_t* A; const bf16_t* Bt; int M, N, K, lda; };

struct StaticOrder {
    int nM, nN, nwg, G, c;
    __device__ void init(int M, int N, int G_, int c_) { nM = M / BM; nN = N / BM; nwg = nM * nN; G = G_; c = c_; }
    __device__ bool next(int i, Unit& u) const {
        const long L = (long)i * G + c; if (L >= nwg) return false;
        int wgid = (int)L; { const int q = nwg / NXCD, r = nwg % NXCD, xcd = wgid % NXCD, off = wgid / NXCD; wgid = (xcd < r ? xcd * (q + 1) : r * (q + 1) + (xcd - r) * q) + off; }
        const int nig = WGM * nN, gid = wgid / nig, fm = gid * WGM, gsz = (nM - fm) < WGM ? (nM - fm) : WGM;
        u.pm = fm + ((wgid % nig) % gsz); u.pn = (wgid % nig) / gsz; return true;
    }
};

template <class Epi>
__device__ __forceinline__ void gemm_phase(LAS unsigned char* lds, const Gemm g, const StaticOrder& S, const Epi& E) {
    int tid_ = threadIdx.x; asm volatile("" : "+v"(tid_));
    const int tid = tid_, wid = __builtin_amdgcn_readfirstlane(tid >> 6), lane = tid & 63, wr = wid >> 2, wc = wid & 3, fr = lane & 15, fq = lane >> 4;
    const int K = g.K, nt = K / BK, lda = g.lda;
    unsigned voffA[2], voffB[2];
#pragma unroll
    for (int i = 0; i < 2; ++i) { int R, C; stage_rc(tid * 16 + i * 8192, R, C); const int Rb = (R & ~31) + perm32(R & 31);
        voffA[i] = (unsigned)(R * lda + C) * 2u; voffB[i] = (unsigned)(Rb * K + C) * 2u; }
    const size_t kstep = (size_t)(BK * 2);
    const size_t hstepA = (size_t)HALF * lda * 2, hstepB = (size_t)HALF * K * 2;
    const size_t tstepA = 2 * hstepA, tstepB = 2 * hstepB;
    const unsigned ldsbase = (unsigned)(uintptr_t)lds + (unsigned)wid * 1024u;
    const int aoff = lds_byte(wr * 64 + fr, fq * 8), boff = lds_byte(wc * 32 + fr, fq * 8);
#define PG8_SA(b, h) (((b) * 2 + (h)) * HTB)
#define PG8_SB(b, h) ((4 + (b) * 2 + (h)) * HTB)
#define PG8_STAGE(bufoff, gbase, voff) do { _Pragma("unroll") for (int _i = 0; _i < 2; ++_i) \
        glds_s((const void*)(gbase), (voff)[_i], ldsbase + (unsigned)((bufoff) + _i * 8192)); } while (0)
#define PG8_LDA(dst, b, h) do { _Pragma("unroll") for (int m = 0; m < 4; ++m) _Pragma("unroll") for (int k = 0; k < 2; ++k) dst[m][k] = *(const LAS bf16x8*)(lds + PG8_SA(b, h) + aoff + m * 2048 + k * 1024); } while (0)
#define PG8_LDB(dst, b, h) do { _Pragma("unroll") for (int n = 0; n < 2; ++n) _Pragma("unroll") for (int k = 0; k < 2; ++k) dst[n][k] = *(const LAS bf16x8*)(lds + PG8_SB(b, h) + boff + n * 2048 + k * 1024); } while (0)
#define PG8_MMA(ai, bj, At, Bt) do { __builtin_amdgcn_s_setprio(1); _Pragma("unroll") for (int m = 0; m < 4; ++m) _Pragma("unroll") for (int n = 0; n < 2; ++n) _Pragma("unroll") for (int k = 0; k < 2; ++k) \
        acc[ai][bj][m][n] = __builtin_amdgcn_mfma_f32_16x16x32_bf16(Bt[n][k], At[m][k], acc[ai][bj][m][n], 0, 0, 0); __builtin_amdgcn_s_setprio(0); } while (0)
#define PG8_WAIT_V(n) asm volatile("s_waitcnt vmcnt(" #n ")" ::: "memory")
#define PG8_WAIT_L(n) asm volatile("s_waitcnt lgkmcnt(" #n ")" ::: "memory")
#define PG8_BAR __builtin_amdgcn_s_barrier()
#define PG8_SCHED __builtin_amdgcn_sched_barrier(0)
    Unit cur, nxt; int ui = 0;
    if (!S.next(0, cur)) return;
    f32x4 acc[2][2][4][2];
#pragma unroll
    for (int a = 0; a < 2; ++a)
#pragma unroll
        for (int b = 0; b < 2; ++b)
#pragma unroll
            for (int m = 0; m < 4; ++m)
#pragma unroll
                for (int n = 0; n < 2; ++n) acc[a][b][m][n] = (f32x4){0.f, 0.f, 0.f, 0.f};
    bf16x8 At[4][2], B0[2][2], B1[2][2];
    const char* cA = (const char*)g.A + (size_t)cur.pm * tstepA; const char* cB = (const char*)g.Bt + (size_t)cur.pn * tstepB;
    PG8_STAGE(PG8_SB(0, 0), cB, voffB); PG8_STAGE(PG8_SB(0, 1), cB + hstepB, voffB); PG8_STAGE(PG8_SA(0, 0), cA, voffA); PG8_STAGE(PG8_SA(0, 1), cA + hstepA, voffA);
    if (wr == 1) PG8_BAR;
    PG8_WAIT_V(2); PG8_BAR;
    PG8_STAGE(PG8_SB(1, 0), cB + kstep, voffB); PG8_STAGE(PG8_SA(1, 0), cA + kstep, voffA); PG8_STAGE(PG8_SB(1, 1), cB + hstepB + kstep, voffB);
    PG8_WAIT_V(6); PG8_BAR;
    for (;;) {
        const bool has_next = S.next(ui + 1, nxt);
        const char* nA = has_next ? (const char*)g.A + (size_t)nxt.pm * tstepA : cA; const char* nB = has_next ? (const char*)g.Bt + (size_t)nxt.pn * tstepB : cB;
        for (int t = 0; t < nt; t += 2) {
            const bool last = (t == nt - 2);
            const char* a1 = cA + (size_t)(t + 1) * kstep;
            const char* a2 = last ? nA : cA + (size_t)(t + 2) * kstep; const char* b2 = last ? nB : cB + (size_t)(t + 2) * kstep;
            const char* a3 = a2 + kstep; const char* b3 = b2 + kstep;
            PG8_LDB(B0, 0, 0); PG8_LDB(B1, 0, 1); PG8_SCHED; PG8_LDA(At, 0, 0); PG8_STAGE(PG8_SA(1, 1), a1 + hstepA, voffA);
            PG8_WAIT_V(8); PG8_WAIT_L(0); PG8_BAR; PG8_MMA(0, 0, At, B0); PG8_MMA(0, 1, At, B1); PG8_BAR; PG8_SCHED;
            PG8_LDA(At, 0, 1); PG8_STAGE(PG8_SB(0, 0), b2, voffB); PG8_STAGE(PG8_SB(0, 1), b2 + hstepB, voffB); PG8_STAGE(PG8_SA(0, 0), a2, voffA);
            PG8_WAIT_V(8); PG8_WAIT_L(0); PG8_BAR; PG8_MMA(1, 0, At, B0); PG8_MMA(1, 1, At, B1); PG8_BAR; PG8_SCHED;
            PG8_LDB(B0, 1, 0); PG8_LDB(B1, 1, 1); PG8_SCHED; PG8_LDA(At, 1, 0); PG8_STAGE(PG8_SA(0, 1), a2 + hstepA, voffA);
            PG8_WAIT_V(8); PG8_WAIT_L(0); PG8_BAR; PG8_MMA(0, 0, At, B0); PG8_MMA(0, 1, At, B1); PG8_BAR; PG8_SCHED;
            PG8_LDA(At, 1, 1); PG8_STAGE(PG8_SB(1, 0), b3, voffB); PG8_STAGE(PG8_SB(1, 1), b3 + hstepB, voffB); PG8_STAGE(PG8_SA(1, 0), a3, voffA);
            PG8_WAIT_V(8); PG8_WAIT_L(0); PG8_BAR; PG8_MMA(1, 0, At, B0); PG8_MMA(1, 1, At, B1); PG8_BAR; PG8_SCHED;
        }
        if (wr == 0) PG8_BAR;
        E(acc, cur, wr, wc, fr, fq);
        if (!has_next) break;
#pragma unroll
        for (int a = 0; a < 2; ++a)
#pragma unroll
            for (int b = 0; b < 2; ++b)
#pragma unroll
                for (int m = 0; m < 4; ++m)
#pragma unroll
                    for (int n = 0; n < 2; ++n) acc[a][b][m][n] = (f32x4){0.f, 0.f, 0.f, 0.f};
        cur = nxt; cA = nA; cB = nB; ++ui;
        if (wr == 1) PG8_BAR;
    }
    PG8_WAIT_V(0);
    PG8_BAR;
#undef PG8_SA
#undef PG8_SB
#undef PG8_STAGE
#undef PG8_LDA
#undef PG8_LDB
#undef PG8_MMA
#undef PG8_WAIT_V
#undef PG8_WAIT_L
#undef PG8_BAR
#undef PG8_SCHED
}

struct EpiSwiGLU {
    bf16_t* H;
    __device__ __forceinline__ void operator()(const f32x4 (&acc)[2][2][4][2], const Unit& u, int wr, int wc, int fr, int fq) const {
        const int row0 = u.pm * BM + wr * 64 + fr, col0 = u.pn * HALF + wc * 32 + 8 * fq;
#pragma unroll
        for (int ai = 0; ai < 2; ++ai)
#pragma unroll
            for (int m = 0; m < 4; ++m) {
                float o[8];
#pragma unroll
                for (int n = 0; n < 2; ++n)
#pragma unroll
                    for (int e = 0; e < 4; ++e) { const float gv = acc[ai][0][m][n][e], uv = acc[ai][1][m][n][e]; o[n * 4 + e] = gv * sigmoidf_(gv) * uv; }
                u32x4 w; w.x = cvt_pk_bf16(o[0], o[1]); w.y = cvt_pk_bf16(o[2], o[3]); w.z = cvt_pk_bf16(o[4], o[5]); w.w = cvt_pk_bf16(o[6], o[7]);
                *(u32x4*)(H + (size_t)(row0 + ai * HALF + m * 16) * DFF + col0) = w;
                asm volatile("" ::: "memory");
            }
    }
};
struct EpiProj {
    bf16_t *Qsb, *KVsb, *Qda, *KVda, *Gt; unsigned* kmax2;
    __device__ __forceinline__ void operator()(const f32x4 (&acc)[2][2][4][2], const Unit& u, int wr, int wc, int fr, int fq) const {
        const int row0 = u.pm * BM + wr * 64 + fr; const int cbase = u.pn * BM; const bool sg = (cbase >= 3072); const bool kdt = (cbase == 2048 || cbase == 2304);
        float mxk[2] = {0.f, 0.f};
#pragma unroll
        for (int ai = 0; ai < 2; ++ai)
#pragma unroll
            for (int m = 0; m < 4; ++m) { const int row = row0 + ai * HALF + m * 16; const int b = row >> 13, t = row & (SEQ - 1);
#pragma unroll
                for (int bj = 0; bj < 2; ++bj) { f32x4 v0 = acc[ai][bj][m][0], v1 = acc[ai][bj][m][1];
                    const int c = cbase + bj * HALF + wc * 32 + 8 * fq;
                    bf16_t* dst;
                    if (cbase < 1536) { const int sec = c >> 9, cc = c & 511, h = cc >> 6, wv = cc & 63; const size_t ri = (size_t)(b * 8 + h) * SEQ + t;
                        dst = (sec == 0) ? Qsb + ri * 64 + wv : KVsb + ri * 128 + (sec == 2 ? 64 : 0) + wv; }
                    else if (cbase < 3072) { const int c2 = c - 1536, sec = c2 >> 9, cc = c2 & 511, h = cc >> 7, wv = cc & 127; const size_t ri = (size_t)(b * 4 + h) * SEQ + t;
                        dst = (sec == 0) ? Qda + ri * 128 + wv : KVda + ri * 256 + (sec == 2 ? 128 : 0) + wv; }
                    else dst = Gt + (size_t)row * 2048 + (c - 3072);
                    if (sg) {
#pragma unroll
                        for (int e = 0; e < 4; ++e) { v0[e] = sigmoidf_(v0[e]); v1[e] = sigmoidf_(v1[e]); } }
                    u32x4 w; w.x = cvt_pk_bf16(v0[0], v0[1]); w.y = cvt_pk_bf16(v0[2], v0[3]); w.z = cvt_pk_bf16(v1[0], v1[1]); w.w = cvt_pk_bf16(v1[2], v1[3]);
                    *(u32x4*)dst = w;
                    if (kdt) { float sq = (bf_lo(w.x) * bf_lo(w.x) + bf_hi(w.x) * bf_hi(w.x)) + (bf_lo(w.y) * bf_lo(w.y) + bf_hi(w.y) * bf_hi(w.y)) + (bf_lo(w.z) * bf_lo(w.z) + bf_hi(w.z) * bf_hi(w.z)) + (bf_lo(w.w) * bf_lo(w.w) + bf_hi(w.w) * bf_hi(w.w));
                        sq += __shfl_xor(sq, 16); sq += __shfl_xor(sq, 32); mxk[bj] = fmaxf(mxk[bj], sq); } }
                asm volatile("" ::: "memory"); }
        if (kdt) {
#pragma unroll
            for (int bj = 0; bj < 2; ++bj) { float v = mxk[bj];
#pragma unroll
                for (int o = 1; o < 16; o <<= 1) v = fmaxf(v, __shfl_xor(v, o));
                const int b = (u.pm * BM) >> 13, h = ((cbase - 2048) >> 7) + bj, idx = ((b * 4 + h) * 2 + (wc >> 1)) * 2 + (wc & 1);
                if ((threadIdx.x & 63) == 0) atomicMax(kmax2 + idx, __float_as_uint(v)); }
        }
    }
};
struct EpiY {
    bf16_t* Y; float* SS;
    __device__ __forceinline__ void operator()(const f32x4 (&acc)[2][2][4][2], const Unit& u, int wr, int wc, int fr, int fq) const {
        const int row0 = u.pm * BM + wr * 64 + fr, col0 = u.pn * BM + wc * 32 + 8 * fq;
#pragma unroll
        for (int ai = 0; ai < 2; ++ai)
#pragma unroll
            for (int m = 0; m < 4; ++m) { const int row = row0 + ai * HALF + m * 16; bf16_t* rowp = Y + (size_t)row * DM + col0; float s = 0.f;
#pragma unroll
                for (int bj = 0; bj < 2; ++bj) { const f32x4 v0 = acc[ai][bj][m][0], v1 = acc[ai][bj][m][1];
                    s += (v0[0] * v0[0] + v0[1] * v0[1]) + (v0[2] * v0[2] + v0[3] * v0[3]) + (v1[0] * v1[0] + v1[1] * v1[1]) + (v1[2] * v1[2] + v1[3] * v1[3]);
                    u32x4 w; w.x = cvt_pk_bf16(v0[0], v0[1]); w.y = cvt_pk_bf16(v0[2], v0[3]); w.z = cvt_pk_bf16(v1[0], v1[1]); w.w = cvt_pk_bf16(v1[2], v1[3]);
                    *(u32x4*)(rowp + bj * HALF) = w; }
                s += __shfl_xor(s, 16); s += __shfl_xor(s, 32);
                if (fq == 0) SS[(size_t)row * 16 + u.pn * 4 + wc] = s;
                asm volatile("" ::: "memory"); }
    }
};
template <bool FIRST> struct EpiGate {
    static constexpr bool PANEL = false;
    bf16_t* Mg; const bf16_t* Gt; int gcol;
    __device__ __forceinline__ void operator()(const f32x4 (&acc)[2][2][4][2], const Unit& u, int wr, int wc, int fr, int fq) const {
        const int row0 = u.pm * BM + wr * 64 + fr, col0 = u.pn * BM + wc * 32 + 8 * fq;
#pragma unroll
        for (int ai = 0; ai < 2; ++ai) {
            u32x4 sg[4][2], tt[4][2];
#pragma unroll
            for (int m = 0; m < 4; ++m)
#pragma unroll
                for (int bj = 0; bj < 2; ++bj) { const size_t row = (size_t)(row0 + ai * HALF + m * 16);
                    sg[m][bj] = *(const u32x4*)(Gt + row * 2048 + gcol + col0 + bj * HALF);
                    if (!FIRST) tt[m][bj] = *(const u32x4*)(Mg + row * DM + col0 + bj * HALF); }
#pragma unroll
            for (int m = 0; m < 4; ++m)
#pragma unroll
                for (int bj = 0; bj < 2; ++bj) { const size_t row = (size_t)(row0 + ai * HALF + m * 16);
                    const f32x4 v0 = acc[ai][bj][m][0], v1 = acc[ai][bj][m][1]; const u32x4 sgv = sg[m][bj];
                    float o[8];
                    o[0] = bf_lo(sgv.x) * v0[0]; o[1] = bf_hi(sgv.x) * v0[1]; o[2] = bf_lo(sgv.y) * v0[2]; o[3] = bf_hi(sgv.y) * v0[3];
                    o[4] = bf_lo(sgv.z) * v1[0]; o[5] = bf_hi(sgv.z) * v1[1]; o[6] = bf_lo(sgv.w) * v1[2]; o[7] = bf_hi(sgv.w) * v1[3];
                    if (!FIRST) { const u32x4 t = tt[m][bj];
                        o[0] += bf_lo(t.x); o[1] += bf_hi(t.x); o[2] += bf_lo(t.y); o[3] += bf_hi(t.y); o[4] += bf_lo(t.z); o[5] += bf_hi(t.z); o[6] += bf_lo(t.w); o[7] += bf_hi(t.w); }
                    u32x4 w; w.x = cvt_pk_bf16(o[0], o[1]); w.y = cvt_pk_bf16(o[2], o[3]); w.z = cvt_pk_bf16(o[4], o[5]); w.w = cvt_pk_bf16(o[6], o[7]);
                    *(u32x4*)(Mg + row * DM + col0 + bj * HALF) = w; }
            asm volatile("" ::: "memory");
        }
    }
};
}

namespace att {
__device__ __forceinline__ int crow(int r, int hi) { return (r & 3) + 8 * (r >> 2) + 4 * hi; }

#define DS_RD128(dst, addr, imm) asm volatile("ds_read_b128 %0, %1 offset:%c2" : "=&v"(dst) : "v"(addr), "i"(imm) : "memory")
#define DS_RDTR(dst, addr, imm) asm volatile("ds_read_b64_tr_b16 %0, %1 offset:%c2" : "=&v"(dst) : "v"(addr), "i"(imm) : "memory")
constexpr int DA_KB = 0, DA_VB = 32768, DA_Q = 65536, DA_QP = 272, DA_QBUF = 32 * DA_QP, DA_TOTAL = DA_Q + 8 * DA_QBUF;
typedef short v4i16_t __attribute__((ext_vector_type(4)));
__device__ __forceinline__ s16x4 vtr(const LAS unsigned char* p) { return __builtin_bit_cast(s16x4, __builtin_amdgcn_ds_read_tr16_b64_v4i16((LAS v4i16_t*)p)); }
__device__ __forceinline__ float max3f(float a, float b, float c) { return fmaxf(fmaxf(a, b), c); }

__device__ __forceinline__ void da_unit(LAS unsigned char* lds, const bf16_t* Qp  , const bf16_t* KVp  , bf16_t* Op  , int qb, float lam, const float* subln, float slope, const unsigned* kmax2  ) {
    int tid_ = threadIdx.x; asm volatile("" : "+v"(tid_));
    const int tid = tid_, lane = tid & 63, q = lane & 31, hi = lane >> 5; const int w = __builtin_amdgcn_readfirstlane(tid >> 6);
    LAS unsigned char* Qw = lds + DA_Q + w * DA_QBUF;
    const unsigned ldsb = (unsigned)(uintptr_t)lds;
    unsigned voff[2];
#pragma unroll
    for (int i = 0; i < 2; ++i) { const int row = 8 * w + 4 * i + (lane >> 4); const int f = ((row & 3) << 2) | ((row >> 2) & 3); voff[i] = (unsigned)(row * 512 + 16 * ((lane & 15) ^ f)); }
    const char* const Pb = (const char*)KVp;
#define DA_DMA(kt, buf) do { const char* tb_ = Pb + (size_t)(kt) * (64 * 512); \
        _Pragma("unroll") for (int i_ = 0; i_ < 2; ++i_) { glds_s(tb_, voff[i_], ldsb + (unsigned)(DA_KB + (buf) * 16384 + (2 * w + i_) * 1024)); \
            glds_s(tb_ + 256, voff[i_], ldsb + (unsigned)(DA_VB + (buf) * 16384 + (2 * w + i_) * 1024)); } } while (0)
    const int nt = 4 * (qb + 1);
    DA_DMA(nt - 1, 0);
    {
        const float c1 = 0.125f * LOG2E;
#pragma unroll
        for (int i = 0; i < 8; ++i) { const int cid = lane + 64 * i, r = cid >> 4, ch = cid & 15;
            u32x4 v = *(const u32x4*)(Qp + (size_t)(qb * 256 + w * 32 + r) * 128 + 8 * ch);
            v.x = cvt_pk_bf16(bf_lo(v.x) * c1, bf_hi(v.x) * c1); v.y = cvt_pk_bf16(bf_lo(v.y) * c1, bf_hi(v.y) * c1);
            v.z = cvt_pk_bf16(bf_lo(v.z) * c1, bf_hi(v.z) * c1); v.w = cvt_pk_bf16(bf_lo(v.w) * c1, bf_hi(v.w) * c1);
            *(LAS u32x4*)(Qw + r * DA_QP + 16 * ch) = v; }
    }
    f32x16 o1[4], o2[4];
#pragma unroll
    for (int d = 0; d < 4; ++d) { o1[d] = (f32x16){}; o2[d] = (f32x16){}; }
    float m1 = -INFINITY, m2 = -INFINITY, l1 = 0.f, l2 = 0.f;
    const int tpos = qb * 256 + w * 32 + q;
    const float c2 = slope * LOG2E;
    const int F16 = 16 * (((q & 3) << 2) | ((q >> 2) & 3));
    const int kq = 256 * q;
    const int qq = (lane & 15) >> 2, g1 = (lane >> 4) & 1, pp = lane & 3;
    const int A0 = 256 * (4 * hi + qq) + 8 * (pp & 1);
    const int vbase0 = A0 + 16 * ((2 * g1 + (pp >> 1)) ^ hi), vbase1 = A0 + 2048 + 16 * ((2 * g1 + (pp >> 1)) ^ (hi + 2));
    asm volatile("s_waitcnt vmcnt(0)" ::: "memory");
    __syncthreads();
    float qb_[2];
#pragma unroll
    for (int mp = 0; mp < 2; ++mp) { float sq = 0.f;
#pragma unroll
        for (int d0 = 0; d0 < 4; ++d0) { const u32x4 f = *(const LAS u32x4*)(Qw + q * DA_QP + (64 * mp + 16 * d0 + 8 * hi) * 2);
            sq += (bf_lo(f.x) * bf_lo(f.x) + bf_hi(f.x) * bf_hi(f.x)) + (bf_lo(f.y) * bf_lo(f.y) + bf_hi(f.y) * bf_hi(f.y)) + (bf_lo(f.z) * bf_lo(f.z) + bf_hi(f.z) * bf_hi(f.z)) + (bf_lo(f.w) * bf_lo(f.w) + bf_hi(f.w) * bf_hi(f.w)); }
        sq += __shfl_xor(sq, 32);
        const float k2 = __uint_as_float(kmax2[2 * mp]) + __uint_as_float(kmax2[2 * mp + 1]);
        qb_[mp] = sqrtf(sq) * sqrtf(k2) * 1.001f + 0.01f; }
    const unsigned FH = (unsigned)(F16 ^ (16 * hi));
    const unsigned qaddr = (unsigned)(uintptr_t)Qw + (unsigned)(q * DA_QP + 16 * hi);
    const unsigned xq = 64u * (unsigned)qq;
#define DA_ISSUE_KQ(mp, kh) do { _Pragma("unroll") for (int d0_ = 0; d0_ < 4; ++d0_) { const unsigned ka_ = kcur + ((unsigned)(128 * (mp) + 32 * d0_) ^ FH); \
        DS_RD128(kf[d0_], ka_, 8192 * (kh)); DS_RD128(qf[d0_], qaddr, 128 * (mp) + 32 * d0_); } } while (0)
    for (int it = 0; it < nt; ++it) {
        const int kt = nt - 1 - it, cur = it & 1;
        if (kt > 0) DA_DMA(kt - 1, cur ^ 1);
        if ((kt - 4 * qb) <= (w >> 1)) {
            const bool band = kt >= 4 * qb;
            const unsigned kcur = ldsb + (unsigned)(DA_KB + cur * 16384 + kq);
            const unsigned vcur = ldsb + (unsigned)(DA_VB + cur * 16384);
#pragma unroll
            for (int kh = 1; kh >= 0; --kh) {
                f32x16 s[2];
#pragma unroll
                for (int mp = 0; mp < 2; ++mp) {
                    bf16x8 kf[4], qf[4];
                    DA_ISSUE_KQ(mp, kh);
                    asm volatile("s_waitcnt lgkmcnt(0)" : "+v"(kf[0]), "+v"(kf[1]), "+v"(kf[2]), "+v"(kf[3]), "+v"(qf[0]), "+v"(qf[1]), "+v"(qf[2]), "+v"(qf[3]) :: "memory");
                    s[mp] = (f32x16){};
#pragma unroll
                    for (int d0 = 0; d0 < 4; ++d0) s[mp] = __builtin_amdgcn_mfma_f32_32x32x16_bf16(kf[d0], qf[d0], s[mp], 0, 0, 0);
                }
                float off, mx[2]; bool doit[2];
                if (band) off = 0.f; else off = c2 * (float)(kt * 64 + 32 * kh + 4 * hi - tpos);
#pragma unroll
                for (int mp = 0; mp < 2; ++mp) {
                    if (band) { const float dbase = (float)(tpos - kt * 64 - 32 * kh - 4 * hi);
#pragma unroll
                        for (int r = 0; r < 16; ++r) s[mp][r] = s[mp][r] - c2 * fabsf(dbase - (float)crow(r, 0));
                    } else {
#pragma unroll
                        for (int r = 0; r < 16; ++r) s[mp][r] = fmaf(c2, (float)crow(r, 0), s[mp][r]);
                    }
                    float m_ = max3f(s[mp][0], s[mp][1], s[mp][2]);
#pragma unroll
                    for (int r = 3; r < 15; r += 2) m_ = max3f(m_, s[mp][r], s[mp][r + 1]);
                    m_ = fmaxf(m_, s[mp][15]) + off;
                    { auto rr = __builtin_amdgcn_permlane32_swap(__float_as_uint(m_), __float_as_uint(m_), false, false); m_ = fmaxf(__uint_as_float(rr[0]), __uint_as_float(rr[1])); }
                    mx[mp] = m_;
                    doit[mp] = !__all(m_ - (mp ? m2 : m1) < -160.0f);
                }
                if (doit[0] || doit[1]) {
                    s16x4 va_lo[4], va_hi[4], vb_lo[4], vb_hi[4];
#define DA_ISSUE_V(lo_, hi_, dbase_) do { _Pragma("unroll") for (int d_ = 0; d_ < 2; ++d_) { const unsigned xd_ = vcur + ((unsigned)(64 * ((dbase_) + d_)) ^ xq); const unsigned a0_ = xd_ + (unsigned)vbase0, a1_ = xd_ + (unsigned)vbase1; \
                        _Pragma("unroll") for (int j_ = 0; j_ < 2; ++j_) { DS_RDTR(lo_[2 * d_ + j_], a0_, 8192 * kh + 4096 * j_); DS_RDTR(hi_[2 * d_ + j_], a1_, 8192 * kh + 4096 * j_); } } } while (0)
                    DA_ISSUE_V(va_lo, va_hi, 0); DA_ISSUE_V(vb_lo, vb_hi, 2);
                    float dd[2];
#pragma unroll
                    for (int mp = 0; mp < 2; ++mp) {
                        float& mref = mp ? m2 : m1; float& lref = mp ? l2 : l1;
                        if (doit[mp]) {
                            const float mnew = fmaxf(mref, mx[mp]);
                            if (__any(mnew > mref)) { const float alpha = fast_exp2(mref - mnew); lref *= alpha;
#pragma unroll
                                for (int d = 0; d < 4; ++d) { if (mp) o2[d] *= alpha; else o1[d] *= alpha; }
                                mref = mnew; }
                            dd[mp] = off - mnew;
                        } else dd[mp] = -INFINITY;
                    }
                    bf16x8 pk[2][2];
                    typedef float f32x8 __attribute__((ext_vector_type(8))); typedef float f32x2v __attribute__((ext_vector_type(2)));
#define DA_SOFTMAX(mp_, lref_) do { s[mp_] = s[mp_] + dd[mp_]; \
                        _Pragma("unroll") for (int r = 0; r < 16; ++r) s[mp_][r] = fast_exp2(s[mp_][r]); \
                        { const f32x8 h8 = __builtin_shufflevector(s[mp_], s[mp_], 0, 1, 2, 3, 4, 5, 6, 7) + __builtin_shufflevector(s[mp_], s[mp_], 8, 9, 10, 11, 12, 13, 14, 15); \
                          const f32x4 h4 = __builtin_shufflevector(h8, h8, 0, 1, 2, 3) + __builtin_shufflevector(h8, h8, 4, 5, 6, 7); \
                          const f32x2v h2 = __builtin_shufflevector(h4, h4, 0, 1) + __builtin_shufflevector(h4, h4, 2, 3); lref_ += h2[0] + h2[1]; } \
                        _Pragma("unroll") for (int j = 0; j < 2; ++j) { u32x4 pw; pw.x = cvt_pk_bf16(s[mp_][8 * j + 0], s[mp_][8 * j + 1]); pw.y = cvt_pk_bf16(s[mp_][8 * j + 2], s[mp_][8 * j + 3]); \
                            pw.z = cvt_pk_bf16(s[mp_][8 * j + 4], s[mp_][8 * j + 5]); pw.w = cvt_pk_bf16(s[mp_][8 * j + 6], s[mp_][8 * j + 7]); pk[mp_][j] = __builtin_bit_cast(bf16x8, pw); } } while (0)
                    DA_SOFTMAX(0, l1);
                    asm volatile("s_waitcnt lgkmcnt(0)" : "+v"(va_lo[0]), "+v"(va_lo[1]), "+v"(va_lo[2]), "+v"(va_lo[3]), "+v"(va_hi[0]), "+v"(va_hi[1]), "+v"(va_hi[2]), "+v"(va_hi[3]),
                                 "+v"(vb_lo[0]), "+v"(vb_lo[1]), "+v"(vb_lo[2]), "+v"(vb_lo[3]), "+v"(vb_hi[0]), "+v"(vb_hi[1]), "+v"(vb_hi[2]), "+v"(vb_hi[3]) :: "memory");
                    bf16x8 vf[4][2];
#pragma unroll
                    for (int d = 0; d < 4; ++d)
#pragma unroll
                        for (int j = 0; j < 2; ++j) { const s16x4 lo = (d < 2) ? va_lo[2 * d + j] : vb_lo[2 * (d - 2) + j], hh = (d < 2) ? va_hi[2 * d + j] : vb_hi[2 * (d - 2) + j];
                            vf[d][j] = (bf16x8){lo[0], lo[1], lo[2], lo[3], hh[0], hh[1], hh[2], hh[3]}; }
#pragma unroll
                    for (int d = 0; d < 4; ++d)
#pragma unroll
                        for (int j = 0; j < 2; ++j) o1[d] = __builtin_amdgcn_mfma_f32_32x32x16_bf16(vf[d][j], pk[0][j], o1[d], 0, 0, 0);
                    DA_SOFTMAX(1, l2);
#pragma unroll
                    for (int g = 0; g < 8; ++g) { __builtin_amdgcn_sched_group_barrier(0x8, 1, 0); __builtin_amdgcn_sched_group_barrier(0x2, 6, 0); }
#pragma unroll
                    for (int d = 0; d < 4; ++d)
#pragma unroll
                        for (int j = 0; j < 2; ++j) o2[d] = __builtin_amdgcn_mfma_f32_32x32x16_bf16(vf[d][j], pk[1][j], o2[d], 0, 0, 0);
#undef DA_SOFTMAX
#undef DA_ISSUE_V
                }
                __builtin_amdgcn_sched_barrier(0);
            }
        }
        asm volatile("s_waitcnt vmcnt(0)" ::: "memory");
        bool okw = false;
        if (kt >= 1 && kt - 1 < 4 * qb) { const float bias = -c2 * (float)(tpos - (64 * (kt - 1) + 63));
            okw = __all((qb_[0] + bias - m1 < -160.0f) && (qb_[1] + bias - m2 < -160.0f)); }
        if (__syncthreads_and(okw ? 1 : 0)) break;
    }
#undef DA_ISSUE_KQ
#undef DA_DMA
    bf16_t* orow = Op + (size_t)(qb * 256 + w * 32 + q) * 512;
    l1 += __shfl_xor(l1, 32); l2 += __shfl_xor(l2, 32);
    const float i1 = 1.0f / l1, i2 = lam / l2; float ss = 0.f;
#pragma unroll
    for (int d = 0; d < 4; ++d)
#pragma unroll
        for (int r = 0; r < 16; ++r) { const float v = o1[d][r] * i1 - o2[d][r] * i2; o1[d][r] = v; ss += v * v; }
    ss += __shfl_xor(ss, 32);
    const float rs = (1.0f / sqrtf(ss * (1.0f / 128.0f) + EPS)) * (1.0f - LAMBDA_INIT);
#pragma unroll
    for (int d = 0; d < 4; ++d)
#pragma unroll
        for (int gq = 0; gq < 4; ++gq) { const int dd = 32 * d + 8 * gq + 4 * hi; const f32x4 sl = *(const f32x4*)(subln + dd);
            u32x2 wv; wv.x = cvt_pk_bf16(o1[d][4 * gq] * rs * sl[0], o1[d][4 * gq + 1] * rs * sl[1]); wv.y = cvt_pk_bf16(o1[d][4 * gq + 2] * rs * sl[2], o1[d][4 * gq + 3] * rs * sl[3]);
            *(u32x2*)(orow + dd) = wv; }
}

__device__ __forceinline__ void sb_unit(LAS unsigned char* lds, const bf16_t* Qp  , const bf16_t* KVp  , bf16_t* Op  , int qb) {
    int tid_ = threadIdx.x; asm volatile("" : "+v"(tid_));
    const int tid = tid_, lane = tid & 63, q = lane & 31, hi = lane >> 5; const int w = __builtin_amdgcn_readfirstlane(tid >> 6);
    const int t0 = qb * 256 + w * 32, tpos = t0 + q;
    const unsigned vbuf = (unsigned)(uintptr_t)lds + (unsigned)w * 16384u;
    bf16x8 qf[4];
#pragma unroll
    for (int d0 = 0; d0 < 4; ++d0) { u32x4 v = *(const u32x4*)(Qp + (size_t)tpos * 64 + 16 * d0 + 8 * hi);
        v.x = cvt_pk_bf16(bf_lo(v.x) * 0.125f, bf_hi(v.x) * 0.125f); v.y = cvt_pk_bf16(bf_lo(v.y) * 0.125f, bf_hi(v.y) * 0.125f);
        v.z = cvt_pk_bf16(bf_lo(v.z) * 0.125f, bf_hi(v.z) * 0.125f); v.w = cvt_pk_bf16(bf_lo(v.w) * 0.125f, bf_hi(v.w) * 0.125f);
        qf[d0] = __builtin_bit_cast(bf16x8, v); }
    const unsigned voffV = (unsigned)((lane >> 3) * 256 + 16 * ((lane & 7) ^ (lane >> 3)));
    const unsigned voffK = (unsigned)(q * 256 + 16 * hi);
    const char* const Pb = (const char*)KVp;
#define SB_DMA_V(kt, buf) do { const char* tb_ = Pb + (size_t)(kt) * (64 * 256) + 128; \
        _Pragma("unroll") for (int I_ = 0; I_ < 8; ++I_) glds_s(tb_ + 2048 * I_, voffV, vbuf + (unsigned)((buf) * 8192 + 1024 * I_)); } while (0)
#define SB_LOAD_K(dst, kt) do { const char* tb_ = Pb + (size_t)(kt) * (64 * 256); \
        _Pragma("unroll") for (int kh_ = 0; kh_ < 2; ++kh_) _Pragma("unroll") for (int d0_ = 0; d0_ < 4; ++d0_) dst[kh_ * 4 + d0_] = *(const u32x4*)(tb_ + voffK + 8192 * kh_ + 32 * d0_); } while (0)
    const int kt_first = t0 >> 6;
    int kt = kt_first, buf = 0;
    u32x4 kf[8], kfn[8];
    SB_LOAD_K(kf, kt); SB_DMA_V(kt, 0);
#pragma unroll
    for (int i = 0; i < 8; ++i) kfn[i] = kf[i];
    f32x16 o[2]; o[0] = (f32x16){}; o[1] = (f32x16){};
    float carry = 0.f;
    const int qq = (lane & 15) >> 2, g1 = (lane >> 4) & 1, pp = lane & 3;
    const unsigned vb = (unsigned)(128 * (4 * hi + qq) + 16 * ((2 * g1 + (pp >> 1)) ^ qq) + 8 * (pp & 1));
    const unsigned vb0 = vb + 64u * (unsigned)hi, vb1 = vb + 64u - 64u * (unsigned)hi;
    for (;;) {
        asm volatile("s_waitcnt vmcnt(0)" ::: "memory");
        if (kt > 0) { SB_LOAD_K(kfn, kt - 1); SB_DMA_V(kt - 1, buf ^ 1); }
        const unsigned vcur = vbuf + (unsigned)(buf * 8192);
#pragma unroll
        for (int kh = 1; kh >= 0; --kh) {
            if (kh == 1 && kt == kt_first && !(t0 & 32)) continue;
            f32x16 s = (f32x16){};
#pragma unroll
            for (int d0 = 0; d0 < 4; ++d0) s = __builtin_amdgcn_mfma_f32_32x32x16_bf16(__builtin_bit_cast(bf16x8, kf[kh * 4 + d0]), qf[d0], s, 0, 0, 0);
            s16x4 vlo[4], vhi[4];
#pragma unroll
            for (int d = 0; d < 2; ++d) { const unsigned a_ = vcur + (d ? vb1 : vb0);
#pragma unroll
                for (int j = 0; j < 2; ++j) { DS_RDTR(vlo[2 * d + j], a_, 4096 * kh + 2048 * j); DS_RDTR(vhi[2 * d + j], a_, 4096 * kh + 2048 * j + 1024); } }
            float sp[16];
#pragma unroll
            for (int r = 0; r < 16; ++r) { const float z = s[r]; const bool valid = (kt * 64 + 32 * kh + crow(r, hi)) < tpos;
                const float a = fabsf(z); const float e = fast_exp2(-a * LOG2E); const float spv = fmaxf(z, 0.f) + fast_log2(1.0f + e) * LN2; sp[r] = valid ? spv : 0.f; }
            float G[4], Gp[4];
#pragma unroll
            for (int i = 0; i < 4; ++i) { G[i] = (sp[4 * i] + sp[4 * i + 1]) + (sp[4 * i + 2] + sp[4 * i + 3]); Gp[i] = __shfl_xor(G[i], 32); }
            float after = 0.f;
#pragma unroll
            for (int i = 3; i >= 0; --i) { float run = carry + after + (hi == 0 ? Gp[i] : 0.f);
#pragma unroll
                for (int j = 3; j >= 0; --j) { const int r = 4 * i + j; run += sp[r]; const bool valid = (kt * 64 + 32 * kh + crow(r, hi)) < tpos;
                    const float wv = fast_exp2((s[r] - run) * LOG2E); s[r] = valid ? wv : 0.f; }
                after += G[i] + Gp[i]; }
            carry += after;
            bf16x8 pk[2];
#pragma unroll
            for (int j = 0; j < 2; ++j) { u32x4 pw; pw.x = cvt_pk_bf16(s[8 * j + 0], s[8 * j + 1]); pw.y = cvt_pk_bf16(s[8 * j + 2], s[8 * j + 3]);
                pw.z = cvt_pk_bf16(s[8 * j + 4], s[8 * j + 5]); pw.w = cvt_pk_bf16(s[8 * j + 6], s[8 * j + 7]);
                pk[j] = __builtin_bit_cast(bf16x8, pw); }
            asm volatile("s_waitcnt lgkmcnt(0)" : "+v"(vlo[0]), "+v"(vlo[1]), "+v"(vlo[2]), "+v"(vlo[3]), "+v"(vhi[0]), "+v"(vhi[1]), "+v"(vhi[2]), "+v"(vhi[3]) :: "memory");
#pragma unroll
            for (int d = 0; d < 2; ++d)
#pragma unroll
                for (int j = 0; j < 2; ++j) { const s16x4 lo = vlo[2 * d + j], hh = vhi[2 * d + j];
                    const bf16x8 vf = (bf16x8){lo[0], lo[1], lo[2], lo[3], hh[0], hh[1], hh[2], hh[3]};
                    o[d] = __builtin_amdgcn_mfma_f32_32x32x16_bf16(vf, pk[j], o[d], 0, 0, 0); }
        }
        if (kt == 0 || __all(carry > 110.0f)) break;
#pragma unroll
        for (int i = 0; i < 8; ++i) kf[i] = kfn[i];
        --kt; buf ^= 1;
    }
    asm volatile("s_waitcnt vmcnt(0)" ::: "memory");
#undef SB_DMA_V
#undef SB_LOAD_K
    bf16_t* orow = Op + (size_t)tpos * 512;
#pragma unroll
    for (int d = 0; d < 2; ++d)
#pragma unroll
        for (int gq = 0; gq < 4; ++gq) { const int dd = 32 * d + 8 * gq + 4 * hi;
            u32x2 wv; wv.x = cvt_pk_bf16(o[d][4 * gq], o[d][4 * gq + 1]); wv.y = cvt_pk_bf16(o[d][4 * gq + 2], o[d][4 * gq + 3]);
            *(u32x2*)(orow + dd) = wv; }
}
}

constexpr int NWAVES = 8, NTHREADS = 512;
constexpr int LDS_BYTES = 143360;
static_assert(att::DA_TOTAL <= LDS_BYTES - 64 && pg8::STAGE_BYTES <= LDS_BYTES - 64, "LDS map");

__device__ __forceinline__ void p0_transpose_item(const float* W, int K, int N, bf16_t* WT, int il  , LAS float* scr, int item, int lane) {
    const int nblk = N / 32, kb = item / nblk, nb = item % nblk, k0 = 64 * kb, n0 = 32 * nb;
    f32x4 v[8];
#pragma unroll
    for (int i = 0; i < 8; ++i) v[i] = *(const f32x4*)(W + (size_t)(k0 + 8 * i + (lane >> 3)) * N + n0 + 4 * (lane & 7));
#pragma unroll
    for (int i = 0; i < 8; ++i) { LAS float* d = scr + (8 * i + (lane >> 3)) * 33 + 4 * (lane & 7); d[0] = v[i][0]; d[1] = v[i][1]; d[2] = v[i][2]; d[3] = v[i][3]; }
    asm volatile("s_waitcnt lgkmcnt(0)" ::: "memory");
    const int c = lane & 7;
    const int rbase = il ? (256 * (n0 / 128) + 128 * (il - 1) + (n0 % 128)) : n0;
#pragma unroll
    for (int j = 0; j < 4; ++j) { const int n = (lane >> 3) + 8 * j; const LAS float* s = scr + (8 * c) * 33 + n;
        u32x4 o; o.x = cvt_pk_bf16(s[0 * 33], s[1 * 33]); o.y = cvt_pk_bf16(s[2 * 33], s[3 * 33]); o.z = cvt_pk_bf16(s[4 * 33], s[5 * 33]); o.w = cvt_pk_bf16(s[6 * 33], s[7 * 33]);
        *(u32x4*)(WT + (size_t)(rbase + n) * K + k0 + 8 * c) = o; }
    asm volatile("s_waitcnt lgkmcnt(0)" ::: "memory");
}

#ifndef PROBE_MASK
#define PROBE_MASK 0
#endif
#define TSTART() unsigned long long t0_ = (PROBE_MASK != 0) ? __builtin_amdgcn_s_memrealtime() : 0ull
#define TEND(k) do { if (PROBE_MASK & (1 << (k))) { const unsigned long long t1_ = __builtin_amdgcn_s_memrealtime(); const unsigned long long dt_ = t1_ - t0_; while (__builtin_amdgcn_s_memrealtime() - t1_ < dt_) __builtin_amdgcn_s_sleep(8); } if (PROBE_MASK != 0) t0_ = __builtin_amdgcn_s_memrealtime(); } while (0)
struct Args { const float* in[21]; float* out; float* modp; float* SS; bf16_t* Wgu[2]; bf16_t* Wd[2]; bf16_t* Win; bf16_t* Wsb; bf16_t* Wda; bf16_t* Wout; bf16_t* U; bf16_t* Y; bf16_t* BIG; bf16_t* Qsb; bf16_t* KVsb; bf16_t* Qda; bf16_t* KVda; bf16_t* Gt; bf16_t* ya; bf16_t* yd; unsigned* ctr; unsigned* kmax2; unsigned* bar; bf16_t* Mg; bf16_t* Y2; bf16_t* Y3; };

template <bool HAS_Y, bool HAS_NEXT, bool HIN_BF16, bool HOUT_BF16>
__device__ __forceinline__ void rowwise_phase(LAS unsigned char* lds, int vcu, int G, const void* hin_, void* hout_, const bf16_t* Y, const float* SS,
                                              const float* modp, const float* npost, const float* npre, int isub, float rw, bf16_t* U) {
    int tid_ = threadIdx.x; asm volatile("" : "+v"(tid_));
    const int tid = tid_, lane = tid & 63, wave = __builtin_amdgcn_readfirstlane(tid >> 6);
    LAS float* vA = (LAS float*)lds; LAS float* vB = vA + 1024; LAS float* vC = vB + 1024;
    for (int rb = vcu; rb < MT / 256; rb += G) {
        const int b = rb >> 5;
        for (int n = tid; n < DM; n += NTHREADS) {
            if (HAS_Y) { float gsum = 0.f;
#pragma unroll
                for (int kc = 0; kc < 16; ++kc) gsum += modp[(size_t)(kc * 8 + b) * NMOD + (isub * 3 + 2) * DM + n];
                vA[n] = rw * gsum * npost[isub * DM + n]; }
            if (HAS_NEXT) { const int jn = isub + 1; float sc = 0.f, sh = 0.f;
#pragma unroll
                for (int kc = 0; kc < 16; ++kc) { sh += modp[(size_t)(kc * 8 + b) * NMOD + (jn * 3 + 0) * DM + n]; sc += modp[(size_t)(kc * 8 + b) * NMOD + (jn * 3 + 1) * DM + n]; }
                vB[n] = npre[jn * DM + n] * (1.0f + sc); vC[n] = sh; }
        }
        __syncthreads();
        f32x4 a[4], bb[4], cc[4];
#pragma unroll
        for (int j = 0; j < 4; ++j) { const int c0 = 4 * lane + 256 * j;
            a[j] = HAS_Y ? *(const LAS f32x4*)(vA + c0) : (f32x4){0.f, 0.f, 0.f, 0.f};
            bb[j] = HAS_NEXT ? *(const LAS f32x4*)(vB + c0) : (f32x4){0.f, 0.f, 0.f, 0.f};
            cc[j] = HAS_NEXT ? *(const LAS f32x4*)(vC + c0) : (f32x4){0.f, 0.f, 0.f, 0.f}; }
        for (int rr = 0; rr < 32; rr += 2) {
            f32x4 hv[2][4]; u32x2 yv[2][4]; float rsy[2];
#pragma unroll
            for (int u = 0; u < 2; ++u) { const size_t row = (size_t)rb * 256 + wave * 32 + rr + u;
#pragma unroll
                for (int j = 0; j < 4; ++j) {
                    if (HIN_BF16) { const u32x2 t = *(const u32x2*)((const bf16_t*)hin_ + row * DM + 4 * lane + 256 * j); hv[u][j] = (f32x4){bf_lo(t.x), bf_hi(t.x), bf_lo(t.y), bf_hi(t.y)}; }
                    else hv[u][j] = *(const f32x4*)((const float*)hin_ + row * DM + 4 * lane + 256 * j);
                    if (HAS_Y) yv[u][j] = *(const u32x2*)(Y + row * DM + 4 * lane + 256 * j); }
                if (HAS_Y) { const f32x4 s0 = *(const f32x4*)(SS + row * 16), s1 = *(const f32x4*)(SS + row * 16 + 4), s2 = *(const f32x4*)(SS + row * 16 + 8), s3 = *(const f32x4*)(SS + row * 16 + 12);
                    const float ssum = ((s0[0] + s0[1]) + (s0[2] + s0[3])) + ((s1[0] + s1[1]) + (s1[2] + s1[3])) + ((s2[0] + s2[1]) + (s2[2] + s2[3])) + ((s3[0] + s3[1]) + (s3[2] + s3[3]));
                    rsy[u] = 1.0f / sqrtf(ssum * (1.0f / DM) + EPS); } }
            asm volatile("" ::: "memory");
#pragma unroll
            for (int u = 0; u < 2; ++u) { const size_t row = (size_t)rb * 256 + wave * 32 + rr + u;
                if (HAS_Y) {
#pragma unroll
                    for (int j = 0; j < 4; ++j) { hv[u][j][0] += a[j][0] * (bf_lo(yv[u][j].x) * rsy[u]); hv[u][j][1] += a[j][1] * (bf_hi(yv[u][j].x) * rsy[u]);
                        hv[u][j][2] += a[j][2] * (bf_lo(yv[u][j].y) * rsy[u]); hv[u][j][3] += a[j][3] * (bf_hi(yv[u][j].y) * rsy[u]);
                        if (HOUT_BF16) { u32x2 o; o.x = cvt_pk_bf16(hv[u][j][0], hv[u][j][1]); o.y = cvt_pk_bf16(hv[u][j][2], hv[u][j][3]);
                            *(u32x2*)((bf16_t*)hout_ + row * DM + 4 * lane + 256 * j) = o;
                            hv[u][j] = (f32x4){bf_lo(o.x), bf_hi(o.x), bf_lo(o.y), bf_hi(o.y)}; }
                        else *(f32x4*)((float*)hout_ + row * DM + 4 * lane + 256 * j) = hv[u][j]; }
                }
                if (HAS_NEXT) {
                    float s = 0.f;
#pragma unroll
                    for (int j = 0; j < 4; ++j) s += (hv[u][j][0] * hv[u][j][0] + hv[u][j][1] * hv[u][j][1]) + (hv[u][j][2] * hv[u][j][2] + hv[u][j][3] * hv[u][j][3]);
                    const float rs = 1.0f / sqrtf(wave_sum(s) * (1.0f / DM) + EPS);
#pragma unroll
                    for (int j = 0; j < 4; ++j) { u32x2 o; o.x = cvt_pk_bf16(hv[u][j][0] * rs * bb[j][0] + cc[j][0], hv[u][j][1] * rs * bb[j][1] + cc[j][1]);
                        o.y = cvt_pk_bf16(hv[u][j][2] * rs * bb[j][2] + cc[j][2], hv[u][j][3] * rs * bb[j][3] + cc[j][3]);
                        *(u32x2*)(U + row * DM + 4 * lane + 256 * j) = o; }
                }
            }
        }
        __syncthreads();
    }
}

#define XB_TMO      128
#define XB_XCNT(j)  (256  + 64 * (j))
#define XB_XSUB(j)  (1280 + 64 * (j))
#define XB_XGEN(j)  (2304 + 64 * (j))
#define XB_TOP      3328
#define XB_TOPGEN   3392
#define XCD_BAR_WORDS 3456
#define XB_SPIN_CAP (1u << 18)

__device__ __forceinline__ unsigned xb_ld(unsigned* p)              { return __hip_atomic_load(p, __ATOMIC_RELAXED, __HIP_MEMORY_SCOPE_AGENT); }
__device__ __forceinline__ unsigned xb_add(unsigned* p, unsigned v) { return __hip_atomic_fetch_add(p, v, __ATOMIC_RELAXED, __HIP_MEMORY_SCOPE_AGENT); }
__device__ __forceinline__ unsigned xb_xcc_id() { return (unsigned)__builtin_amdgcn_s_getreg((3 << 11) | 20) & 0xFu; }
#define XB_SPIN(cond, bar) do { unsigned _sp = 0; while (cond) { __builtin_amdgcn_s_sleep(1); \
    if ((++_sp & 255u) == 0u) { if (xb_ld(&(bar)[XB_TMO])) break; if (_sp > XB_SPIN_CAP) { atomicAdd(&(bar)[XB_TMO], 1u); break; } } } } while (0)

struct XcdBarrier {
    unsigned* bar; unsigned x;
    volatile LAS unsigned* st;
};

__device__ __forceinline__ XcdBarrier xcd_barrier_post(unsigned* bar, volatile LAS unsigned* st) {
    XcdBarrier b; b.bar = bar; b.x = xb_xcc_id(); b.st = st;
    if (threadIdx.x == 0) (void)xb_add(&bar[XB_XCNT(b.x)], 1u);
    return b;
}
__device__ __forceinline__ void xcd_barrier_complete(unsigned* bar, unsigned x, unsigned& nloc, unsigned& nx) {
    const unsigned G = gridDim.x * gridDim.y * gridDim.z;
    unsigned sum, cnt, mine, sp = 0u;
    for (;;) {
        sum = 0u; cnt = 0u; mine = 0u;
#pragma unroll
        for (unsigned j = 0; j < 16; ++j) { const unsigned c = xb_ld(&bar[XB_XCNT(j)]); sum += c; cnt += (c > 0u) ? 1u : 0u; mine = (j == x) ? c : mine; }
        if (sum == G) break;
        __builtin_amdgcn_s_sleep(1);
        if ((++sp & 255u) == 0u) { if (xb_ld(&bar[XB_TMO])) break; if (sp > XB_SPIN_CAP) { atomicAdd(&bar[XB_TMO], 1u); break; } }
    }
    nloc = mine > 0u ? mine : 1u; nx = cnt > 0u ? cnt : 1u;
}

__device__ __forceinline__ void xcd_barrier(const XcdBarrier& b) {
    asm volatile("s_waitcnt vmcnt(0)" ::: "memory");
    __syncthreads();
    if (threadIdx.x == 0) {
        unsigned* bar = b.bar;
        __builtin_amdgcn_s_waitcnt(0);
        unsigned nloc = b.st[0], nx = b.st[1];
        if (nloc == 0u) { xcd_barrier_complete(bar, b.x, nloc, nx); b.st[0] = nloc; b.st[1] = nx; }
        const unsigned old = xb_add(&bar[XB_XSUB(b.x)], 1u);
        const unsigned gen = old / nloc;
        if (old + 1u == (gen + 1u) * nloc) {
            __builtin_amdgcn_fence(__ATOMIC_RELEASE, "agent");
            asm volatile("s_waitcnt vmcnt(0)" ::: "memory");
            const unsigned og = xb_add(&bar[XB_TOP], 1u);
            const unsigned tg = og / nx;
            if (og + 1u == (tg + 1u) * nx) xb_add(&bar[XB_TOPGEN], 1u);
            else XB_SPIN(xb_ld(&bar[XB_TOPGEN]) == tg, bar);
            __builtin_amdgcn_fence(__ATOMIC_ACQUIRE, "agent");
            xb_add(&bar[XB_XGEN(b.x)], 1u);
            asm volatile("s_waitcnt vmcnt(0)" ::: "memory");
        } else {
            XB_SPIN(xb_ld(&bar[XB_XGEN(b.x)]) == gen, bar);
            __builtin_amdgcn_fence(__ATOMIC_ACQUIRE, "agent");
            asm volatile("s_waitcnt vmcnt(0)" ::: "memory");
        }
    }
    __syncthreads();
}


__global__ void __launch_bounds__(NTHREADS, 2) fwd_megakernel(Args args) {
    extern __shared__ __attribute__((aligned(16))) unsigned char lds_raw[];
    LAS unsigned char* lds = (LAS unsigned char*)lds_raw;
    cg::grid_group grid = cg::this_grid();
    const int tid = threadIdx.x, lane = tid & 63, wave = __builtin_amdgcn_readfirstlane(tid >> 6);
    const int G = gridDim.x, bx = blockIdx.x; const int vcu = (G % 8 == 0) ? (bx % 8) * (G / 8) + bx / 8 : bx;
    TSTART();
    volatile LAS unsigned* xst = (volatile LAS unsigned*)(lds + (LDS_BYTES - 32));
    if (tid < 2) xst[tid] = 0u;
    if (bx == 0) for (int i = tid; i < XCD_BAR_WORDS; i += NTHREADS) __hip_atomic_store(args.bar + i, 0u, __ATOMIC_RELAXED, __HIP_MEMORY_SCOPE_AGENT);
    if (bx == 0 && tid == 0) __hip_atomic_store(args.ctr, 0u, __ATOMIC_RELAXED, __HIP_MEMORY_SCOPE_AGENT);
    if (bx == 0 && tid < 128) __hip_atomic_store(args.kmax2 + tid, 0u, __ATOMIC_RELAXED, __HIP_MEMORY_SCOPE_AGENT);
    {
        LAS float* scr = (LAS float*)(lds + wave * 8448);
        const int gw = vcu * NWAVES + wave, NGW = G * NWAVES;
        constexpr int I_G = (DM / 64) * (DFF / 32), I_D = (DFF / 64) * (DM / 32), I_IN = (DM / 64) * (INW / 32), I_BR = (512 / 64) * (DM / 32), I_O = (DM / 64) * (DM / 32);
        constexpr int NITEMS = 4 * I_G + 2 * I_D + I_IN + 2 * I_BR + I_O;
        for (int it = gw; it < NITEMS; it += NGW) {
            int r = it;
            if (r < I_G) { p0_transpose_item(args.in[6], DM, DFF, args.Wgu[0], 1, scr, r, lane); continue; } r -= I_G;
            if (r < I_G) { p0_transpose_item(args.in[7], DM, DFF, args.Wgu[0], 2, scr, r, lane); continue; } r -= I_G;
            if (r < I_G) { p0_transpose_item(args.in[18], DM, DFF, args.Wgu[1], 1, scr, r, lane); continue; } r -= I_G;
            if (r < I_G) { p0_transpose_item(args.in[19], DM, DFF, args.Wgu[1], 2, scr, r, lane); continue; } r -= I_G;
            if (r < I_D) { p0_transpose_item(args.in[8], DFF, DM, args.Wd[0], 0, scr, r, lane); continue; } r -= I_D;
            if (r < I_D) { p0_transpose_item(args.in[20], DFF, DM, args.Wd[1], 0, scr, r, lane); continue; } r -= I_D;
            if (r < I_IN) { p0_transpose_item(args.in[9], DM, INW, args.Win, 0, scr, r, lane); continue; } r -= I_IN;
            if (r < I_BR) { p0_transpose_item(args.in[15], 512, DM, args.Wsb, 0, scr, r, lane); continue; } r -= I_BR;
            if (r < I_BR) { p0_transpose_item(args.in[16], 512, DM, args.Wda, 0, scr, r, lane); continue; } r -= I_BR;
            p0_transpose_item(args.in[17], DM, DM, args.Wout, 0, scr, r, lane);
        }
        LAS float* sc = (LAS float*)(lds + 69632);
        for (int i = tid; i < NB * DM; i += NTHREADS) { const float cv = args.in[1][i]; sc[i] = cv * sigmoidf_(cv); }
        __syncthreads();
        for (int task = bx * NTHREADS + tid; task < 16 * NMOD; task += G * NTHREADS) {
            const int kc = task / NMOD, n = task % NMOD;
            float acc[8];
#pragma unroll
            for (int b = 0; b < 8; ++b) acc[b] = 0.f;
            for (int k = kc * 64; k < kc * 64 + 64; ++k) { const float wv = args.in[2][(size_t)k * NMOD + n];
#pragma unroll
                for (int b = 0; b < 8; ++b) acc[b] += sc[b * DM + k] * wv; }
            if (kc == 0) { const float bv = args.in[3][n];
#pragma unroll
                for (int b = 0; b < 8; ++b) acc[b] += bv; }
#pragma unroll
            for (int b = 0; b < 8; ++b) args.modp[(size_t)(kc * 8 + b) * NMOD + n] = acc[b];
        }
    }
    TEND(0);
    grid.sync();
    (void)xcd_barrier_post(args.bar, xst);
#define GSYNC() do { XcdBarrier b_; b_.bar = args.bar; b_.x = xb_xcc_id(); b_.st = (volatile LAS unsigned*)(lds + (LDS_BYTES - 32)); xcd_barrier(b_); } while (0)

    TEND(10);
    rowwise_phase<false, true, false, false>(lds, vcu, G, args.in[0], nullptr, nullptr, nullptr, args.modp, args.in[5], args.in[4], -1, 0.f, args.U);
    TEND(1);
    GSYNC();
    TEND(10);

    for (int f = 0; f < 2; ++f) {
        { pg8::Gemm g{args.U, args.Wgu[f], MT, NGU, DM, DM}; pg8::StaticOrder S; S.init(MT, NGU, G, bx); pg8::EpiSwiGLU E{args.BIG}; pg8::gemm_phase(lds, g, S, E); }
        TEND(2);
        GSYNC();
        TEND(10);
        { pg8::Gemm g{args.BIG, args.Wd[f], MT, DM, DFF, DFF}; pg8::StaticOrder S; S.init(MT, DM, G, bx); pg8::EpiY E{f ? args.Y3 : args.Y, args.SS}; pg8::gemm_phase(lds, g, S, E); }
        TEND(3);
        GSYNC();
        TEND(10);
        if (f == 0) {
            rowwise_phase<true, true, false, true>(lds, vcu, G, args.in[0], args.Y, args.Y, args.SS, args.modp, args.in[5], args.in[4], 0, 0.5f, args.U);
            TEND(1);
            GSYNC();
            TEND(10);
            { pg8::Gemm g{args.U, args.Win, MT, INW, DM, DM}; pg8::StaticOrder S; S.init(MT, INW, G, bx); pg8::EpiProj E{args.Qsb, args.KVsb, args.Qda, args.KVda, args.Gt, args.kmax2}; pg8::gemm_phase(lds, g, S, E); }
            TEND(4);
            GSYNC();
            TEND(10);
            {
                float d1 = 0.f, d2 = 0.f;
                for (int i = 0; i < 64; ++i) { d1 += args.in[10][i] * args.in[11][i]; d2 += args.in[12][i] * args.in[13][i]; }
                const float lam = expf(d1) - expf(d2) + LAMBDA_INIT;
                LAS unsigned* slot = (LAS unsigned*)(lds + (LDS_BYTES - 16));
                for (;;) {
                    if (tid == 0) *slot = __hip_atomic_fetch_add(args.ctr, 1u, __ATOMIC_RELAXED, __HIP_MEMORY_SCOPE_AGENT);
                    __syncthreads();
                    const unsigned u = *slot;
                    __syncthreads();
                    if (u >= 3072u) break;
                    if (u < 1024u) { const int hh = 3 - (int)(u >> 8), rem = (int)(u & 255u), qb = 31 - (rem >> 3), bh = (rem & 7) * 4 + hh;
                        const float slope = exp2f(-2.0f * (float)(hh + 1));
                        att::da_unit(lds, args.Qda + (size_t)bh * SEQ * 128, args.KVda + (size_t)bh * SEQ * 256, args.yd + (size_t)(bh >> 2) * SEQ * 512 + 128 * hh, qb, lam, args.in[14], slope, args.kmax2 + bh * 4);
                    } else { const int v = (int)u - 1024, bh = v >> 5, qb = 31 - (v & 31);
                        att::sb_unit(lds, args.Qsb + (size_t)bh * SEQ * 64, args.KVsb + (size_t)bh * SEQ * 128, args.ya + (size_t)(bh >> 3) * SEQ * 512 + 64 * (bh & 7), qb); }
                }
            }
            TEND(5);
            GSYNC();
            TEND(10);
            { pg8::Gemm g{args.ya, args.Wsb, MT, DM, 512, 512}; pg8::StaticOrder S; S.init(MT, DM, G, bx); pg8::EpiGate<true> E{args.Mg, args.Gt, 0}; pg8::gemm_phase(lds, g, S, E); }
            __syncthreads();
            { pg8::Gemm g{args.yd, args.Wda, MT, DM, 512, 512}; pg8::StaticOrder S; S.init(MT, DM, G, bx); pg8::EpiGate<false> E{args.Mg, args.Gt, 1024}; pg8::gemm_phase(lds, g, S, E); }
            TEND(6);
            GSYNC();
            TEND(10);
            { pg8::Gemm g{args.Mg, args.Wout, MT, DM, DM, DM}; pg8::StaticOrder S; S.init(MT, DM, G, bx); pg8::EpiY E{args.Y2, args.SS}; pg8::gemm_phase(lds, g, S, E); }
            TEND(7);
            GSYNC();
            TEND(10);
            rowwise_phase<true, true, true, true>(lds, vcu, G, args.Y, args.Y, args.Y2, args.SS, args.modp, args.in[5], args.in[4], 1, 1.0f, args.U);
            TEND(1);
            GSYNC();
            TEND(10);
        } else {
            rowwise_phase<true, false, true, false>(lds, vcu, G, args.Y, args.out, args.Y3, args.SS, args.modp, args.in[5], args.in[4], 2, 0.5f, nullptr);
            TEND(1);
        }
    }
}

extern "C" void kernel_launch(void* const* d_in, const int* in_sizes, int n_in, void* d_out, int out_size, void* d_ws, size_t ws_size, hipStream_t stream) {
    static int grid = 0;
    if (grid == 0) {
        if (n_in != 21 || in_sizes[0] != MT * DM || out_size != MT * DM || ws_size < WS_END) {
            fprintf(stderr, "kernel_launch: unexpected shapes (n_in %d in0 %d out %d ws %zu); nothing launched\n", n_in, n_in > 0 ? in_sizes[0] : -1, out_size, ws_size); grid = -1; return; }
        int dev = 0, cus = 0, per_cu = 0;
        hipGetDevice(&dev);
        hipDeviceGetAttribute(&cus, hipDeviceAttributeMultiprocessorCount, dev);
        if (hipFuncSetAttribute((const void*)fwd_megakernel, hipFuncAttributeMaxDynamicSharedMemorySize, LDS_BYTES) != hipSuccess) fprintf(stderr, "kernel_launch: hipFuncSetAttribute failed\n");
        if (hipOccupancyMaxActiveBlocksPerMultiprocessor(&per_cu, (const void*)fwd_megakernel, NTHREADS, LDS_BYTES) != hipSuccess || per_cu < 1) { fprintf(stderr, "kernel_launch: occupancy query gave %d\n", per_cu); per_cu = 1; }
        (void)hipGetLastError();
        grid = cus * 1;
        if (grid <= 0) grid = 256;
    }
    if (grid < 0) return;
    Args a{};
    for (int i = 0; i < 21; ++i) a.in[i] = (const float*)d_in[i];
    unsigned char* ws = (unsigned char*)d_ws;
    a.out = (float*)d_out; a.modp = (float*)(ws + WS_MODP); a.SS = (float*)(ws + WS_SS);
    a.Wgu[0] = (bf16_t*)(ws + WS_WGU1); a.Wgu[1] = (bf16_t*)(ws + WS_WGU2); a.Wd[0] = (bf16_t*)(ws + WS_WD1); a.Wd[1] = (bf16_t*)(ws + WS_WD2);
    a.Win = (bf16_t*)(ws + WS_WIN); a.Wsb = (bf16_t*)(ws + WS_WSB); a.Wda = (bf16_t*)(ws + WS_WDA); a.Wout = (bf16_t*)(ws + WS_WOUT);
    a.U = (bf16_t*)(ws + WS_U); a.Y = (bf16_t*)(ws + WS_Y); a.BIG = (bf16_t*)(ws + WS_BIG);
    a.Qsb = (bf16_t*)(ws + WS_BIG); a.KVsb = (bf16_t*)(ws + WS_BIG + 64 * MiB); a.Qda = (bf16_t*)(ws + WS_BIG + 192 * MiB); a.KVda = (bf16_t*)(ws + WS_BIG + 256 * MiB); a.Gt = (bf16_t*)(ws + WS_BIG + 384 * MiB);
    a.ctr = (unsigned*)ws; a.kmax2 = (unsigned*)(ws + 4096); a.bar = (unsigned*)(ws + 16384);
    a.ya = (bf16_t*)(ws + WS_U); a.yd = (bf16_t*)(ws + WS_U + 64 * MiB);
    a.Mg = (bf16_t*)(ws + WS_BIG + 256 * MiB); a.Y2 = (bf16_t*)(ws + WS_BIG + 64 * MiB); a.Y3 = (bf16_t*)(ws + WS_BIG + 384 * MiB);
    void* kargs[] = {&a};
    hipError_t e = hipLaunchCooperativeKernel((const void*)fwd_megakernel, dim3(grid), dim3(NTHREADS), kargs, LDS_BYTES, stream);
    if (e != hipSuccess) fprintf(stderr, "cooperative launch failed: %s (grid %d)\n", hipGetErrorString(e), grid);
}
```

```cpp
#include <hip/hip_runtime.h>
#include <hip/hip_cooperative_groups.h>
#include <cstdio>
#include <cstdint>
namespace cg = cooperative_groups;

#define LAS __attribute__((address_space(3)))
typedef unsigned short bf16_t;
typedef short bf16x8 __attribute__((ext_vector_type(8)));
typedef short s16x4 __attribute__((ext_vector_type(4)));
typedef float f32x4 __attribute__((ext_vector_type(4)));
typedef float f32x16 __attribute__((ext_vector_type(16)));
typedef unsigned u32x4 __attribute__((ext_vector_type(4)));
typedef unsigned u32x2 __attribute__((ext_vector_type(2)));

constexpr int DM = 1024, NB = 8, SEQ = 8192, MT = NB * SEQ, DFF = 2816, NGU = 2 * DFF, INW = 5120, NMOD = 9216;
constexpr float EPS = 1e-6f, LOG2E = 1.4426950408889634f, LN2 = 0.6931471805599453f;
constexpr float LAMBDA_INIT = 0.2f;

constexpr size_t MiB = 1u << 20;
constexpr size_t WS_MODP = 1 * MiB;
constexpr size_t WS_SS = 6 * MiB;
constexpr size_t WS_WGU1 = 10 * MiB, WS_WD1 = 21 * MiB, WS_WIN = 27 * MiB, WS_WSB = 37 * MiB, WS_WDA = 38 * MiB, WS_WOUT = 39 * MiB, WS_WGU2 = 41 * MiB, WS_WD2 = 52 * MiB;
constexpr size_t WS_U = 64 * MiB;
constexpr size_t WS_Y = 192 * MiB;
constexpr size_t WS_BIG = 320 * MiB;
constexpr size_t WS_END = 960 * MiB;

typedef float f32x2_t __attribute__((ext_vector_type(2))); typedef __bf16 bf16x2_t __attribute__((ext_vector_type(2)));
__device__ __forceinline__ unsigned cvt_pk_bf16(float lo, float hi) { const f32x2_t v = {lo, hi}; const bf16x2_t b = __builtin_convertvector(v, bf16x2_t); return __builtin_bit_cast(unsigned, b); }
__device__ __forceinline__ float bf_lo(unsigned u) { return __uint_as_float(u << 16); }
__device__ __forceinline__ float bf_hi(unsigned u) { return __uint_as_float(u & 0xffff0000u); }
__device__ __forceinline__ float fast_exp2(float x) { return __builtin_amdgcn_exp2f(x); }
__device__ __forceinline__ float fast_log2(float x) { return __builtin_amdgcn_logf(x); }
__device__ __forceinline__ float fast_rcp(float x) { return __builtin_amdgcn_rcpf(x); }
__device__ __forceinline__ float sigmoidf_(float x) { return fast_rcp(1.0f + fast_exp2(-x * LOG2E)); }
__device__ __forceinline__ float wave_sum(float v) {
#pragma unroll
    for (int o = 1; o < 64; o <<= 1) v += __shfl_xor(v, o);
    return v;
}

__device__ __forceinline__ void glds_s(const void* sbase, unsigned voff, unsigned lds_dst) {
    unsigned keep;
    asm volatile("s_mov_b32 %0, m0\n\ts_mov_b32 m0, %3\n\ts_nop 0\n\tglobal_load_lds_dwordx4 %1, %2\n\ts_mov_b32 m0, %0" : "=&s"(keep) : "v"(voff), "s"(sbase), "s"(lds_dst) : "memory");
}

namespace pg8 {
constexpr int BM = 256, BK = 64, HALF = 128, HTB = HALF * BK * 2, STAGE_BYTES = 8 * HTB, NXCD = 8, WGM = 8;
__host__ __device__ __forceinline__ int lds_byte(int r, int c) { const int st = (r >> 4) * 2 + (c >> 5), rr = r & 15, cc = c & 31, ob = rr * 64 + cc * 2; return st * 1024 + (ob ^ (((ob >> 9) & 1) << 5)); }
__host__ __device__ __forceinline__ void stage_rc(int b, int& R, int& C) { const int st = b / 1024, sb = b % 1024, swz = sb ^ (((sb >> 9) & 1) << 5); R = (st >> 1) * 16 + swz / 64; C = (st & 1) * 32 + (swz % 64) / 2; }
__host__ __device__ __forceinline__ int perm32(int rho) { const int n = rho >> 4, i = rho & 15; return 8 * (i >> 2) + 4 * n + (i & 3); }

struct Unit { int pm, pn; };
struct Gemm { const bf16_t* A; const bf16_t* Bt; int M, N, K, lda; };

struct StaticOrder {
    int nM, nN, nwg, G, c;
    __device__ void init(int M, int N, int G_, int c_) { nM = M / BM; nN = N / BM; nwg = nM * nN; G = G_; c = c_; }
    __device__ bool next(int i, Unit& u) const {
        const long L = (long)i * G + c; if (L >= nwg) return false;
        int wgid = (int)L; { const int q = nwg / NXCD, r = nwg % NXCD, xcd = wgid % NXCD, off = wgid / NXCD; wgid = (xcd < r ? xcd * (q + 1) : r * (q + 1) + (xcd - r) * q) + off; }
        const int nig = WGM * nN, gid = wgid / nig, fm = gid * WGM, gsz = (nM - fm) < WGM ? (nM - fm) : WGM;
        u.pm = fm + ((wgid % nig) % gsz); u.pn = (wgid % nig) / gsz; return true;
    }
};

template <class Epi>
__device__ __forceinline__ void gemm_phase(LAS unsigned char* lds, const Gemm g, const StaticOrder& S, const Epi& E) {
    int tid_ = threadIdx.x; asm volatile("" : "+v"(tid_));
    const int tid = tid_, wid = __builtin_amdgcn_readfirstlane(tid >> 6), lane = tid & 63, wr = wid >> 2, wc = wid & 3, fr = lane & 15, fq = lane >> 4;
    const int K = g.K, nt = K / BK, lda = g.lda;
    unsigned voffA[2], voffB[2];
#pragma unroll
    for (int i = 0; i < 2; ++i) { int R, C; stage_rc(tid * 16 + i * 8192, R, C); const int Rb = (R & ~31) + perm32(R & 31);
        voffA[i] = (unsigned)(R * lda + C) * 2u; voffB[i] = (unsigned)(Rb * K + C) * 2u; }
    const size_t kstep = (size_t)(BK * 2);
    const size_t hstepA = (size_t)HALF * lda * 2, hstepB = (size_t)HALF * K * 2;
    const size_t tstepA = 2 * hstepA, tstepB = 2 * hstepB;
    const unsigned ldsbase = (unsigned)(uintptr_t)lds + (unsigned)wid * 1024u;
    const int aoff = lds_byte(wr * 64 + fr, fq * 8), boff = lds_byte(wc * 32 + fr, fq * 8);
#define PG8_SA(b, h) (((b) * 2 + (h)) * HTB)
#define PG8_SB(b, h) ((4 + (b) * 2 + (h)) * HTB)
#define PG8_STAGE(bufoff, gbase, voff) do { _Pragma("unroll") for (int _i = 0; _i < 2; ++_i) \
        glds_s((const void*)(gbase), (voff)[_i], ldsbase + (unsigned)((bufoff) + _i * 8192)); } while (0)
#define PG8_LDA(dst, b, h) do { _Pragma("unroll") for (int m = 0; m < 4; ++m) _Pragma("unroll") for (int k = 0; k < 2; ++k) dst[m][k] = *(const LAS bf16x8*)(lds + PG8_SA(b, h) + aoff + m * 2048 + k * 1024); } while (0)
#define PG8_LDB(dst, b, h) do { _Pragma("unroll") for (int n = 0; n < 2; ++n) _Pragma("unroll") for (int k = 0; k < 2; ++k) dst[n][k] = *(const LAS bf16x8*)(lds + PG8_SB(b, h) + boff + n * 2048 + k * 1024); } while (0)
#define PG8_MMA(ai, bj, At, Bt) do { __builtin_amdgcn_s_setprio(1); _Pragma("unroll") for (int m = 0; m < 4; ++m) _Pragma("unroll") for (int n = 0; n < 2; ++n) _Pragma("unroll") for (int k = 0; k < 2; ++k) \
        acc[ai][bj][m][n] = __builtin_amdgcn_mfma_f32_16x16x32_bf16(Bt[n][k], At[m][k], acc[ai][bj][m][n], 0, 0, 0); __builtin_amdgcn_s_setprio(0); } while (0)
#define PG8_WAIT_V(n) asm volatile("s_waitcnt vmcnt(" #n ")" ::: "memory")
#define PG8_WAIT_L(n) asm volatile("s_waitcnt lgkmcnt(" #n ")" ::: "memory")
#define PG8_BAR __builtin_amdgcn_s_barrier()
#define PG8_SCHED __builtin_amdgcn_sched_barrier(0)
    Unit cur, nxt; int ui = 0;
    if (!S.next(0, cur)) return;
    f32x4 acc[2][2][4][2];
#pragma unroll
    for (int a = 0; a < 2; ++a)
#pragma unroll
        for (int b = 0; b < 2; ++b)
#pragma unroll
            for (int m = 0; m < 4; ++m)
#pragma unroll
                for (int n = 0; n < 2; ++n) acc[a][b][m][n] = (f32x4){0.f, 0.f, 0.f, 0.f};
    bf16x8 At[4][2], B0[2][2], B1[2][2];
    const char* cA = (const char*)g.A + (size_t)cur.pm * tstepA; const char* cB = (const char*)g.Bt + (size_t)cur.pn * tstepB;
    PG8_STAGE(PG8_SB(0, 0), cB, voffB); PG8_STAGE(PG8_SB(0, 1), cB + hstepB, voffB); PG8_STAGE(PG8_SA(0, 0), cA, voffA); PG8_STAGE(PG8_SA(0, 1), cA + hstepA, voffA);
    if (wr == 1) PG8_BAR;
    PG8_WAIT_V(2); PG8_BAR;
    PG8_STAGE(PG8_SB(1, 0), cB + kstep, voffB); PG8_STAGE(PG8_SA(1, 0), cA + kstep, voffA); PG8_STAGE(PG8_SB(1, 1), cB + hstepB + kstep, voffB);
    PG8_WAIT_V(6); PG8_BAR;
    for (;;) {
        const bool has_next = S.next(ui + 1, nxt);
        const char* nA = has_next ? (const char*)g.A + (size_t)nxt.pm * tstepA : cA; const char* nB = has_next ? (const char*)g.Bt + (size_t)nxt.pn * tstepB : cB;
        for (int t = 0; t < nt; t += 2) {
            const bool last = (t == nt - 2);
            const char* a1 = cA + (size_t)(t + 1) * kstep;
            const char* a2 = last ? nA : cA + (size_t)(t + 2) * kstep; const char* b2 = last ? nB : cB + (size_t)(t + 2) * kstep;
            const char* a3 = a2 + kstep; const char* b3 = b2 + kstep;
            PG8_LDB(B0, 0, 0); PG8_LDB(B1, 0, 1); PG8_SCHED; PG8_LDA(At, 0, 0); PG8_STAGE(PG8_SA(1, 1), a1 + hstepA, voffA);
            PG8_WAIT_V(8); PG8_WAIT_L(0); PG8_BAR; PG8_MMA(0, 0, At, B0); PG8_MMA(0, 1, At, B1); PG8_BAR; PG8_SCHED;
            PG8_LDA(At, 0, 1); PG8_STAGE(PG8_SB(0, 0), b2, voffB); PG8_STAGE(PG8_SB(0, 1), b2 + hstepB, voffB); PG8_STAGE(PG8_SA(0, 0), a2, voffA);
            PG8_WAIT_V(8); PG8_WAIT_L(0); PG8_BAR; PG8_MMA(1, 0, At, B0); PG8_MMA(1, 1, At, B1); PG8_BAR; PG8_SCHED;
            PG8_LDB(B0, 1, 0); PG8_LDB(B1, 1, 1); PG8_SCHED; PG8_LDA(At, 1, 0); PG8_STAGE(PG8_SA(0, 1), a2 + hstepA, voffA);
            PG8_WAIT_V(8); PG8_WAIT_L(0); PG8_BAR; PG8_MMA(0, 0, At, B0); PG8_MMA(0, 1, At, B1); PG8_BAR; PG8_SCHED;
            PG8_LDA(At, 1, 1); PG8_STAGE(PG8_SB(1, 0), b3, voffB); PG8_STAGE(PG8_SB(1, 1), b3 + hstepB, voffB); PG8_STAGE(PG8_SA(1, 0), a3, voffA);
            PG8_WAIT_V(8); PG8_WAIT_L(0); PG8_BAR; PG8_MMA(1, 0, At, B0); PG8_MMA(1, 1, At, B1); PG8_BAR; PG8_SCHED;
        }
        if (wr == 0) PG8_BAR;
        E(acc, cur, wr, wc, fr, fq);
        if (!has_next) break;
#pragma unroll
        for (int a = 0; a < 2; ++a)
#pragma unroll
            for (int b = 0; b < 2; ++b)
#pragma unroll
                for (int m = 0; m < 4; ++m)
#pragma unroll
                    for (int n = 0; n < 2; ++n) acc[a][b][m][n] = (f32x4){0.f, 0.f, 0.f, 0.f};
        cur = nxt; cA = nA; cB = nB; ++ui;
        if (wr == 1) PG8_BAR;
    }
    PG8_WAIT_V(0);
    PG8_BAR;
#undef PG8_SA
#undef PG8_SB
#undef PG8_STAGE
#undef PG8_LDA
#undef PG8_LDB
#undef PG8_MMA
#undef PG8_WAIT_V
#undef PG8_WAIT_L
#undef PG8_BAR
#undef PG8_SCHED
}

struct EpiSwiGLU {
    bf16_t* H;
    __device__ __forceinline__ void operator()(const f32x4 (&acc)[2][2][4][2], const Unit& u, int wr, int wc, int fr, int fq) const {
        const int row0 = u.pm * BM + wr * 64 + fr, col0 = u.pn * HALF + wc * 32 + 8 * fq;
#pragma unroll
        for (int ai = 0; ai < 2; ++ai)
#pragma unroll
            for (int m = 0; m < 4; ++m) {
                float o[8];
#pragma unroll
                for (int n = 0; n < 2; ++n)
#pragma unroll
                    for (int e = 0; e < 4; ++e) { const float gv = acc[ai][0][m][n][e], uv = acc[ai][1][m][n][e]; o[n * 4 + e] = gv * sigmoidf_(gv) * uv; }
                u32x4 w; w.x = cvt_pk_bf16(o[0], o[1]); w.y = cvt_pk_bf16(o[2], o[3]); w.z = cvt_pk_bf16(o[4], o[5]); w.w = cvt_pk_bf16(o[6], o[7]);
                *(u32x4*)(H + (size_t)(row0 + ai * HALF + m * 16) * DFF + col0) = w;
                asm volatile("" ::: "memory");
            }
    }
};
struct EpiProj {
    bf16_t *Qsb, *KVsb, *Qda, *KVda, *Gt; unsigned* kmax2;
    __device__ __forceinline__ void operator()(const f32x4 (&acc)[2][2][4][2], const Unit& u, int wr, int wc, int fr, int fq) const {
        const int row0 = u.pm * BM + wr * 64 + fr; const int cbase = u.pn * BM; const bool sg = (cbase >= 3072); const bool kdt = (cbase == 2048 || cbase == 2304);
        float mxk[2] = {0.f, 0.f};
#pragma unroll
        for (int ai = 0; ai < 2; ++ai)
#pragma unroll
            for (int m = 0; m < 4; ++m) { const int row = row0 + ai * HALF + m * 16; const int b = row >> 13, t = row & (SEQ - 1);
#pragma unroll
                for (int bj = 0; bj < 2; ++bj) { f32x4 v0 = acc[ai][bj][m][0], v1 = acc[ai][bj][m][1];
                    const int c = cbase + bj * HALF + wc * 32 + 8 * fq;
                    bf16_t* dst;
                    if (cbase < 1536) { const int sec = c >> 9, cc = c & 511, h = cc >> 6, wv = cc & 63; const size_t ri = (size_t)(b * 8 + h) * SEQ + t;
                        dst = (sec == 0) ? Qsb + ri * 64 + wv : KVsb + ri * 128 + (sec == 2 ? 64 : 0) + wv; }
                    else if (cbase < 3072) { const int c2 = c - 1536, sec = c2 >> 9, cc = c2 & 511, h = cc >> 7, wv = cc & 127; const size_t ri = (size_t)(b * 4 + h) * SEQ + t;
                        dst = (sec == 0) ? Qda + ri * 128 + wv : KVda + ri * 256 + (sec == 2 ? 128 : 0) + wv; }
                    else dst = Gt + (size_t)row * 2048 + (c - 3072);
                    if (sg) {
#pragma unroll
                        for (int e = 0; e < 4; ++e) { v0[e] = sigmoidf_(v0[e]); v1[e] = sigmoidf_(v1[e]); } }
                    u32x4 w; w.x = cvt_pk_bf16(v0[0], v0[1]); w.y = cvt_pk_bf16(v0[2], v0[3]); w.z = cvt_pk_bf16(v1[0], v1[1]); w.w = cvt_pk_bf16(v1[2], v1[3]);
                    *(u32x4*)dst = w;
                    if (kdt) { float sq = (bf_lo(w.x) * bf_lo(w.x) + bf_hi(w.x) * bf_hi(w.x)) + (bf_lo(w.y) * bf_lo(w.y) + bf_hi(w.y) * bf_hi(w.y)) + (bf_lo(w.z) * bf_lo(w.z) + bf_hi(w.z) * bf_hi(w.z)) + (bf_lo(w.w) * bf_lo(w.w) + bf_hi(w.w) * bf_hi(w.w));
                        sq += __shfl_xor(sq, 16); sq += __shfl_xor(sq, 32); mxk[bj] = fmaxf(mxk[bj], sq); } }
                asm volatile("" ::: "memory"); }
        if (kdt) {
#pragma unroll
            for (int bj = 0; bj < 2; ++bj) { float v = mxk[bj];
#pragma unroll
                for (int o = 1; o < 16; o <<= 1) v = fmaxf(v, __shfl_xor(v, o));
                const int b = (u.pm * BM) >> 13, h = ((cbase - 2048) >> 7) + bj, idx = ((b * 4 + h) * 2 + (wc >> 1)) * 2 + (wc & 1);
                if ((threadIdx.x & 63) == 0) atomicMax(kmax2 + idx, __float_as_uint(v)); }
        }
    }
};
struct EpiY {
    bf16_t* Y; float* SS;
    __device__ __forceinline__ void operator()(const f32x4 (&acc)[2][2][4][2], const Unit& u, int wr, int wc, int fr, int fq) const {
        const int row0 = u.pm * BM + wr * 64 + fr, col0 = u.pn * BM + wc * 32 + 8 * fq;
#pragma unroll
        for (int ai = 0; ai < 2; ++ai)
#pragma unroll
            for (int m = 0; m < 4; ++m) { const int row = row0 + ai * HALF + m * 16; bf16_t* rowp = Y + (size_t)row * DM + col0; float s = 0.f;
#pragma unroll
                for (int bj = 0; bj < 2; ++bj) { const f32x4 v0 = acc[ai][bj][m][0], v1 = acc[ai][bj][m][1];
                    s += (v0[0] * v0[0] + v0[1] * v0[1]) + (v0[2] * v0[2] + v0[3] * v0[3]) + (v1[0] * v1[0] + v1[1] * v1[1]) + (v1[2] * v1[2] + v1[3] * v1[3]);
                    u32x4 w; w.x = cvt_pk_bf16(v0[0], v0[1]); w.y = cvt_pk_bf16(v0[2], v0[3]); w.z = cvt_pk_bf16(v1[0], v1[1]); w.w = cvt_pk_bf16(v1[2], v1[3]);
                    *(u32x4*)(rowp + bj * HALF) = w; }
                s += __shfl_xor(s, 16); s += __shfl_xor(s, 32);
                if (fq == 0) SS[(size_t)row * 16 + u.pn * 4 + wc] = s;
                asm volatile("" ::: "memory"); }
    }
};
template <bool FIRST> struct EpiGate {
    static constexpr bool PANEL = false;
    bf16_t* Mg; const bf16_t* Gt; int gcol;
    __device__ __forceinline__ void operator()(const f32x4 (&acc)[2][2][4][2], const Unit& u, int wr, int wc, int fr, int fq) const {
        const int row0 = u.pm * BM + wr * 64 + fr, col0 = u.pn * BM + wc * 32 + 8 * fq;
#pragma unroll
        for (int ai = 0; ai < 2; ++ai) {
            u32x4 sg[4][2], tt[4][2];
#pragma unroll
            for (int m = 0; m < 4; ++m)
#pragma unroll
                for (int bj = 0; bj < 2; ++bj) { const size_t row = (size_t)(row0 + ai * HALF + m * 16);
                    sg[m][bj] = *(const u32x4*)(Gt + row * 2048 + gcol + col0 + bj * HALF);
                    if (!FIRST) tt[m][bj] = *(const u32x4*)(Mg + row * DM + col0 + bj * HALF); }
#pragma unroll
            for (int m = 0; m < 4; ++m)
#pragma unroll
                for (int bj = 0; bj < 2; ++bj) { const size_t row = (size_t)(row0 + ai * HALF + m * 16);
                    const f32x4 v0 = acc[ai][bj][m][0], v1 = acc[ai][bj][m][1]; const u32x4 sgv = sg[m][bj];
                    float o[8];
                    o[0] = bf_lo(sgv.x) * v0[0]; o[1] = bf_hi(sgv.x) * v0[1]; o[2] = bf_lo(sgv.y) * v0[2]; o[3] = bf_hi(sgv.y) * v0[3];
                    o[4] = bf_lo(sgv.z) * v1[0]; o[5] = bf_hi(sgv.z) * v1[1]; o[6] = bf_lo(sgv.w) * v1[2]; o[7] = bf_hi(sgv.w) * v1[3];
                    if (!FIRST) { const u32x4 t = tt[m][bj];
                        o[0] += bf_lo(t.x); o[1] += bf_hi(t.x); o[2] += bf_lo(t.y); o[3] += bf_hi(t.y); o[4] += bf_lo(t.z); o[5] += bf_hi(t.z); o[6] += bf_lo(t.w); o[7] += bf_hi(t.w); }
                    u32x4 w; w.x = cvt_pk_bf16(o[0], o[1]); w.y = cvt_pk_bf16(o[2], o[3]); w.z = cvt_pk_bf16(o[4], o[5]); w.w = cvt_pk_bf16(o[6], o[7]);
                    *(u32x4*)(Mg + row * DM + col0 + bj * HALF) = w; }
            asm volatile("" ::: "memory");
        }
    }
};
}

namespace att {
__device__ __forceinline__ int crow(int r, int hi) { return (r & 3) + 8 * (r >> 2) + 4 * hi; }

#define DS_RD128(dst, addr, imm) asm volatile("ds_read_b128 %0, %1 offset:%c2" : "=&v"(dst) : "v"(addr), "i"(imm) : "memory")
#define DS_RDTR(dst, addr, imm) asm volatile("ds_read_b64_tr_b16 %0, %1 offset:%c2" : "=&v"(dst) : "v"(addr), "i"(imm) : "memory")
constexpr int DA_KB = 0, DA_VB = 32768, DA_Q = 65536, DA_QP = 272, DA_QBUF = 32 * DA_QP, DA_TOTAL = DA_Q + 8 * DA_QBUF;
typedef short v4i16_t __attribute__((ext_vector_type(4)));
__device__ __forceinline__ s16x4 vtr(const LAS unsigned char* p) { return __builtin_bit_cast(s16x4, __builtin_amdgcn_ds_read_tr16_b64_v4i16((LAS v4i16_t*)p)); }
__device__ __forceinline__ float max3f(float a, float b, float c) { return fmaxf(fmaxf(a, b), c); }

__device__ __forceinline__ void da_unit(LAS unsigned char* lds, const bf16_t* Qp  , const bf16_t* KVp  , bf16_t* Op  , int qb, float lam, const float* subln, float slope, const unsigned* kmax2  ) {
    int tid_ = threadIdx.x; asm volatile("" : "+v"(tid_));
    const int tid = tid_, lane = tid & 63, q = lane & 31, hi = lane >> 5; const int w = __builtin_amdgcn_readfirstlane(tid >> 6);
    LAS unsigned char* Qw = lds + DA_Q + w * DA_QBUF;
    const unsigned ldsb = (unsigned)(uintptr_t)lds;
    unsigned voff[2];
#pragma unroll
    for (int i = 0; i < 2; ++i) { const int row = 8 * w + 4 * i + (lane >> 4); const int f = ((row & 3) << 2) | ((row >> 2) & 3); voff[i] = (unsigned)(row * 512 + 16 * ((lane & 15) ^ f)); }
    const char* const Pb = (const char*)KVp;
#define DA_DMA(kt, buf) do { const char* tb_ = Pb + (size_t)(kt) * (64 * 512); \
        _Pragma("unroll") for (int i_ = 0; i_ < 2; ++i_) { glds_s(tb_, voff[i_], ldsb + (unsigned)(DA_KB + (buf) * 16384 + (2 * w + i_) * 1024)); \
            glds_s(tb_ + 256, voff[i_], ldsb + (unsigned)(DA_VB + (buf) * 16384 + (2 * w + i_) * 1024)); } } while (0)
    const int nt = 4 * (qb + 1);
    DA_DMA(nt - 1, 0);
    {
        const float c1 = 0.125f * LOG2E;
#pragma unroll
        for (int i = 0; i < 8; ++i) { const int cid = lane + 64 * i, r = cid >> 4, ch = cid & 15;
            u32x4 v = *(const u32x4*)(Qp + (size_t)(qb * 256 + w * 32 + r) * 128 + 8 * ch);
            v.x = cvt_pk_bf16(bf_lo(v.x) * c1, bf_hi(v.x) * c1); v.y = cvt_pk_bf16(bf_lo(v.y) * c1, bf_hi(v.y) * c1);
            v.z = cvt_pk_bf16(bf_lo(v.z) * c1, bf_hi(v.z) * c1); v.w = cvt_pk_bf16(bf_lo(v.w) * c1, bf_hi(v.w) * c1);
            *(LAS u32x4*)(Qw + r * DA_QP + 16 * ch) = v; }
    }
    f32x16 o1[4], o2[4];
#pragma unroll
    for (int d = 0; d < 4; ++d) { o1[d] = (f32x16){}; o2[d] = (f32x16){}; }
    float m1 = -INFINITY, m2 = -INFINITY, l1 = 0.f, l2 = 0.f;
    const int tpos = qb * 256 + w * 32 + q;
    const float c2 = slope * LOG2E;
    const int F16 = 16 * (((q & 3) << 2) | ((q >> 2) & 3));
    const int kq = 256 * q;
    const int qq = (lane & 15) >> 2, g1 = (lane >> 4) & 1, pp = lane & 3;
    const int A0 = 256 * (4 * hi + qq) + 8 * (pp & 1);
    const int vbase0 = A0 + 16 * ((2 * g1 + (pp >> 1)) ^ hi), vbase1 = A0 + 2048 + 16 * ((2 * g1 + (pp >> 1)) ^ (hi + 2));
    asm volatile("s_waitcnt vmcnt(0)" ::: "memory");
    __syncthreads();
    float qb_[2];
#pragma unroll
    for (int mp = 0; mp < 2; ++mp) { float sq = 0.f;
#pragma unroll
        for (int d0 = 0; d0 < 4; ++d0) { const u32x4 f = *(const LAS u32x4*)(Qw + q * DA_QP + (64 * mp + 16 * d0 + 8 * hi) * 2);
            sq += (bf_lo(f.x) * bf_lo(f.x) + bf_hi(f.x) * bf_hi(f.x)) + (bf_lo(f.y) * bf_lo(f.y) + bf_hi(f.y) * bf_hi(f.y)) + (bf_lo(f.z) * bf_lo(f.z) + bf_hi(f.z) * bf_hi(f.z)) + (bf_lo(f.w) * bf_lo(f.w) + bf_hi(f.w) * bf_hi(f.w)); }
        sq += __shfl_xor(sq, 32);
        const float k2 = __uint_as_float(kmax2[2 * mp]) + __uint_as_float(kmax2[2 * mp + 1]);
        qb_[mp] = sqrtf(sq) * sqrtf(k2) * 1.001f + 0.01f; }
    const unsigned FH = (unsigned)(F16 ^ (16 * hi));
    const unsigned qaddr = (unsigned)(uintptr_t)Qw + (unsigned)(q * DA_QP + 16 * hi);
    const unsigned xq = 64u * (unsigned)qq;
#define DA_ISSUE_KQ(mp, kh) do { _Pragma("unroll") for (int d0_ = 0; d0_ < 4; ++d0_) { const unsigned ka_ = kcur + ((unsigned)(128 * (mp) + 32 * d0_) ^ FH); \
        DS_RD128(kf[d0_], ka_, 8192 * (kh)); DS_RD128(qf[d0_], qaddr, 128 * (mp) + 32 * d0_); } } while (0)
    for (int it = 0; it < nt; ++it) {
        const int kt = nt - 1 - it, cur = it & 1;
        if (kt > 0) DA_DMA(kt - 1, cur ^ 1);
        if ((kt - 4 * qb) <= (w >> 1)) {
            const bool band = kt >= 4 * qb;
            const unsigned kcur = ldsb + (unsigned)(DA_KB + cur * 16384 + kq);
            const unsigned vcur = ldsb + (unsigned)(DA_VB + cur * 16384);
#pragma unroll
            for (int kh = 1; kh >= 0; --kh) {
                f32x16 s[2];
#pragma unroll
                for (int mp = 0; mp < 2; ++mp) {
                    bf16x8 kf[4], qf[4];
                    DA_ISSUE_KQ(mp, kh);
                    asm volatile("s_waitcnt lgkmcnt(0)" : "+v"(kf[0]), "+v"(kf[1]), "+v"(kf[2]), "+v"(kf[3]), "+v"(qf[0]), "+v"(qf[1]), "+v"(qf[2]), "+v"(qf[3]) :: "memory");
                    s[mp] = (f32x16){};
#pragma unroll
                    for (int d0 = 0; d0 < 4; ++d0) s[mp] = __builtin_amdgcn_mfma_f32_32x32x16_bf16(kf[d0], qf[d0], s[mp], 0, 0, 0);
                }
                float off, mx[2]; bool doit[2];
                if (band) off = 0.f; else off = c2 * (float)(kt * 64 + 32 * kh + 4 * hi - tpos);
#pragma unroll
                for (int mp = 0; mp < 2; ++mp) {
                    if (band) { const float dbase = (float)(tpos - kt * 64 - 32 * kh - 4 * hi);
#pragma unroll
                        for (int r = 0; r < 16; ++r) s[mp][r] = s[mp][r] - c2 * fabsf(dbase - (float)crow(r, 0));
                    } else {
#pragma unroll
                        for (int r = 0; r < 16; ++r) s[mp][r] = fmaf(c2, (float)crow(r, 0), s[mp][r]);
                    }
                    float m_ = max3f(s[mp][0], s[mp][1], s[mp][2]);
#pragma unroll
                    for (int r = 3; r < 15; r += 2) m_ = max3f(m_, s[mp][r], s[mp][r + 1]);
                    m_ = fmaxf(m_, s[mp][15]) + off;
                    { auto rr = __builtin_amdgcn_permlane32_swap(__float_as_uint(m_), __float_as_uint(m_), false, false); m_ = fmaxf(__uint_as_float(rr[0]), __uint_as_float(rr[1])); }
                    mx[mp] = m_;
                    doit[mp] = !__all(m_ - (mp ? m2 : m1) < -160.0f);
                }
                if (doit[0] || doit[1]) {
                    s16x4 va_lo[4], va_hi[4], vb_lo[4], vb_hi[4];
#define DA_ISSUE_V(lo_, hi_, dbase_) do { _Pragma("unroll") for (int d_ = 0; d_ < 2; ++d_) { const unsigned xd_ = vcur + ((unsigned)(64 * ((dbase_) + d_)) ^ xq); const unsigned a0_ = xd_ + (unsigned)vbase0, a1_ = xd_ + (unsigned)vbase1; \
                        _Pragma("unroll") for (int j_ = 0; j_ < 2; ++j_) { DS_RDTR(lo_[2 * d_ + j_], a0_, 8192 * kh + 4096 * j_); DS_RDTR(hi_[2 * d_ + j_], a1_, 8192 * kh + 4096 * j_); } } } while (0)
                    DA_ISSUE_V(va_lo, va_hi, 0); DA_ISSUE_V(vb_lo, vb_hi, 2);
                    float dd[2];
#pragma unroll
                    for (int mp = 0; mp < 2; ++mp) {
                        float& mref = mp ? m2 : m1; float& lref = mp ? l2 : l1;
                        if (doit[mp]) {
                            if (__any(mx[mp] - mref > 8.0f)) { const float mnew = fmaxf(mref, mx[mp]); const float alpha = fast_exp2(mref - mnew); lref *= alpha;
#pragma unroll
                                for (int d = 0; d < 4; ++d) { if (mp) o2[d] *= alpha; else o1[d] *= alpha; }
                                mref = mnew; }
                            dd[mp] = off - mref;
                        } else dd[mp] = -INFINITY;
                    }
                    bf16x8 pk[2][2];
                    typedef float f32x8 __attribute__((ext_vector_type(8))); typedef float f32x2v __attribute__((ext_vector_type(2)));
#define DA_SOFTMAX(mp_, lref_) do { s[mp_] = s[mp_] + dd[mp_]; \
                        _Pragma("unroll") for (int r = 0; r < 16; ++r) s[mp_][r] = fast_exp2(s[mp_][r]); \
                        { const f32x8 h8 = __builtin_shufflevector(s[mp_], s[mp_], 0, 1, 2, 3, 4, 5, 6, 7) + __builtin_shufflevector(s[mp_], s[mp_], 8, 9, 10, 11, 12, 13, 14, 15); \
                          const f32x4 h4 = __builtin_shufflevector(h8, h8, 0, 1, 2, 3) + __builtin_shufflevector(h8, h8, 4, 5, 6, 7); \
                          const f32x2v h2 = __builtin_shufflevector(h4, h4, 0, 1) + __builtin_shufflevector(h4, h4, 2, 3); lref_ += h2[0] + h2[1]; } \
                        _Pragma("unroll") for (int j = 0; j < 2; ++j) { u32x4 pw; pw.x = cvt_pk_bf16(s[mp_][8 * j + 0], s[mp_][8 * j + 1]); pw.y = cvt_pk_bf16(s[mp_][8 * j + 2], s[mp_][8 * j + 3]); \
                            pw.z = cvt_pk_bf16(s[mp_][8 * j + 4], s[mp_][8 * j + 5]); pw.w = cvt_pk_bf16(s[mp_][8 * j + 6], s[mp_][8 * j + 7]); pk[mp_][j] = __builtin_bit_cast(bf16x8, pw); } } while (0)
                    DA_SOFTMAX(0, l1);
                    asm volatile("s_waitcnt lgkmcnt(0)" : "+v"(va_lo[0]), "+v"(va_lo[1]), "+v"(va_lo[2]), "+v"(va_lo[3]), "+v"(va_hi[0]), "+v"(va_hi[1]), "+v"(va_hi[2]), "+v"(va_hi[3]),
                                 "+v"(vb_lo[0]), "+v"(vb_lo[1]), "+v"(vb_lo[2]), "+v"(vb_lo[3]), "+v"(vb_hi[0]), "+v"(vb_hi[1]), "+v"(vb_hi[2]), "+v"(vb_hi[3]) :: "memory");
                    bf16x8 vf[4][2];
#pragma unroll
                    for (int d = 0; d < 4; ++d)
#pragma unroll
                        for (int j = 0; j < 2; ++j) { const s16x4 lo = (d < 2) ? va_lo[2 * d + j] : vb_lo[2 * (d - 2) + j], hh = (d < 2) ? va_hi[2 * d + j] : vb_hi[2 * (d - 2) + j];
                            vf[d][j] = (bf16x8){lo[0], lo[1], lo[2], lo[3], hh[0], hh[1], hh[2], hh[3]}; }
#pragma unroll
                    for (int d = 0; d < 4; ++d)
#pragma unroll
                        for (int j = 0; j < 2; ++j) o1[d] = __builtin_amdgcn_mfma_f32_32x32x16_bf16(vf[d][j], pk[0][j], o1[d], 0, 0, 0);
                    DA_SOFTMAX(1, l2);
#pragma unroll
                    for (int g = 0; g < 8; ++g) { __builtin_amdgcn_sched_group_barrier(0x8, 1, 0); __builtin_amdgcn_sched_group_barrier(0x2, 6, 0); }
#pragma unroll
                    for (int d = 0; d < 4; ++d)
#pragma unroll
                        for (int j = 0; j < 2; ++j) o2[d] = __builtin_amdgcn_mfma_f32_32x32x16_bf16(vf[d][j], pk[1][j], o2[d], 0, 0, 0);
#undef DA_SOFTMAX
#undef DA_ISSUE_V
                }
                __builtin_amdgcn_sched_barrier(0);
            }
        }
        asm volatile("s_waitcnt vmcnt(0)" ::: "memory");
        bool okw = false;
        if (kt >= 1 && kt - 1 < 4 * qb) { const float bias = -c2 * (float)(tpos - (64 * (kt - 1) + 63));
            okw = __all((qb_[0] + bias - m1 < -160.0f) && (qb_[1] + bias - m2 < -160.0f)); }
        if (__syncthreads_and(okw ? 1 : 0)) break;
    }
#undef DA_ISSUE_KQ
#undef DA_DMA
    bf16_t* orow = Op + (size_t)(qb * 256 + w * 32 + q) * 512;
    l1 += __shfl_xor(l1, 32); l2 += __shfl_xor(l2, 32);
    const float i1 = 1.0f / l1, i2 = lam / l2; float ss = 0.f;
#pragma unroll
    for (int d = 0; d < 4; ++d)
#pragma unroll
        for (int r = 0; r < 16; ++r) { const float v = o1[d][r] * i1 - o2[d][r] * i2; o1[d][r] = v; ss += v * v; }
    ss += __shfl_xor(ss, 32);
    const float rs = (1.0f / sqrtf(ss * (1.0f / 128.0f) + EPS)) * (1.0f - LAMBDA_INIT);
#pragma unroll
    for (int d = 0; d < 4; ++d)
#pragma unroll
        for (int gq = 0; gq < 4; ++gq) { const int dd = 32 * d + 8 * gq + 4 * hi; const f32x4 sl = *(const f32x4*)(subln + dd);
            u32x2 wv; wv.x = cvt_pk_bf16(o1[d][4 * gq] * rs * sl[0], o1[d][4 * gq + 1] * rs * sl[1]); wv.y = cvt_pk_bf16(o1[d][4 * gq + 2] * rs * sl[2], o1[d][4 * gq + 3] * rs * sl[3]);
            *(u32x2*)(orow + dd) = wv; }
}

__device__ __forceinline__ void sb_unit(LAS unsigned char* lds, const bf16_t* Qp  , const bf16_t* KVp  , bf16_t* Op  , int qb) {
    int tid_ = threadIdx.x; asm volatile("" : "+v"(tid_));
    const int tid = tid_, lane = tid & 63, q = lane & 31, hi = lane >> 5; const int w = __builtin_amdgcn_readfirstlane(tid >> 6);
    const int t0 = qb * 256 + w * 32, tpos = t0 + q;
    const unsigned vbuf = (unsigned)(uintptr_t)lds + (unsigned)w * 16384u;
    bf16x8 qf[4];
#pragma unroll
    for (int d0 = 0; d0 < 4; ++d0) { u32x4 v = *(const u32x4*)(Qp + (size_t)tpos * 64 + 16 * d0 + 8 * hi);
        v.x = cvt_pk_bf16(bf_lo(v.x) * 0.125f, bf_hi(v.x) * 0.125f); v.y = cvt_pk_bf16(bf_lo(v.y) * 0.125f, bf_hi(v.y) * 0.125f);
        v.z = cvt_pk_bf16(bf_lo(v.z) * 0.125f, bf_hi(v.z) * 0.125f); v.w = cvt_pk_bf16(bf_lo(v.w) * 0.125f, bf_hi(v.w) * 0.125f);
        qf[d0] = __builtin_bit_cast(bf16x8, v); }
    const unsigned voffV = (unsigned)((lane >> 3) * 256 + 16 * ((lane & 7) ^ (lane >> 3)));
    const unsigned voffK = (unsigned)(q * 256 + 16 * hi);
    const char* const Pb = (const char*)KVp;
#define SB_DMA_V(kt, buf) do { const char* tb_ = Pb + (size_t)(kt) * (64 * 256) + 128; \
        _Pragma("unroll") for (int I_ = 0; I_ < 8; ++I_) glds_s(tb_ + 2048 * I_, voffV, vbuf + (unsigned)((buf) * 8192 + 1024 * I_)); } while (0)
#define SB_LOAD_K(dst, kt) do { const char* tb_ = Pb + (size_t)(kt) * (64 * 256); \
        _Pragma("unroll") for (int kh_ = 0; kh_ < 2; ++kh_) _Pragma("unroll") for (int d0_ = 0; d0_ < 4; ++d0_) dst[kh_ * 4 + d0_] = *(const u32x4*)(tb_ + voffK + 8192 * kh_ + 32 * d0_); } while (0)
    const int kt_first = t0 >> 6;
    int kt = kt_first, buf = 0;
    u32x4 kf[8], kfn[8];
    SB_LOAD_K(kf, kt); SB_DMA_V(kt, 0);
#pragma unroll
    for (int i = 0; i < 8; ++i) kfn[i] = kf[i];
    f32x16 o[2]; o[0] = (f32x16){}; o[1] = (f32x16){};
    float carry = 0.f;
    const int qq = (lane & 15) >> 2, g1 = (lane >> 4) & 1, pp = lane & 3;
    const unsigned vb = (unsigned)(128 * (4 * hi + qq) + 16 * ((2 * g1 + (pp >> 1)) ^ qq) + 8 * (pp & 1));
    const unsigned vb0 = vb + 64u * (unsigned)hi, vb1 = vb + 64u - 64u * (unsigned)hi;
    for (;;) {
        asm volatile("s_waitcnt vmcnt(0)" ::: "memory");
        if (kt > 0) { SB_LOAD_K(kfn, kt - 1); SB_DMA_V(kt - 1, buf ^ 1); }
        const unsigned vcur = vbuf + (unsigned)(buf * 8192);
#pragma unroll
        for (int kh = 1; kh >= 0; --kh) {
            if (kh == 1 && kt == kt_first && !(t0 & 32)) continue;
            f32x16 s = (f32x16){};
#pragma unroll
            for (int d0 = 0; d0 < 4; ++d0) s = __builtin_amdgcn_mfma_f32_32x32x16_bf16(__builtin_bit_cast(bf16x8, kf[kh * 4 + d0]), qf[d0], s, 0, 0, 0);
            s16x4 vlo[4], vhi[4];
#pragma unroll
            for (int d = 0; d < 2; ++d) { const unsigned a_ = vcur + (d ? vb1 : vb0);
#pragma unroll
                for (int j = 0; j < 2; ++j) { DS_RDTR(vlo[2 * d + j], a_, 4096 * kh + 2048 * j); DS_RDTR(vhi[2 * d + j], a_, 4096 * kh + 2048 * j + 1024); } }
            float sp[16];
#pragma unroll
            for (int r = 0; r < 16; ++r) { const float z = s[r]; const bool valid = (kt * 64 + 32 * kh + crow(r, hi)) < tpos;
                const float a = fabsf(z); const float e = fast_exp2(-a * LOG2E); const float spv = fmaxf(z, 0.f) + fast_log2(1.0f + e) * LN2; sp[r] = valid ? spv : 0.f; }
            float G[4], Gp[4];
#pragma unroll
            for (int i = 0; i < 4; ++i) { G[i] = (sp[4 * i] + sp[4 * i + 1]) + (sp[4 * i + 2] + sp[4 * i + 3]); Gp[i] = __shfl_xor(G[i], 32); }
            float after = 0.f;
#pragma unroll
            for (int i = 3; i >= 0; --i) { float run = carry + after + (hi == 0 ? Gp[i] : 0.f);
#pragma unroll
                for (int j = 3; j >= 0; --j) { const int r = 4 * i + j; run += sp[r]; const bool valid = (kt * 64 + 32 * kh + crow(r, hi)) < tpos;
                    const float wv = fast_exp2((s[r] - run) * LOG2E); s[r] = valid ? wv : 0.f; }
                after += G[i] + Gp[i]; }
            carry += after;
            bf16x8 pk[2];
#pragma unroll
            for (int j = 0; j < 2; ++j) { u32x4 pw; pw.x = cvt_pk_bf16(s[8 * j + 0], s[8 * j + 1]); pw.y = cvt_pk_bf16(s[8 * j + 2], s[8 * j + 3]);
                pw.z = cvt_pk_bf16(s[8 * j + 4], s[8 * j + 5]); pw.w = cvt_pk_bf16(s[8 * j + 6], s[8 * j + 7]);
                pk[j] = __builtin_bit_cast(bf16x8, pw); }
            asm volatile("s_waitcnt lgkmcnt(0)" : "+v"(vlo[0]), "+v"(vlo[1]), "+v"(vlo[2]), "+v"(vlo[3]), "+v"(vhi[0]), "+v"(vhi[1]), "+v"(vhi[2]), "+v"(vhi[3]) :: "memory");
#pragma unroll
            for (int d = 0; d < 2; ++d)
#pragma unroll
                for (int j = 0; j < 2; ++j) { const s16x4 lo = vlo[2 * d + j], hh = vhi[2 * d + j];
                    const bf16x8 vf = (bf16x8){lo[0], lo[1], lo[2], lo[3], hh[0], hh[1], hh[2], hh[3]};
                    o[d] = __builtin_amdgcn_mfma_f32_32x32x16_bf16(vf, pk[j], o[d], 0, 0, 0); }
        }
        if (kt == 0 || __all(carry > 110.0f)) break;
#pragma unroll
        for (int i = 0; i < 8; ++i) kf[i] = kfn[i];
        --kt; buf ^= 1;
    }
    asm volatile("s_waitcnt vmcnt(0)" ::: "memory");
#undef SB_DMA_V
#undef SB_LOAD_K
    bf16_t* orow = Op + (size_t)tpos * 512;
#pragma unroll
    for (int d = 0; d < 2; ++d)
#pragma unroll
        for (int gq = 0; gq < 4; ++gq) { const int dd = 32 * d + 8 * gq + 4 * hi;
            u32x2 wv; wv.x = cvt_pk_bf16(o[d][4 * gq], o[d][4 * gq + 1]); wv.y = cvt_pk_bf16(o[d][4 * gq + 2], o[d][4 * gq + 3]);
            *(u32x2*)(orow + dd) = wv; }
}
}

constexpr int NWAVES = 8, NTHREADS = 512;
constexpr int LDS_BYTES = 143360;
static_assert(att::DA_TOTAL <= LDS_BYTES - 64 && pg8::STAGE_BYTES <= LDS_BYTES - 64, "LDS map");

__device__ __forceinline__ void p0_transpose_item(const float* W, int K, int N, bf16_t* WT, int il  , LAS float* scr, int item, int lane) {
    const int nblk = N / 32, kb = item / nblk, nb = item % nblk, k0 = 64 * kb, n0 = 32 * nb;
    f32x4 v[8];
#pragma unroll
    for (int i = 0; i < 8; ++i) v[i] = *(const f32x4*)(W + (size_t)(k0 + 8 * i + (lane >> 3)) * N + n0 + 4 * (lane & 7));
#pragma unroll
    for (int i = 0; i < 8; ++i) { LAS float* d = scr + (8 * i + (lane >> 3)) * 33 + 4 * (lane & 7); d[0] = v[i][0]; d[1] = v[i][1]; d[2] = v[i][2]; d[3] = v[i][3]; }
    asm volatile("s_waitcnt lgkmcnt(0)" ::: "memory");
    const int c = lane & 7;
    const int rbase = il ? (256 * (n0 / 128) + 128 * (il - 1) + (n0 % 128)) : n0;
#pragma unroll
    for (int j = 0; j < 4; ++j) { const int n = (lane >> 3) + 8 * j; const LAS float* s = scr + (8 * c) * 33 + n;
        u32x4 o; o.x = cvt_pk_bf16(s[0 * 33], s[1 * 33]); o.y = cvt_pk_bf16(s[2 * 33], s[3 * 33]); o.z = cvt_pk_bf16(s[4 * 33], s[5 * 33]); o.w = cvt_pk_bf16(s[6 * 33], s[7 * 33]);
        *(u32x4*)(WT + (size_t)(rbase + n) * K + k0 + 8 * c) = o; }
    asm volatile("s_waitcnt lgkmcnt(0)" ::: "memory");
}

#ifndef PROBE_MASK
#define PROBE_MASK 0
#endif
#define TSTART() unsigned long long t0_ = (PROBE_MASK != 0) ? __builtin_amdgcn_s_memrealtime() : 0ull
#define TEND(k) do { if (PROBE_MASK & (1 << (k))) { const unsigned long long t1_ = __builtin_amdgcn_s_memrealtime(); const unsigned long long dt_ = t1_ - t0_; while (__builtin_amdgcn_s_memrealtime() - t1_ < dt_) __builtin_amdgcn_s_sleep(8); } if (PROBE_MASK != 0) t0_ = __builtin_amdgcn_s_memrealtime(); } while (0)
struct Args { const float* in[21]; float* out; float* modp; float* SS; bf16_t* Wgu[2]; bf16_t* Wd[2]; bf16_t* Win; bf16_t* Wsb; bf16_t* Wda; bf16_t* Wout; bf16_t* U; bf16_t* Y; bf16_t* BIG; bf16_t* Qsb; bf16_t* KVsb; bf16_t* Qda; bf16_t* KVda; bf16_t* Gt; bf16_t* ya; bf16_t* yd; unsigned* ctr; unsigned* kmax2; unsigned* bar; bf16_t* Mg; bf16_t* Y2; bf16_t* Y3; };

template <bool HAS_Y, bool HAS_NEXT, bool HIN_BF16, bool HOUT_BF16>
__device__ __forceinline__ void rowwise_phase(LAS unsigned char* lds, int vcu, int G, const void* hin_, void* hout_, const bf16_t* Y, const float* SS,
                                              const float* modp, const float* npost, const float* npre, int isub, float rw, bf16_t* U) {
    int tid_ = threadIdx.x; asm volatile("" : "+v"(tid_));
    const int tid = tid_, lane = tid & 63, wave = __builtin_amdgcn_readfirstlane(tid >> 6);
    LAS float* vA = (LAS float*)lds; LAS float* vB = vA + 1024; LAS float* vC = vB + 1024;
    for (int rb = vcu; rb < MT / 256; rb += G) {
        const int b = rb >> 5;
        for (int n = tid; n < DM; n += NTHREADS) {
            if (HAS_Y) { float gsum = 0.f;
#pragma unroll
                for (int kc = 0; kc < 16; ++kc) gsum += modp[(size_t)(kc * 8 + b) * NMOD + (isub * 3 + 2) * DM + n];
                vA[n] = rw * gsum * npost[isub * DM + n]; }
            if (HAS_NEXT) { const int jn = isub + 1; float sc = 0.f, sh = 0.f;
#pragma unroll
                for (int kc = 0; kc < 16; ++kc) { sh += modp[(size_t)(kc * 8 + b) * NMOD + (jn * 3 + 0) * DM + n]; sc += modp[(size_t)(kc * 8 + b) * NMOD + (jn * 3 + 1) * DM + n]; }
                vB[n] = npre[jn * DM + n] * (1.0f + sc); vC[n] = sh; }
        }
        __syncthreads();
        f32x4 a[4], bb[4], cc[4];
#pragma unroll
        for (int j = 0; j < 4; ++j) { const int c0 = 4 * lane + 256 * j;
            a[j] = HAS_Y ? *(const LAS f32x4*)(vA + c0) : (f32x4){0.f, 0.f, 0.f, 0.f};
            bb[j] = HAS_NEXT ? *(const LAS f32x4*)(vB + c0) : (f32x4){0.f, 0.f, 0.f, 0.f};
            cc[j] = HAS_NEXT ? *(const LAS f32x4*)(vC + c0) : (f32x4){0.f, 0.f, 0.f, 0.f}; }
        for (int rr = 0; rr < 32; rr += 2) {
            f32x4 hv[2][4]; u32x2 yv[2][4]; float rsy[2];
#pragma unroll
            for (int u = 0; u < 2; ++u) { const size_t row = (size_t)rb * 256 + wave * 32 + rr + u;
#pragma unroll
                for (int j = 0; j < 4; ++j) {
                    if (HIN_BF16) { const u32x2 t = *(const u32x2*)((const bf16_t*)hin_ + row * DM + 4 * lane + 256 * j); hv[u][j] = (f32x4){bf_lo(t.x), bf_hi(t.x), bf_lo(t.y), bf_hi(t.y)}; }
                    else hv[u][j] = *(const f32x4*)((const float*)hin_ + row * DM + 4 * lane + 256 * j);
                    if (HAS_Y) yv[u][j] = *(const u32x2*)(Y + row * DM + 4 * lane + 256 * j); }
                if (HAS_Y) { const f32x4 s0 = *(const f32x4*)(SS + row * 16), s1 = *(const f32x4*)(SS + row * 16 + 4), s2 = *(const f32x4*)(SS + row * 16 + 8), s3 = *(const f32x4*)(SS + row * 16 + 12);
                    const float ssum = ((s0[0] + s0[1]) + (s0[2] + s0[3])) + ((s1[0] + s1[1]) + (s1[2] + s1[3])) + ((s2[0] + s2[1]) + (s2[2] + s2[3])) + ((s3[0] + s3[1]) + (s3[2] + s3[3]));
                    rsy[u] = 1.0f / sqrtf(ssum * (1.0f / DM) + EPS); } }
            asm volatile("" ::: "memory");
#pragma unroll
            for (int u = 0; u < 2; ++u) { const size_t row = (size_t)rb * 256 + wave * 32 + rr + u;
                if (HAS_Y) {
#pragma unroll
                    for (int j = 0; j < 4; ++j) { hv[u][j][0] += a[j][0] * (bf_lo(yv[u][j].x) * rsy[u]); hv[u][j][1] += a[j][1] * (bf_hi(yv[u][j].x) * rsy[u]);
                        hv[u][j][2] += a[j][2] * (bf_lo(yv[u][j].y) * rsy[u]); hv[u][j][3] += a[j][3] * (bf_hi(yv[u][j].y) * rsy[u]);
                        if (HOUT_BF16) { u32x2 o; o.x = cvt_pk_bf16(hv[u][j][0], hv[u][j][1]); o.y = cvt_pk_bf16(hv[u][j][2], hv[u][j][3]);
                            *(u32x2*)((bf16_t*)hout_ + row * DM + 4 * lane + 256 * j) = o;
                            hv[u][j] = (f32x4){bf_lo(o.x), bf_hi(o.x), bf_lo(o.y), bf_hi(o.y)}; }
                        else *(f32x4*)((float*)hout_ + row * DM + 4 * lane + 256 * j) = hv[u][j]; }
                }
                if (HAS_NEXT) {
                    float s = 0.f;
#pragma unroll
                    for (int j = 0; j < 4; ++j) s += (hv[u][j][0] * hv[u][j][0] + hv[u][j][1] * hv[u][j][1]) + (hv[u][j][2] * hv[u][j][2] + hv[u][j][3] * hv[u][j][3]);
                    const float rs = 1.0f / sqrtf(wave_sum(s) * (1.0f / DM) + EPS);
#pragma unroll
                    for (int j = 0; j < 4; ++j) { u32x2 o; o.x = cvt_pk_bf16(hv[u][j][0] * rs * bb[j][0] + cc[j][0], hv[u][j][1] * rs * bb[j][1] + cc[j][1]);
                        o.y = cvt_pk_bf16(hv[u][j][2] * rs * bb[j][2] + cc[j][2], hv[u][j][3] * rs * bb[j][3] + cc[j][3]);
                        *(u32x2*)(U + row * DM + 4 * lane + 256 * j) = o; }
                }
            }
        }
        __syncthreads();
    }
}

#define XB_TMO      128
#define XB_XCNT(j)  (256  + 64 * (j))
#define XB_XSUB(j)  (1280 + 64 * (j))
#define XB_XGEN(j)  (2304 + 64 * (j))
#define XB_TOP      3328
#define XB_TOPGEN   3392
#define XCD_BAR_WORDS 3456
#define XB_SPIN_CAP (1u << 18)

__device__ __forceinline__ unsigned xb_ld(unsigned* p)              { return __hip_atomic_load(p, __ATOMIC_RELAXED, __HIP_MEMORY_SCOPE_AGENT); }
__device__ __forceinline__ unsigned xb_add(unsigned* p, unsigned v) { return __hip_atomic_fetch_add(p, v, __ATOMIC_RELAXED, __HIP_MEMORY_SCOPE_AGENT); }
__device__ __forceinline__ unsigned xb_xcc_id() { return (unsigned)__builtin_amdgcn_s_getreg((3 << 11) | 20) & 0xFu; }
#define XB_SPIN(cond, bar) do { unsigned _sp = 0; while (cond) { __builtin_amdgcn_s_sleep(1); \
    if ((++_sp & 255u) == 0u) { if (xb_ld(&(bar)[XB_TMO])) break; if (_sp > XB_SPIN_CAP) { atomicAdd(&(bar)[XB_TMO], 1u); break; } } } } while (0)

struct XcdBarrier {
    unsigned* bar; unsigned x;
    volatile LAS unsigned* st;
};

__device__ __forceinline__ XcdBarrier xcd_barrier_post(unsigned* bar, volatile LAS unsigned* st) {
    XcdBarrier b; b.bar = bar; b.x = xb_xcc_id(); b.st = st;
    if (threadIdx.x == 0) (void)xb_add(&bar[XB_XCNT(b.x)], 1u);
    return b;
}
__device__ __forceinline__ void xcd_barrier_complete(unsigned* bar, unsigned x, unsigned& nloc, unsigned& nx) {
    const unsigned G = gridDim.x * gridDim.y * gridDim.z;
    unsigned sum, cnt, mine, sp = 0u;
    for (;;) {
        sum = 0u; cnt = 0u; mine = 0u;
#pragma unroll
        for (unsigned j = 0; j < 16; ++j) { const unsigned c = xb_ld(&bar[XB_XCNT(j)]); sum += c; cnt += (c > 0u) ? 1u : 0u; mine = (j == x) ? c : mine; }
        if (sum == G) break;
        __builtin_amdgcn_s_sleep(1);
        if ((++sp & 255u) == 0u) { if (xb_ld(&bar[XB_TMO])) break; if (sp > XB_SPIN_CAP) { atomicAdd(&bar[XB_TMO], 1u); break; } }
    }
    nloc = mine > 0u ? mine : 1u; nx = cnt > 0u ? cnt : 1u;
}

__device__ __forceinline__ void xcd_barrier(const XcdBarrier& b) {
    asm volatile("s_waitcnt vmcnt(0)" ::: "memory");
    __syncthreads();
    if (threadIdx.x == 0) {
        unsigned* bar = b.bar;
        __builtin_amdgcn_s_waitcnt(0);
        unsigned nloc = b.st[0], nx = b.st[1];
        if (nloc == 0u) { xcd_barrier_complete(bar, b.x, nloc, nx); b.st[0] = nloc; b.st[1] = nx; }
        const unsigned old = xb_add(&bar[XB_XSUB(b.x)], 1u);
        const unsigned gen = old / nloc;
        if (old + 1u == (gen + 1u) * nloc) {
            __builtin_amdgcn_fence(__ATOMIC_RELEASE, "agent");
            asm volatile("s_waitcnt vmcnt(0)" ::: "memory");
            const unsigned og = xb_add(&bar[XB_TOP], 1u);
            const unsigned tg = og / nx;
            if (og + 1u == (tg + 1u) * nx) xb_add(&bar[XB_TOPGEN], 1u);
            else XB_SPIN(xb_ld(&bar[XB_TOPGEN]) == tg, bar);
            __builtin_amdgcn_fence(__ATOMIC_ACQUIRE, "agent");
            xb_add(&bar[XB_XGEN(b.x)], 1u);
            asm volatile("s_waitcnt vmcnt(0)" ::: "memory");
        } else {
            XB_SPIN(xb_ld(&bar[XB_XGEN(b.x)]) == gen, bar);
            __builtin_amdgcn_fence(__ATOMIC_ACQUIRE, "agent");
            asm volatile("s_waitcnt vmcnt(0)" ::: "memory");
        }
    }
    __syncthreads();
}


__global__ void __launch_bounds__(NTHREADS, 2) fwd_megakernel(Args args) {
    extern __shared__ __attribute__((aligned(16))) unsigned char lds_raw[];
    LAS unsigned char* lds = (LAS unsigned char*)lds_raw;
    cg::grid_group grid = cg::this_grid();
    const int tid = threadIdx.x, lane = tid & 63, wave = __builtin_amdgcn_readfirstlane(tid >> 6);
    const int G = gridDim.x, bx = blockIdx.x; const int vcu = (G % 8 == 0) ? (bx % 8) * (G / 8) + bx / 8 : bx;
    TSTART();
    volatile LAS unsigned* xst = (volatile LAS unsigned*)(lds + (LDS_BYTES - 32));
    if (tid < 2) xst[tid] = 0u;
    if (bx == 0) for (int i = tid; i < XCD_BAR_WORDS; i += NTHREADS) __hip_atomic_store(args.bar + i, 0u, __ATOMIC_RELAXED, __HIP_MEMORY_SCOPE_AGENT);
    if (bx == 0 && tid == 0) __hip_atomic_store(args.ctr, 0u, __ATOMIC_RELAXED, __HIP_MEMORY_SCOPE_AGENT);
    if (bx == 0 && tid < 128) __hip_atomic_store(args.kmax2 + tid, 0u, __ATOMIC_RELAXED, __HIP_MEMORY_SCOPE_AGENT);
    {
        LAS float* scr = (LAS float*)(lds + wave * 8448);
        const int gw = vcu * NWAVES + wave, NGW = G * NWAVES;
        constexpr int I_G = (DM / 64) * (DFF / 32), I_D = (DFF / 64) * (DM / 32), I_IN = (DM / 64) * (INW / 32), I_BR = (512 / 64) * (DM / 32), I_O = (DM / 64) * (DM / 32);
        constexpr int NITEMS = 4 * I_G + 2 * I_D + I_IN + 2 * I_BR + I_O;
        for (int it = gw; it < NITEMS; it += NGW) {
            int r = it;
            if (r < I_G) { p0_transpose_item(args.in[6], DM, DFF, args.Wgu[0], 1, scr, r, lane); continue; } r -= I_G;
            if (r < I_G) { p0_transpose_item(args.in[7], DM, DFF, args.Wgu[0], 2, scr, r, lane); continue; } r -= I_G;
            if (r < I_G) { p0_transpose_item(args.in[18], DM, DFF, args.Wgu[1], 1, scr, r, lane); continue; } r -= I_G;
            if (r < I_G) { p0_transpose_item(args.in[19], DM, DFF, args.Wgu[1], 2, scr, r, lane); continue; } r -= I_G;
            if (r < I_D) { p0_transpose_item(args.in[8], DFF, DM, args.Wd[0], 0, scr, r, lane); continue; } r -= I_D;
            if (r < I_D) { p0_transpose_item(args.in[20], DFF, DM, args.Wd[1], 0, scr, r, lane); continue; } r -= I_D;
            if (r < I_IN) { p0_transpose_item(args.in[9], DM, INW, args.Win, 0, scr, r, lane); continue; } r -= I_IN;
            if (r < I_BR) { p0_transpose_item(args.in[15], 512, DM, args.Wsb, 0, scr, r, lane); continue; } r -= I_BR;
            if (r < I_BR) { p0_transpose_item(args.in[16], 512, DM, args.Wda, 0, scr, r, lane); continue; } r -= I_BR;
            p0_transpose_item(args.in[17], DM, DM, args.Wout, 0, scr, r, lane);
        }
        LAS float* sc = (LAS float*)(lds + 69632);
        for (int i = tid; i < NB * DM; i += NTHREADS) { const float cv = args.in[1][i]; sc[i] = cv * sigmoidf_(cv); }
        __syncthreads();
        for (int task = bx * NTHREADS + tid; task < 16 * NMOD; task += G * NTHREADS) {
            const int kc = task / NMOD, n = task % NMOD;
            float acc[8];
#pragma unroll
            for (int b = 0; b < 8; ++b) acc[b] = 0.f;
            for (int k = kc * 64; k < kc * 64 + 64; ++k) { const float wv = args.in[2][(size_t)k * NMOD + n];
#pragma unroll
                for (int b = 0; b < 8; ++b) acc[b] += sc[b * DM + k] * wv; }
            if (kc == 0) { const float bv = args.in[3][n];
#pragma unroll
                for (int b = 0; b < 8; ++b) acc[b] += bv; }
#pragma unroll
            for (int b = 0; b < 8; ++b) args.modp[(size_t)(kc * 8 + b) * NMOD + n] = acc[b];
        }
    }
    TEND(0);
    grid.sync();
    (void)xcd_barrier_post(args.bar, xst);
#define GSYNC() do { XcdBarrier b_; b_.bar = args.bar; b_.x = xb_xcc_id(); b_.st = (volatile LAS unsigned*)(lds + (LDS_BYTES - 32)); xcd_barrier(b_); } while (0)

    TEND(10);
    rowwise_phase<false, true, false, false>(lds, vcu, G, args.in[0], nullptr, nullptr, nullptr, args.modp, args.in[5], args.in[4], -1, 0.f, args.U);
    TEND(1);
    GSYNC();
    TEND(10);

    for (int f = 0; f < 2; ++f) {
        { pg8::Gemm g{args.U, args.Wgu[f], MT, NGU, DM, DM}; pg8::StaticOrder S; S.init(MT, NGU, G, bx); pg8::EpiSwiGLU E{args.BIG}; pg8::gemm_phase(lds, g, S, E); }
        TEND(2);
        GSYNC();
        TEND(10);
        { pg8::Gemm g{args.BIG, args.Wd[f], MT, DM, DFF, DFF}; pg8::StaticOrder S; S.init(MT, DM, G, bx); pg8::EpiY E{f ? args.Y3 : args.Y, args.SS}; pg8::gemm_phase(lds, g, S, E); }
        TEND(3);
        GSYNC();
        TEND(10);
        if (f == 0) {
            rowwise_phase<true, true, false, true>(lds, vcu, G, args.in[0], args.Y, args.Y, args.SS, args.modp, args.in[5], args.in[4], 0, 0.5f, args.U);
            TEND(1);
            GSYNC();
            TEND(10);
            { pg8::Gemm g{args.U, args.Win, MT, INW, DM, DM}; pg8::StaticOrder S; S.init(MT, INW, G, bx); pg8::EpiProj E{args.Qsb, args.KVsb, args.Qda, args.KVda, args.Gt, args.kmax2}; pg8::gemm_phase(lds, g, S, E); }
            TEND(4);
            GSYNC();
            TEND(10);
            {
                float d1 = 0.f, d2 = 0.f;
                for (int i = 0; i < 64; ++i) { d1 += args.in[10][i] * args.in[11][i]; d2 += args.in[12][i] * args.in[13][i]; }
                const float lam = expf(d1) - expf(d2) + LAMBDA_INIT;
                LAS unsigned* slot = (LAS unsigned*)(lds + (LDS_BYTES - 16));
                for (;;) {
                    if (tid == 0) *slot = __hip_atomic_fetch_add(args.ctr, 1u, __ATOMIC_RELAXED, __HIP_MEMORY_SCOPE_AGENT);
                    __syncthreads();
                    const unsigned u = *slot;
                    __syncthreads();
                    if (u >= 3072u) break;
                    if (u < 1024u) { const int hh = 3 - (int)(u >> 8), rem = (int)(u & 255u), qb = 31 - (rem >> 3), bh = (rem & 7) * 4 + hh;
                        const float slope = exp2f(-2.0f * (float)(hh + 1));
                        att::da_unit(lds, args.Qda + (size_t)bh * SEQ * 128, args.KVda + (size_t)bh * SEQ * 256, args.yd + (size_t)(bh >> 2) * SEQ * 512 + 128 * hh, qb, lam, args.in[14], slope, args.kmax2 + bh * 4);
                    } else { const int v = (int)u - 1024, bh = v >> 5, qb = 31 - (v & 31);
                        att::sb_unit(lds, args.Qsb + (size_t)bh * SEQ * 64, args.KVsb + (size_t)bh * SEQ * 128, args.ya + (size_t)(bh >> 3) * SEQ * 512 + 64 * (bh & 7), qb); }
                }
            }
            TEND(5);
            GSYNC();
            TEND(10);
            { pg8::Gemm g{args.ya, args.Wsb, MT, DM, 512, 512}; pg8::StaticOrder S; S.init(MT, DM, G, bx); pg8::EpiGate<true> E{args.Mg, args.Gt, 0}; pg8::gemm_phase(lds, g, S, E); }
            __syncthreads();
            { pg8::Gemm g{args.yd, args.Wda, MT, DM, 512, 512}; pg8::StaticOrder S; S.init(MT, DM, G, bx); pg8::EpiGate<false> E{args.Mg, args.Gt, 1024}; pg8::gemm_phase(lds, g, S, E); }
            TEND(6);
            GSYNC();
            TEND(10);
            { pg8::Gemm g{args.Mg, args.Wout, MT, DM, DM, DM}; pg8::StaticOrder S; S.init(MT, DM, G, bx); pg8::EpiY E{args.Y2, args.SS}; pg8::gemm_phase(lds, g, S, E); }
            TEND(7);
            GSYNC();
            TEND(10);
            rowwise_phase<true, true, true, true>(lds, vcu, G, args.Y, args.Y, args.Y2, args.SS, args.modp, args.in[5], args.in[4], 1, 1.0f, args.U);
            TEND(1);
            GSYNC();
            TEND(10);
        } else {
            rowwise_phase<true, false, true, false>(lds, vcu, G, args.Y, args.out, args.Y3, args.SS, args.modp, args.in[5], args.in[4], 2, 0.5f, nullptr);
            TEND(1);
        }
    }
}

extern "C" void kernel_launch(void* const* d_in, const int* in_sizes, int n_in, void* d_out, int out_size, void* d_ws, size_t ws_size, hipStream_t stream) {
    static int grid = 0;
    if (grid == 0) {
        if (n_in != 21 || in_sizes[0] != MT * DM || out_size != MT * DM || ws_size < WS_END) {
            fprintf(stderr, "kernel_launch: unexpected shapes (n_in %d in0 %d out %d ws %zu); nothing launched\n", n_in, n_in > 0 ? in_sizes[0] : -1, out_size, ws_size); grid = -1; return; }
        int dev = 0, cus = 0, per_cu = 0;
        hipGetDevice(&dev);
        hipDeviceGetAttribute(&cus, hipDeviceAttributeMultiprocessorCount, dev);
        if (hipFuncSetAttribute((const void*)fwd_megakernel, hipFuncAttributeMaxDynamicSharedMemorySize, LDS_BYTES) != hipSuccess) fprintf(stderr, "kernel_launch: hipFuncSetAttribute failed\n");
        if (hipOccupancyMaxActiveBlocksPerMultiprocessor(&per_cu, (const void*)fwd_megakernel, NTHREADS, LDS_BYTES) != hipSuccess || per_cu < 1) { fprintf(stderr, "kernel_launch: occupancy query gave %d\n", per_cu); per_cu = 1; }
        (void)hipGetLastError();
        grid = cus * 1;
        if (grid <= 0) grid = 256;
    }
    if (grid < 0) return;
    Args a{};
    for (int i = 0; i < 21; ++i) a.in[i] = (const float*)d_in[i];
    unsigned char* ws = (unsigned char*)d_ws;
    a.out = (float*)d_out; a.modp = (float*)(ws + WS_MODP); a.SS = (float*)(ws + WS_SS);
    a.Wgu[0] = (bf16_t*)(ws + WS_WGU1); a.Wgu[1] = (bf16_t*)(ws + WS_WGU2); a.Wd[0] = (bf16_t*)(ws + WS_WD1); a.Wd[1] = (bf16_t*)(ws + WS_WD2);
    a.Win = (bf16_t*)(ws + WS_WIN); a.Wsb = (bf16_t*)(ws + WS_WSB); a.Wda = (bf16_t*)(ws + WS_WDA); a.Wout = (bf16_t*)(ws + WS_WOUT);
    a.U = (bf16_t*)(ws + WS_U); a.Y = (bf16_t*)(ws + WS_Y); a.BIG = (bf16_t*)(ws + WS_BIG);
    a.Qsb = (bf16_t*)(ws + WS_BIG); a.KVsb = (bf16_t*)(ws + WS_BIG + 64 * MiB); a.Qda = (bf16_t*)(ws + WS_BIG + 192 * MiB); a.KVda = (bf16_t*)(ws + WS_BIG + 256 * MiB); a.Gt = (bf16_t*)(ws + WS_BIG + 384 * MiB);
    a.ctr = (unsigned*)ws; a.kmax2 = (unsigned*)(ws + 4096); a.bar = (unsigned*)(ws + 16384);
    a.ya = (bf16_t*)(ws + WS_U); a.yd = (bf16_t*)(ws + WS_U + 64 * MiB);
    a.Mg = (bf16_t*)(ws + WS_BIG + 256 * MiB); a.Y2 = (bf16_t*)(ws + WS_BIG + 64 * MiB); a.Y3 = (bf16_t*)(ws + WS_BIG + 384 * MiB);
    void* kargs[] = {&a};
    hipError_t e = hipLaunchCooperativeKernel((const void*)fwd_megakernel, dim3(grid), dim3(NTHREADS), kargs, LDS_BYTES, stream);
    if (e != hipSuccess) fprintf(stderr, "cooperative launch failed: %s (grid %d)\n", hipGetErrorString(e), grid);
}
```

```cpp
#include <hip/hip_runtime.h>
#include <hip/hip_cooperative_groups.h>
#include <cstdio>
#include <cstdint>
namespace cg = cooperative_groups;

#define LAS __attribute__((address_space(3)))
typedef unsigned short bf16_t;
typedef short bf16x8 __attribute__((ext_vector_type(8)));
typedef short s16x4 __attribute__((ext_vector_type(4)));
typedef float f32x4 __attribute__((ext_vector_type(4)));
typedef float f32x16 __attribute__((ext_vector_type(16)));
typedef unsigned u32x4 __attribute__((ext_vector_type(4)));
typedef unsigned u32x2 __attribute__((ext_vector_type(2)));

constexpr int DM = 1024, NB = 8, SEQ = 8192, MT = NB * SEQ, DFF = 2816, NGU = 2 * DFF, INW = 5120, NMOD = 9216;
constexpr float EPS = 1e-6f, LOG2E = 1.4426950408889634f, LN2 = 0.6931471805599453f;
constexpr float LAMBDA_INIT = 0.2f;

constexpr size_t MiB = 1u << 20;
constexpr size_t WS_MODP = 1 * MiB;
constexpr size_t WS_SS = 6 * MiB;
constexpr size_t WS_WGU1 = 10 * MiB, WS_WD1 = 21 * MiB, WS_WIN = 27 * MiB, WS_WSB = 37 * MiB, WS_WDA = 38 * MiB, WS_WOUT = 39 * MiB, WS_WGU2 = 41 * MiB, WS_WD2 = 52 * MiB;
constexpr size_t WS_U = 64 * MiB;
constexpr size_t WS_Y = 192 * MiB;
constexpr size_t WS_BIG = 320 * MiB;
constexpr size_t WS_END = 960 * MiB;

typedef float f32x2_t __attribute__((ext_vector_type(2))); typedef __bf16 bf16x2_t __attribute__((ext_vector_type(2)));
__device__ __forceinline__ unsigned cvt_pk_bf16(float lo, float hi) { const f32x2_t v = {lo, hi}; const bf16x2_t b = __builtin_convertvector(v, bf16x2_t); return __builtin_bit_cast(unsigned, b); }
__device__ __forceinline__ float bf_lo(unsigned u) { return __uint_as_float(u << 16); }
__device__ __forceinline__ float bf_hi(unsigned u) { return __uint_as_float(u & 0xffff0000u); }
__device__ __forceinline__ float fast_exp2(float x) { return __builtin_amdgcn_exp2f(x); }
__device__ __forceinline__ float fast_log2(float x) { return __builtin_amdgcn_logf(x); }
__device__ __forceinline__ float fast_rcp(float x) { return __builtin_amdgcn_rcpf(x); }
__device__ __forceinline__ float sigmoidf_(float x) { return fast_rcp(1.0f + fast_exp2(-x * LOG2E)); }
__device__ __forceinline__ float wave_sum(float v) {
#pragma unroll
    for (int o = 1; o < 64; o <<= 1) v += __shfl_xor(v, o);
    return v;
}

__device__ __forceinline__ void glds_s(const void* sbase, unsigned voff, unsigned lds_dst) {
    unsigned keep;
    asm volatile("s_mov_b32 %0, m0\n\ts_mov_b32 m0, %3\n\ts_nop 0\n\tglobal_load_lds_dwordx4 %1, %2\n\ts_mov_b32 m0, %0" : "=&s"(keep) : "v"(voff), "s"(sbase), "s"(lds_dst) : "memory");
}

namespace pg8 {
constexpr int BM = 256, BK = 64, HALF = 128, HTB = HALF * BK * 2, STAGE_BYTES = 8 * HTB, NXCD = 8, WGM = 8;
__host__ __device__ __forceinline__ int lds_byte(int r, int c) { const int st = (r >> 4) * 2 + (c >> 5), rr = r & 15, cc = c & 31, ob = rr * 64 + cc * 2; return st * 1024 + (ob ^ (((ob >> 9) & 1) << 5)); }
__host__ __device__ __forceinline__ void stage_rc(int b, int& R, int& C) { const int st = b / 1024, sb = b % 1024, swz = sb ^ (((sb >> 9) & 1) << 5); R = (st >> 1) * 16 + swz / 64; C = (st & 1) * 32 + (swz % 64) / 2; }
__host__ __device__ __forceinline__ int perm32(int rho) { const int n = rho >> 4, i = rho & 15; return 8 * (i >> 2) + 4 * n + (i & 3); }

struct Unit { int pm, pn; };
__device__ __forceinline__ size_t native_off(int pm, int pn, int ai, int m, int bj, int wr, int wc, int fr, int fq) {
    return ((((((size_t)pm * 4 + pn) * 2 + ai) * 4 + m) * 2 + bj) * 512 + (size_t)((wr * 4 + wc) * 64 + fq * 16 + fr)) * 8; }
struct Gemm { const bf16_t* A; const bf16_t* Bt; int M, N, K, lda; };

struct StaticOrder {
    int nM, nN, nwg, G, c;
    __device__ void init(int M, int N, int G_, int c_) { nM = M / BM; nN = N / BM; nwg = nM * nN; G = G_; c = c_; }
    __device__ bool next(int i, Unit& u) const {
        const long L = (long)i * G + c; if (L >= nwg) return false;
        int wgid = (int)L; { const int q = nwg / NXCD, r = nwg % NXCD, xcd = wgid % NXCD, off = wgid / NXCD; wgid = (xcd < r ? xcd * (q + 1) : r * (q + 1) + (xcd - r) * q) + off; }
        const int nig = WGM * nN, gid = wgid / nig, fm = gid * WGM, gsz = (nM - fm) < WGM ? (nM - fm) : WGM;
        u.pm = fm + ((wgid % nig) % gsz); u.pn = (wgid % nig) / gsz; return true;
    }
};

template <class Epi>
__device__ __forceinline__ void gemm_phase(LAS unsigned char* lds, const Gemm g, const StaticOrder& S, const Epi& E) {
    int tid_ = threadIdx.x; asm volatile("" : "+v"(tid_));
    const int tid = tid_, wid = __builtin_amdgcn_readfirstlane(tid >> 6), lane = tid & 63, wr = wid >> 2, wc = wid & 3, fr = lane & 15, fq = lane >> 4;
    const int K = g.K, nt = K / BK, lda = g.lda;
    unsigned voffA[2], voffB[2];
#pragma unroll
    for (int i = 0; i < 2; ++i) { int R, C; stage_rc(tid * 16 + i * 8192, R, C); const int Rb = (R & ~31) + perm32(R & 31);
        voffA[i] = (unsigned)(R * lda + C) * 2u; voffB[i] = (unsigned)(Rb * K + C) * 2u; }
    const size_t kstep = (size_t)(BK * 2);
    const size_t hstepA = (size_t)HALF * lda * 2, hstepB = (size_t)HALF * K * 2;
    const size_t tstepA = 2 * hstepA, tstepB = 2 * hstepB;
    const unsigned ldsbase = (unsigned)(uintptr_t)lds + (unsigned)wid * 1024u;
    const int aoff = lds_byte(wr * 64 + fr, fq * 8), boff = lds_byte(wc * 32 + fr, fq * 8);
#define PG8_SA(b, h) (((b) * 2 + (h)) * HTB)
#define PG8_SB(b, h) ((4 + (b) * 2 + (h)) * HTB)
#define PG8_STAGE(bufoff, gbase, voff) do { _Pragma("unroll") for (int _i = 0; _i < 2; ++_i) \
        glds_s((const void*)(gbase), (voff)[_i], ldsbase + (unsigned)((bufoff) + _i * 8192)); } while (0)
#define PG8_LDA(dst, b, h) do { _Pragma("unroll") for (int m = 0; m < 4; ++m) _Pragma("unroll") for (int k = 0; k < 2; ++k) dst[m][k] = *(const LAS bf16x8*)(lds + PG8_SA(b, h) + aoff + m * 2048 + k * 1024); } while (0)
#define PG8_LDB(dst, b, h) do { _Pragma("unroll") for (int n = 0; n < 2; ++n) _Pragma("unroll") for (int k = 0; k < 2; ++k) dst[n][k] = *(const LAS bf16x8*)(lds + PG8_SB(b, h) + boff + n * 2048 + k * 1024); } while (0)
#define PG8_MMA(ai, bj, At, Bt) do { __builtin_amdgcn_s_setprio(1); _Pragma("unroll") for (int m = 0; m < 4; ++m) _Pragma("unroll") for (int n = 0; n < 2; ++n) _Pragma("unroll") for (int k = 0; k < 2; ++k) \
        acc[ai][bj][m][n] = __builtin_amdgcn_mfma_f32_16x16x32_bf16(Bt[n][k], At[m][k], acc[ai][bj][m][n], 0, 0, 0); __builtin_amdgcn_s_setprio(0); } while (0)
#define PG8_WAIT_V(n) asm volatile("s_waitcnt vmcnt(" #n ")" ::: "memory")
#define PG8_WAIT_L(n) asm volatile("s_waitcnt lgkmcnt(" #n ")" ::: "memory")
#define PG8_BAR __builtin_amdgcn_s_barrier()
#define PG8_SCHED __builtin_amdgcn_sched_barrier(0)
    Unit cur, nxt; int ui = 0;
    if (!S.next(0, cur)) return;
    f32x4 acc[2][2][4][2];
#pragma unroll
    for (int a = 0; a < 2; ++a)
#pragma unroll
        for (int b = 0; b < 2; ++b)
#pragma unroll
            for (int m = 0; m < 4; ++m)
#pragma unroll
                for (int n = 0; n < 2; ++n) acc[a][b][m][n] = (f32x4){0.f, 0.f, 0.f, 0.f};
    bf16x8 At[4][2], B0[2][2], B1[2][2];
    const char* cA = (const char*)g.A + (size_t)cur.pm * tstepA; const char* cB = (const char*)g.Bt + (size_t)cur.pn * tstepB;
    PG8_STAGE(PG8_SB(0, 0), cB, voffB); PG8_STAGE(PG8_SB(0, 1), cB + hstepB, voffB); PG8_STAGE(PG8_SA(0, 0), cA, voffA); PG8_STAGE(PG8_SA(0, 1), cA + hstepA, voffA);
    if (wr == 1) PG8_BAR;
    PG8_WAIT_V(2); PG8_BAR;
    PG8_STAGE(PG8_SB(1, 0), cB + kstep, voffB); PG8_STAGE(PG8_SA(1, 0), cA + kstep, voffA); PG8_STAGE(PG8_SB(1, 1), cB + hstepB + kstep, voffB);
    PG8_WAIT_V(6); PG8_BAR;
    for (;;) {
        const bool has_next = S.next(ui + 1, nxt);
        const char* nA = has_next ? (const char*)g.A + (size_t)nxt.pm * tstepA : cA; const char* nB = has_next ? (const char*)g.Bt + (size_t)nxt.pn * tstepB : cB;
        for (int t = 0; t < nt; t += 2) {
            const bool last = (t == nt - 2);
            const char* a1 = cA + (size_t)(t + 1) * kstep;
            const char* a2 = last ? nA : cA + (size_t)(t + 2) * kstep; const char* b2 = last ? nB : cB + (size_t)(t + 2) * kstep;
            const char* a3 = a2 + kstep; const char* b3 = b2 + kstep;
            PG8_LDB(B0, 0, 0); PG8_LDB(B1, 0, 1); PG8_SCHED; PG8_LDA(At, 0, 0); PG8_STAGE(PG8_SA(1, 1), a1 + hstepA, voffA);
            PG8_WAIT_V(8); PG8_WAIT_L(0); PG8_BAR; PG8_MMA(0, 0, At, B0); PG8_MMA(0, 1, At, B1); PG8_BAR; PG8_SCHED;
            PG8_LDA(At, 0, 1); PG8_STAGE(PG8_SB(0, 0), b2, voffB); PG8_STAGE(PG8_SB(0, 1), b2 + hstepB, voffB); PG8_STAGE(PG8_SA(0, 0), a2, voffA);
            PG8_WAIT_V(8); PG8_WAIT_L(0); PG8_BAR; PG8_MMA(1, 0, At, B0); PG8_MMA(1, 1, At, B1); PG8_BAR; PG8_SCHED;
            PG8_LDB(B0, 1, 0); PG8_LDB(B1, 1, 1); PG8_SCHED; PG8_LDA(At, 1, 0); PG8_STAGE(PG8_SA(0, 1), a2 + hstepA, voffA);
            PG8_WAIT_V(8); PG8_WAIT_L(0); PG8_BAR; PG8_MMA(0, 0, At, B0); PG8_MMA(0, 1, At, B1); PG8_BAR; PG8_SCHED;
            PG8_LDA(At, 1, 1); PG8_STAGE(PG8_SB(1, 0), b3, voffB); PG8_STAGE(PG8_SB(1, 1), b3 + hstepB, voffB); PG8_STAGE(PG8_SA(1, 0), a3, voffA);
            PG8_WAIT_V(8); PG8_WAIT_L(0); PG8_BAR; PG8_MMA(1, 0, At, B0); PG8_MMA(1, 1, At, B1); PG8_BAR; PG8_SCHED;
        }
        if (wr == 0) PG8_BAR;
        E(acc, cur, wr, wc, fr, fq);
        if (!has_next) break;
#pragma unroll
        for (int a = 0; a < 2; ++a)
#pragma unroll
            for (int b = 0; b < 2; ++b)
#pragma unroll
                for (int m = 0; m < 4; ++m)
#pragma unroll
                    for (int n = 0; n < 2; ++n) acc[a][b][m][n] = (f32x4){0.f, 0.f, 0.f, 0.f};
        cur = nxt; cA = nA; cB = nB; ++ui;
        if (wr == 1) PG8_BAR;
    }
    PG8_WAIT_V(0);
    PG8_BAR;
#undef PG8_SA
#undef PG8_SB
#undef PG8_STAGE
#undef PG8_LDA
#undef PG8_LDB
#undef PG8_MMA
#undef PG8_WAIT_V
#undef PG8_WAIT_L
#undef PG8_BAR
#undef PG8_SCHED
}

struct EpiSwiGLU {
    bf16_t* H;
    __device__ __forceinline__ void operator()(const f32x4 (&acc)[2][2][4][2], const Unit& u, int wr, int wc, int fr, int fq) const {
        const int row0 = u.pm * BM + wr * 64 + fr, col0 = u.pn * HALF + wc * 32 + 8 * fq;
#pragma unroll
        for (int ai = 0; ai < 2; ++ai)
#pragma unroll
            for (int m = 0; m < 4; ++m) {
                float o[8];
#pragma unroll
                for (int n = 0; n < 2; ++n)
#pragma unroll
                    for (int e = 0; e < 4; ++e) { const float gv = acc[ai][0][m][n][e], uv = acc[ai][1][m][n][e]; o[n * 4 + e] = gv * sigmoidf_(gv) * uv; }
                u32x4 w; w.x = cvt_pk_bf16(o[0], o[1]); w.y = cvt_pk_bf16(o[2], o[3]); w.z = cvt_pk_bf16(o[4], o[5]); w.w = cvt_pk_bf16(o[6], o[7]);
                *(u32x4*)(H + (size_t)(row0 + ai * HALF + m * 16) * DFF + col0) = w;
                asm volatile("" ::: "memory");
            }
    }
};
struct EpiProj {
    bf16_t *Qsb, *KVsb, *Qda, *KVda, *Gt; unsigned* kmax2;
    __device__ __forceinline__ void operator()(const f32x4 (&acc)[2][2][4][2], const Unit& u, int wr, int wc, int fr, int fq) const {
        const int row0 = u.pm * BM + wr * 64 + fr; const int cbase = u.pn * BM; const bool sg = (cbase >= 3072); const bool kdt = (cbase == 2048 || cbase == 2304);
        float mxk[2] = {0.f, 0.f};
#pragma unroll
        for (int ai = 0; ai < 2; ++ai)
#pragma unroll
            for (int m = 0; m < 4; ++m) { const int row = row0 + ai * HALF + m * 16; const int b = row >> 13, t = row & (SEQ - 1);
#pragma unroll
                for (int bj = 0; bj < 2; ++bj) { f32x4 v0 = acc[ai][bj][m][0], v1 = acc[ai][bj][m][1];
                    const int c = cbase + bj * HALF + wc * 32 + 8 * fq;
                    bf16_t* dst;
                    if (cbase < 1536) { const int sec = c >> 9, cc = c & 511, h = cc >> 6, wv = cc & 63; const size_t ri = (size_t)(b * 8 + h) * SEQ + t;
                        dst = (sec == 0) ? Qsb + ri * 64 + wv : KVsb + ri * 128 + (sec == 2 ? 64 : 0) + wv; }
                    else if (cbase < 3072) { const int c2 = c - 1536, sec = c2 >> 9, cc = c2 & 511, h = cc >> 7, wv = cc & 127; const size_t ri = (size_t)(b * 4 + h) * SEQ + t;
                        dst = (sec == 0) ? Qda + ri * 128 + wv : KVda + ri * 256 + (sec == 2 ? 128 : 0) + wv; }
                    else { const int gc = cbase - 3072; dst = Gt + (size_t)(gc >> 10) * ((size_t)MT * 1024) + native_off(u.pm, (gc & 1023) >> 8, ai, m, bj, wr, wc, fr, fq); }
                    if (sg) {
#pragma unroll
                        for (int e = 0; e < 4; ++e) { v0[e] = sigmoidf_(v0[e]); v1[e] = sigmoidf_(v1[e]); } }
                    u32x4 w; w.x = cvt_pk_bf16(v0[0], v0[1]); w.y = cvt_pk_bf16(v0[2], v0[3]); w.z = cvt_pk_bf16(v1[0], v1[1]); w.w = cvt_pk_bf16(v1[2], v1[3]);
                    *(u32x4*)dst = w;
                    if (kdt) { float sq = (bf_lo(w.x) * bf_lo(w.x) + bf_hi(w.x) * bf_hi(w.x)) + (bf_lo(w.y) * bf_lo(w.y) + bf_hi(w.y) * bf_hi(w.y)) + (bf_lo(w.z) * bf_lo(w.z) + bf_hi(w.z) * bf_hi(w.z)) + (bf_lo(w.w) * bf_lo(w.w) + bf_hi(w.w) * bf_hi(w.w));
                        sq += __shfl_xor(sq, 16); sq += __shfl_xor(sq, 32); mxk[bj] = fmaxf(mxk[bj], sq); } }
                asm volatile("" ::: "memory"); }
        if (kdt) {
#pragma unroll
            for (int bj = 0; bj < 2; ++bj) { float v = mxk[bj];
#pragma unroll
                for (int o = 1; o < 16; o <<= 1) v = fmaxf(v, __shfl_xor(v, o));
                const int b = (u.pm * BM) >> 13, h = ((cbase - 2048) >> 7) + bj, idx = ((b * 4 + h) * 2 + (wc >> 1)) * 2 + (wc & 1);
                if ((threadIdx.x & 63) == 0) atomicMax(kmax2 + idx, __float_as_uint(v)); }
        }
    }
};
struct EpiY {
    bf16_t* Y; float* SS;
    __device__ __forceinline__ void operator()(const f32x4 (&acc)[2][2][4][2], const Unit& u, int wr, int wc, int fr, int fq) const {
        const int row0 = u.pm * BM + wr * 64 + fr, col0 = u.pn * BM + wc * 32 + 8 * fq;
#pragma unroll
        for (int ai = 0; ai < 2; ++ai)
#pragma unroll
            for (int m = 0; m < 4; ++m) { const int row = row0 + ai * HALF + m * 16; bf16_t* rowp = Y + (size_t)row * DM + col0; float s = 0.f;
#pragma unroll
                for (int bj = 0; bj < 2; ++bj) { const f32x4 v0 = acc[ai][bj][m][0], v1 = acc[ai][bj][m][1];
                    s += (v0[0] * v0[0] + v0[1] * v0[1]) + (v0[2] * v0[2] + v0[3] * v0[3]) + (v1[0] * v1[0] + v1[1] * v1[1]) + (v1[2] * v1[2] + v1[3] * v1[3]);
                    u32x4 w; w.x = cvt_pk_bf16(v0[0], v0[1]); w.y = cvt_pk_bf16(v0[2], v0[3]); w.z = cvt_pk_bf16(v1[0], v1[1]); w.w = cvt_pk_bf16(v1[2], v1[3]);
                    *(u32x4*)(rowp + bj * HALF) = w; }
                s += __shfl_xor(s, 16); s += __shfl_xor(s, 32);
                if (fq == 0) SS[(size_t)row * 16 + u.pn * 4 + wc] = s;
                asm volatile("" ::: "memory"); }
    }
};
template <bool FIRST> struct EpiGate {
    static constexpr bool PANEL = false;
    bf16_t* Mg; const bf16_t* Gt  ; bf16_t* Tn  ;
    __device__ __forceinline__ void operator()(const f32x4 (&acc)[2][2][4][2], const Unit& u, int wr, int wc, int fr, int fq) const {
        const int row0 = u.pm * BM + wr * 64 + fr, col0 = u.pn * BM + wc * 32 + 8 * fq;
#pragma unroll
        for (int ai = 0; ai < 2; ++ai) {
            u32x4 sg[4][2], tt[4][2];
#pragma unroll
            for (int m = 0; m < 4; ++m)
#pragma unroll
                for (int bj = 0; bj < 2; ++bj) { const size_t no = native_off(u.pm, u.pn, ai, m, bj, wr, wc, fr, fq);
                    sg[m][bj] = *(const u32x4*)(Gt + no);
                    if (!FIRST) tt[m][bj] = *(const u32x4*)(Tn + no); }
#pragma unroll
            for (int m = 0; m < 4; ++m)
#pragma unroll
                for (int bj = 0; bj < 2; ++bj) { const size_t row = (size_t)(row0 + ai * HALF + m * 16);
                    const f32x4 v0 = acc[ai][bj][m][0], v1 = acc[ai][bj][m][1]; const u32x4 sgv = sg[m][bj];
                    float o[8];
                    o[0] = bf_lo(sgv.x) * v0[0]; o[1] = bf_hi(sgv.x) * v0[1]; o[2] = bf_lo(sgv.y) * v0[2]; o[3] = bf_hi(sgv.y) * v0[3];
                    o[4] = bf_lo(sgv.z) * v1[0]; o[5] = bf_hi(sgv.z) * v1[1]; o[6] = bf_lo(sgv.w) * v1[2]; o[7] = bf_hi(sgv.w) * v1[3];
                    if (!FIRST) { const u32x4 t = tt[m][bj];
                        o[0] += bf_lo(t.x); o[1] += bf_hi(t.x); o[2] += bf_lo(t.y); o[3] += bf_hi(t.y); o[4] += bf_lo(t.z); o[5] += bf_hi(t.z); o[6] += bf_lo(t.w); o[7] += bf_hi(t.w); }
                    u32x4 w; w.x = cvt_pk_bf16(o[0], o[1]); w.y = cvt_pk_bf16(o[2], o[3]); w.z = cvt_pk_bf16(o[4], o[5]); w.w = cvt_pk_bf16(o[6], o[7]);
                    if (FIRST) *(u32x4*)(Tn + native_off(u.pm, u.pn, ai, m, bj, wr, wc, fr, fq)) = w;
                    else *(u32x4*)(Mg + row * DM + col0 + bj * HALF) = w; }
            asm volatile("" ::: "memory");
        }
    }
};
}

namespace att {
__device__ __forceinline__ int crow(int r, int hi) { return (r & 3) + 8 * (r >> 2) + 4 * hi; }

#define DS_RD128(dst, addr, imm) asm volatile("ds_read_b128 %0, %1 offset:%c2" : "=&v"(dst) : "v"(addr), "i"(imm) : "memory")
#define DS_RDTR(dst, addr, imm) asm volatile("ds_read_b64_tr_b16 %0, %1 offset:%c2" : "=&v"(dst) : "v"(addr), "i"(imm) : "memory")
constexpr int DA_KB = 0, DA_VB = 32768, DA_Q = 65536, DA_QP = 272, DA_QBUF = 32 * DA_QP, DA_TOTAL = DA_Q + 8 * DA_QBUF;
typedef short v4i16_t __attribute__((ext_vector_type(4)));
__device__ __forceinline__ s16x4 vtr(const LAS unsigned char* p) { return __builtin_bit_cast(s16x4, __builtin_amdgcn_ds_read_tr16_b64_v4i16((LAS v4i16_t*)p)); }
__device__ __forceinline__ float max3f(float a, float b, float c) { return fmaxf(fmaxf(a, b), c); }

__device__ __forceinline__ void da_unit(LAS unsigned char* lds, const bf16_t* Qp  , const bf16_t* KVp  , bf16_t* Op  , int qb, float lam, const float* subln, float slope, const unsigned* kmax2  ) {
    int tid_ = threadIdx.x; asm volatile("" : "+v"(tid_));
    const int tid = tid_, lane = tid & 63, q = lane & 31, hi = lane >> 5; const int w = __builtin_amdgcn_readfirstlane(tid >> 6);
    LAS unsigned char* Qw = lds + DA_Q + w * DA_QBUF;
    const unsigned ldsb = (unsigned)(uintptr_t)lds;
    unsigned voff[2];
#pragma unroll
    for (int i = 0; i < 2; ++i) { const int row = 8 * w + 4 * i + (lane >> 4); const int f = ((row & 3) << 2) | ((row >> 2) & 3); voff[i] = (unsigned)(row * 512 + 16 * ((lane & 15) ^ f)); }
    const char* const Pb = (const char*)KVp;
#define DA_DMA(kt, buf) do { const char* tb_ = Pb + (size_t)(kt) * (64 * 512); \
        _Pragma("unroll") for (int i_ = 0; i_ < 2; ++i_) { glds_s(tb_, voff[i_], ldsb + (unsigned)(DA_KB + (buf) * 16384 + (2 * w + i_) * 1024)); \
            glds_s(tb_ + 256, voff[i_], ldsb + (unsigned)(DA_VB + (buf) * 16384 + (2 * w + i_) * 1024)); } } while (0)
    const int nt = 4 * (qb + 1);
    DA_DMA(nt - 1, 0);
    {
        const float c1 = 0.125f * LOG2E;
#pragma unroll
        for (int i = 0; i < 8; ++i) { const int cid = lane + 64 * i, r = cid >> 4, ch = cid & 15;
            u32x4 v = *(const u32x4*)(Qp + (size_t)(qb * 256 + w * 32 + r) * 128 + 8 * ch);
            v.x = cvt_pk_bf16(bf_lo(v.x) * c1, bf_hi(v.x) * c1); v.y = cvt_pk_bf16(bf_lo(v.y) * c1, bf_hi(v.y) * c1);
            v.z = cvt_pk_bf16(bf_lo(v.z) * c1, bf_hi(v.z) * c1); v.w = cvt_pk_bf16(bf_lo(v.w) * c1, bf_hi(v.w) * c1);
            *(LAS u32x4*)(Qw + r * DA_QP + 16 * ch) = v; }
    }
    f32x16 o1[4], o2[4];
#pragma unroll
    for (int d = 0; d < 4; ++d) { o1[d] = (f32x16){}; o2[d] = (f32x16){}; }
    float m1 = -INFINITY, m2 = -INFINITY, l1 = 0.f, l2 = 0.f;
    const int tpos = qb * 256 + w * 32 + q;
    const float c2 = slope * LOG2E;
    const int F16 = 16 * (((q & 3) << 2) | ((q >> 2) & 3));
    const int kq = 256 * q;
    const int qq = (lane & 15) >> 2, g1 = (lane >> 4) & 1, pp = lane & 3;
    const int A0 = 256 * (4 * hi + qq) + 8 * (pp & 1);
    const int vbase0 = A0 + 16 * ((2 * g1 + (pp >> 1)) ^ hi), vbase1 = A0 + 2048 + 16 * ((2 * g1 + (pp >> 1)) ^ (hi + 2));
    asm volatile("s_waitcnt vmcnt(0)" ::: "memory");
    __syncthreads();
    float qb_[2];
#pragma unroll
    for (int mp = 0; mp < 2; ++mp) { float sq = 0.f;
#pragma unroll
        for (int d0 = 0; d0 < 4; ++d0) { const u32x4 f = *(const LAS u32x4*)(Qw + q * DA_QP + (64 * mp + 16 * d0 + 8 * hi) * 2);
            sq += (bf_lo(f.x) * bf_lo(f.x) + bf_hi(f.x) * bf_hi(f.x)) + (bf_lo(f.y) * bf_lo(f.y) + bf_hi(f.y) * bf_hi(f.y)) + (bf_lo(f.z) * bf_lo(f.z) + bf_hi(f.z) * bf_hi(f.z)) + (bf_lo(f.w) * bf_lo(f.w) + bf_hi(f.w) * bf_hi(f.w)); }
        sq += __shfl_xor(sq, 32);
        const float k2 = __uint_as_float(kmax2[2 * mp]) + __uint_as_float(kmax2[2 * mp + 1]);
        qb_[mp] = sqrtf(sq) * sqrtf(k2) * 1.001f + 0.01f; }
    const unsigned FH = (unsigned)(F16 ^ (16 * hi));
    const unsigned qaddr = (unsigned)(uintptr_t)Qw + (unsigned)(q * DA_QP + 16 * hi);
    const unsigned xq = 64u * (unsigned)qq;
#define DA_ISSUE_KQ(mp, kh) do { _Pragma("unroll") for (int d0_ = 0; d0_ < 4; ++d0_) { const unsigned ka_ = kcur + ((unsigned)(128 * (mp) + 32 * d0_) ^ FH); \
        DS_RD128(kf[d0_], ka_, 8192 * (kh)); DS_RD128(qf[d0_], qaddr, 128 * (mp) + 32 * d0_); } } while (0)
    for (int it = 0; it < nt; ++it) {
        const int kt = nt - 1 - it, cur = it & 1;
        if (kt > 0) DA_DMA(kt - 1, cur ^ 1);
        if ((kt - 4 * qb) <= (w >> 1)) {
            const bool band = kt >= 4 * qb;
            const unsigned kcur = ldsb + (unsigned)(DA_KB + cur * 16384 + kq);
            const unsigned vcur = ldsb + (unsigned)(DA_VB + cur * 16384);
#pragma unroll
            for (int kh = 1; kh >= 0; --kh) {
                f32x16 s[2];
#pragma unroll
                for (int mp = 0; mp < 2; ++mp) {
                    bf16x8 kf[4], qf[4];
                    DA_ISSUE_KQ(mp, kh);
                    asm volatile("s_waitcnt lgkmcnt(0)" : "+v"(kf[0]), "+v"(kf[1]), "+v"(kf[2]), "+v"(kf[3]), "+v"(qf[0]), "+v"(qf[1]), "+v"(qf[2]), "+v"(qf[3]) :: "memory");
                    s[mp] = (f32x16){};
#pragma unroll
                    for (int d0 = 0; d0 < 4; ++d0) s[mp] = __builtin_amdgcn_mfma_f32_32x32x16_bf16(kf[d0], qf[d0], s[mp], 0, 0, 0);
                }
                float off, mx[2]; bool doit[2];
                if (band) off = 0.f; else off = c2 * (float)(kt * 64 + 32 * kh + 4 * hi - tpos);
#pragma unroll
                for (int mp = 0; mp < 2; ++mp) {
                    if (band) { const float dbase = (float)(tpos - kt * 64 - 32 * kh - 4 * hi);
#pragma unroll
                        for (int r = 0; r < 16; ++r) s[mp][r] = s[mp][r] - c2 * fabsf(dbase - (float)crow(r, 0));
                    } else {
#pragma unroll
                        for (int r = 0; r < 16; ++r) s[mp][r] = fmaf(c2, (float)crow(r, 0), s[mp][r]);
                    }
                    float m_ = max3f(s[mp][0], s[mp][1], s[mp][2]);
#pragma unroll
                    for (int r = 3; r < 15; r += 2) m_ = max3f(m_, s[mp][r], s[mp][r + 1]);
                    m_ = fmaxf(m_, s[mp][15]) + off;
                    { auto rr = __builtin_amdgcn_permlane32_swap(__float_as_uint(m_), __float_as_uint(m_), false, false); m_ = fmaxf(__uint_as_float(rr[0]), __uint_as_float(rr[1])); }
                    mx[mp] = m_;
                    doit[mp] = !__all(m_ - (mp ? m2 : m1) < -160.0f);
                }
                if (doit[0] || doit[1]) {
                    s16x4 va_lo[4], va_hi[4], vb_lo[4], vb_hi[4];
#define DA_ISSUE_V(lo_, hi_, dbase_) do { _Pragma("unroll") for (int d_ = 0; d_ < 2; ++d_) { const unsigned xd_ = vcur + ((unsigned)(64 * ((dbase_) + d_)) ^ xq); const unsigned a0_ = xd_ + (unsigned)vbase0, a1_ = xd_ + (unsigned)vbase1; \
                        _Pragma("unroll") for (int j_ = 0; j_ < 2; ++j_) { DS_RDTR(lo_[2 * d_ + j_], a0_, 8192 * kh + 4096 * j_); DS_RDTR(hi_[2 * d_ + j_], a1_, 8192 * kh + 4096 * j_); } } } while (0)
                    DA_ISSUE_V(va_lo, va_hi, 0); DA_ISSUE_V(vb_lo, vb_hi, 2);
                    float dd[2];
#pragma unroll
                    for (int mp = 0; mp < 2; ++mp) {
                        float& mref = mp ? m2 : m1; float& lref = mp ? l2 : l1;
                        if (doit[mp]) {
                            if (__any(mx[mp] - mref > 8.0f)) { const float mnew = fmaxf(mref, mx[mp]); const float alpha = fast_exp2(mref - mnew); lref *= alpha;
#pragma unroll
                                for (int d = 0; d < 4; ++d) { if (mp) o2[d] *= alpha; else o1[d] *= alpha; }
                                mref = mnew; }
                            dd[mp] = off - mref;
                        } else dd[mp] = -INFINITY;
                    }
                    bf16x8 pk[2][2];
                    typedef float f32x8 __attribute__((ext_vector_type(8))); typedef float f32x2v __attribute__((ext_vector_type(2)));
#define DA_SOFTMAX(mp_, lref_) do { s[mp_] = s[mp_] + dd[mp_]; \
                        _Pragma("unroll") for (int r = 0; r < 16; ++r) s[mp_][r] = fast_exp2(s[mp_][r]); \
                        { const f32x8 h8 = __builtin_shufflevector(s[mp_], s[mp_], 0, 1, 2, 3, 4, 5, 6, 7) + __builtin_shufflevector(s[mp_], s[mp_], 8, 9, 10, 11, 12, 13, 14, 15); \
                          const f32x4 h4 = __builtin_shufflevector(h8, h8, 0, 1, 2, 3) + __builtin_shufflevector(h8, h8, 4, 5, 6, 7); \
                          const f32x2v h2 = __builtin_shufflevector(h4, h4, 0, 1) + __builtin_shufflevector(h4, h4, 2, 3); lref_ += h2[0] + h2[1]; } \
                        _Pragma("unroll") for (int j = 0; j < 2; ++j) { u32x4 pw; pw.x = cvt_pk_bf16(s[mp_][8 * j + 0], s[mp_][8 * j + 1]); pw.y = cvt_pk_bf16(s[mp_][8 * j + 2], s[mp_][8 * j + 3]); \
                            pw.z = cvt_pk_bf16(s[mp_][8 * j + 4], s[mp_][8 * j + 5]); pw.w = cvt_pk_bf16(s[mp_][8 * j + 6], s[mp_][8 * j + 7]); pk[mp_][j] = __builtin_bit_cast(bf16x8, pw); } } while (0)
                    DA_SOFTMAX(0, l1);
                    asm volatile("s_waitcnt lgkmcnt(0)" : "+v"(va_lo[0]), "+v"(va_lo[1]), "+v"(va_lo[2]), "+v"(va_lo[3]), "+v"(va_hi[0]), "+v"(va_hi[1]), "+v"(va_hi[2]), "+v"(va_hi[3]),
                                 "+v"(vb_lo[0]), "+v"(vb_lo[1]), "+v"(vb_lo[2]), "+v"(vb_lo[3]), "+v"(vb_hi[0]), "+v"(vb_hi[1]), "+v"(vb_hi[2]), "+v"(vb_hi[3]) :: "memory");
                    bf16x8 vf[4][2];
#pragma unroll
                    for (int d = 0; d < 4; ++d)
#pragma unroll
                        for (int j = 0; j < 2; ++j) { const s16x4 lo = (d < 2) ? va_lo[2 * d + j] : vb_lo[2 * (d - 2) + j], hh = (d < 2) ? va_hi[2 * d + j] : vb_hi[2 * (d - 2) + j];
                            vf[d][j] = (bf16x8){lo[0], lo[1], lo[2], lo[3], hh[0], hh[1], hh[2], hh[3]}; }
#pragma unroll
                    for (int d = 0; d < 4; ++d)
#pragma unroll
                        for (int j = 0; j < 2; ++j) o1[d] = __builtin_amdgcn_mfma_f32_32x32x16_bf16(vf[d][j], pk[0][j], o1[d], 0, 0, 0);
                    DA_SOFTMAX(1, l2);
#pragma unroll
                    for (int g = 0; g < 8; ++g) { __builtin_amdgcn_sched_group_barrier(0x8, 1, 0); __builtin_amdgcn_sched_group_barrier(0x2, 6, 0); }
#pragma unroll
                    for (int d = 0; d < 4; ++d)
#pragma unroll
                        for (int j = 0; j < 2; ++j) o2[d] = __builtin_amdgcn_mfma_f32_32x32x16_bf16(vf[d][j], pk[1][j], o2[d], 0, 0, 0);
#undef DA_SOFTMAX
#undef DA_ISSUE_V
                }
                __builtin_amdgcn_sched_barrier(0);
            }
        }
        asm volatile("s_waitcnt vmcnt(0)" ::: "memory");
        bool okw = false;
        if (kt >= 1 && kt - 1 < 4 * qb) { const float bias = -c2 * (float)(tpos - (64 * (kt - 1) + 63));
            okw = __all((qb_[0] + bias - m1 < -160.0f) && (qb_[1] + bias - m2 < -160.0f)); }
        if (__syncthreads_and(okw ? 1 : 0)) break;
    }
#undef DA_ISSUE_KQ
#undef DA_DMA
    bf16_t* orow = Op + (size_t)(qb * 256 + w * 32 + q) * 512;
    l1 += __shfl_xor(l1, 32); l2 += __shfl_xor(l2, 32);
    const float i1 = 1.0f / l1, i2 = lam / l2; float ss = 0.f;
#pragma unroll
    for (int d = 0; d < 4; ++d)
#pragma unroll
        for (int r = 0; r < 16; ++r) { const float v = o1[d][r] * i1 - o2[d][r] * i2; o1[d][r] = v; ss += v * v; }
    ss += __shfl_xor(ss, 32);
    const float rs = (1.0f / sqrtf(ss * (1.0f / 128.0f) + EPS)) * (1.0f - LAMBDA_INIT);
#pragma unroll
    for (int d = 0; d < 4; ++d)
#pragma unroll
        for (int gq = 0; gq < 4; ++gq) { const int dd = 32 * d + 8 * gq + 4 * hi; const f32x4 sl = *(const f32x4*)(subln + dd);
            u32x2 wv; wv.x = cvt_pk_bf16(o1[d][4 * gq] * rs * sl[0], o1[d][4 * gq + 1] * rs * sl[1]); wv.y = cvt_pk_bf16(o1[d][4 * gq + 2] * rs * sl[2], o1[d][4 * gq + 3] * rs * sl[3]);
            *(u32x2*)(orow + dd) = wv; }
}

__device__ __forceinline__ void sb_unit(LAS unsigned char* lds, const bf16_t* Qp  , const bf16_t* KVp  , bf16_t* Op  , int qb) {
    int tid_ = threadIdx.x; asm volatile("" : "+v"(tid_));
    const int tid = tid_, lane = tid & 63, q = lane & 31, hi = lane >> 5; const int w = __builtin_amdgcn_readfirstlane(tid >> 6);
    const int t0 = qb * 256 + w * 32, tpos = t0 + q;
    const unsigned vbuf = (unsigned)(uintptr_t)lds + (unsigned)w * 16384u;
    bf16x8 qf[4];
#pragma unroll
    for (int d0 = 0; d0 < 4; ++d0) { u32x4 v = *(const u32x4*)(Qp + (size_t)tpos * 64 + 16 * d0 + 8 * hi);
        v.x = cvt_pk_bf16(bf_lo(v.x) * 0.125f, bf_hi(v.x) * 0.125f); v.y = cvt_pk_bf16(bf_lo(v.y) * 0.125f, bf_hi(v.y) * 0.125f);
        v.z = cvt_pk_bf16(bf_lo(v.z) * 0.125f, bf_hi(v.z) * 0.125f); v.w = cvt_pk_bf16(bf_lo(v.w) * 0.125f, bf_hi(v.w) * 0.125f);
        qf[d0] = __builtin_bit_cast(bf16x8, v); }
    const unsigned voffV = (unsigned)((lane >> 3) * 256 + 16 * ((lane & 7) ^ (lane >> 3)));
    const unsigned voffK = (unsigned)(q * 256 + 16 * hi);
    const char* const Pb = (const char*)KVp;
#define SB_DMA_V(kt, buf) do { const char* tb_ = Pb + (size_t)(kt) * (64 * 256) + 128; \
        _Pragma("unroll") for (int I_ = 0; I_ < 8; ++I_) glds_s(tb_ + 2048 * I_, voffV, vbuf + (unsigned)((buf) * 8192 + 1024 * I_)); } while (0)
#define SB_LOAD_K(dst, kt) do { const char* tb_ = Pb + (size_t)(kt) * (64 * 256); \
        _Pragma("unroll") for (int kh_ = 0; kh_ < 2; ++kh_) _Pragma("unroll") for (int d0_ = 0; d0_ < 4; ++d0_) dst[kh_ * 4 + d0_] = *(const u32x4*)(tb_ + voffK + 8192 * kh_ + 32 * d0_); } while (0)
    const int kt_first = t0 >> 6;
    int kt = kt_first, buf = 0;
    u32x4 kf[8], kfn[8];
    SB_LOAD_K(kf, kt); SB_DMA_V(kt, 0);
#pragma unroll
    for (int i = 0; i < 8; ++i) kfn[i] = kf[i];
    f32x16 o[2]; o[0] = (f32x16){}; o[1] = (f32x16){};
    float carry = 0.f;
    const int qq = (lane & 15) >> 2, g1 = (lane >> 4) & 1, pp = lane & 3;
    const unsigned vb = (unsigned)(128 * (4 * hi + qq) + 16 * ((2 * g1 + (pp >> 1)) ^ qq) + 8 * (pp & 1));
    const unsigned vb0 = vb + 64u * (unsigned)hi, vb1 = vb + 64u - 64u * (unsigned)hi;
    for (;;) {
        asm volatile("s_waitcnt vmcnt(0)" ::: "memory");
        if (kt > 0) { SB_LOAD_K(kfn, kt - 1); SB_DMA_V(kt - 1, buf ^ 1); }
        const unsigned vcur = vbuf + (unsigned)(buf * 8192);
#pragma unroll
        for (int kh = 1; kh >= 0; --kh) {
            if (kh == 1 && kt == kt_first && !(t0 & 32)) continue;
            f32x16 s = (f32x16){};
#pragma unroll
            for (int d0 = 0; d0 < 4; ++d0) s = __builtin_amdgcn_mfma_f32_32x32x16_bf16(__builtin_bit_cast(bf16x8, kf[kh * 4 + d0]), qf[d0], s, 0, 0, 0);
            s16x4 vlo[4], vhi[4];
#pragma unroll
            for (int d = 0; d < 2; ++d) { const unsigned a_ = vcur + (d ? vb1 : vb0);
#pragma unroll
                for (int j = 0; j < 2; ++j) { DS_RDTR(vlo[2 * d + j], a_, 4096 * kh + 2048 * j); DS_RDTR(vhi[2 * d + j], a_, 4096 * kh + 2048 * j + 1024); } }
            float sp[16];
#pragma unroll
            for (int r = 0; r < 16; ++r) { const float z = s[r]; const bool valid = (kt * 64 + 32 * kh + crow(r, hi)) < tpos;
                const float a = fabsf(z); const float e = fast_exp2(-a * LOG2E); const float spv = fmaxf(z, 0.f) + fast_log2(1.0f + e) * LN2; sp[r] = valid ? spv : 0.f; }
            float G[4], Gp[4];
#pragma unroll
            for (int i = 0; i < 4; ++i) { G[i] = (sp[4 * i] + sp[4 * i + 1]) + (sp[4 * i + 2] + sp[4 * i + 3]); Gp[i] = __shfl_xor(G[i], 32); }
            float after = 0.f;
#pragma unroll
            for (int i = 3; i >= 0; --i) { float run = carry + after + (hi == 0 ? Gp[i] : 0.f);
#pragma unroll
                for (int j = 3; j >= 0; --j) { const int r = 4 * i + j; run += sp[r]; const bool valid = (kt * 64 + 32 * kh + crow(r, hi)) < tpos;
                    const float wv = fast_exp2((s[r] - run) * LOG2E); s[r] = valid ? wv : 0.f; }
                after += G[i] + Gp[i]; }
            carry += after;
            bf16x8 pk[2];
#pragma unroll
            for (int j = 0; j < 2; ++j) { u32x4 pw; pw.x = cvt_pk_bf16(s[8 * j + 0], s[8 * j + 1]); pw.y = cvt_pk_bf16(s[8 * j + 2], s[8 * j + 3]);
                pw.z = cvt_pk_bf16(s[8 * j + 4], s[8 * j + 5]); pw.w = cvt_pk_bf16(s[8 * j + 6], s[8 * j + 7]);
                pk[j] = __builtin_bit_cast(bf16x8, pw); }
            asm volatile("s_waitcnt lgkmcnt(0)" : "+v"(vlo[0]), "+v"(vlo[1]), "+v"(vlo[2]), "+v"(vlo[3]), "+v"(vhi[0]), "+v"(vhi[1]), "+v"(vhi[2]), "+v"(vhi[3]) :: "memory");
#pragma unroll
            for (int d = 0; d < 2; ++d)
#pragma unroll
                for (int j = 0; j < 2; ++j) { const s16x4 lo = vlo[2 * d + j], hh = vhi[2 * d + j];
                    const bf16x8 vf = (bf16x8){lo[0], lo[1], lo[2], lo[3], hh[0], hh[1], hh[2], hh[3]};
                    o[d] = __builtin_amdgcn_mfma_f32_32x32x16_bf16(vf, pk[j], o[d], 0, 0, 0); }
        }
        if (kt == 0 || __all(carry > 110.0f)) break;
#pragma unroll
        for (int i = 0; i < 8; ++i) kf[i] = kfn[i];
        --kt; buf ^= 1;
    }
    asm volatile("s_waitcnt vmcnt(0)" ::: "memory");
#undef SB_DMA_V
#undef SB_LOAD_K
    bf16_t* orow = Op + (size_t)tpos * 512;
#pragma unroll
    for (int d = 0; d < 2; ++d)
#pragma unroll
        for (int gq = 0; gq < 4; ++gq) { const int dd = 32 * d + 8 * gq + 4 * hi;
            u32x2 wv; wv.x = cvt_pk_bf16(o[d][4 * gq], o[d][4 * gq + 1]); wv.y = cvt_pk_bf16(o[d][4 * gq + 2], o[d][4 * gq + 3]);
            *(u32x2*)(orow + dd) = wv; }
}
}

constexpr int NWAVES = 8, NTHREADS = 512;
constexpr int LDS_BYTES = 143360;
static_assert(att::DA_TOTAL <= LDS_BYTES - 64 && pg8::STAGE_BYTES <= LDS_BYTES - 64, "LDS map");

__device__ __forceinline__ void p0_transpose_item(const float* W, int K, int N, bf16_t* WT, int il  , LAS float* scr, int item, int lane) {
    const int nblk = N / 32, kb = item / nblk, nb = item % nblk, k0 = 64 * kb, n0 = 32 * nb;
    f32x4 v[8];
#pragma unroll
    for (int i = 0; i < 8; ++i) v[i] = *(const f32x4*)(W + (size_t)(k0 + 8 * i + (lane >> 3)) * N + n0 + 4 * (lane & 7));
#pragma unroll
    for (int i = 0; i < 8; ++i) { LAS float* d = scr + (8 * i + (lane >> 3)) * 33 + 4 * (lane & 7); d[0] = v[i][0]; d[1] = v[i][1]; d[2] = v[i][2]; d[3] = v[i][3]; }
    asm volatile("s_waitcnt lgkmcnt(0)" ::: "memory");
    const int c = lane & 7;
    const int rbase = il ? (256 * (n0 / 128) + 128 * (il - 1) + (n0 % 128)) : n0;
#pragma unroll
    for (int j = 0; j < 4; ++j) { const int n = (lane >> 3) + 8 * j; const LAS float* s = scr + (8 * c) * 33 + n;
        u32x4 o; o.x = cvt_pk_bf16(s[0 * 33], s[1 * 33]); o.y = cvt_pk_bf16(s[2 * 33], s[3 * 33]); o.z = cvt_pk_bf16(s[4 * 33], s[5 * 33]); o.w = cvt_pk_bf16(s[6 * 33], s[7 * 33]);
        *(u32x4*)(WT + (size_t)(rbase + n) * K + k0 + 8 * c) = o; }
    asm volatile("s_waitcnt lgkmcnt(0)" ::: "memory");
}

#ifndef PROBE_MASK
#define PROBE_MASK 0
#endif
#define TSTART() unsigned long long t0_ = (PROBE_MASK != 0) ? __builtin_amdgcn_s_memrealtime() : 0ull
#define TEND(k) do { if (PROBE_MASK & (1 << (k))) { const unsigned long long t1_ = __builtin_amdgcn_s_memrealtime(); const unsigned long long dt_ = t1_ - t0_; while (__builtin_amdgcn_s_memrealtime() - t1_ < dt_) __builtin_amdgcn_s_sleep(8); } if (PROBE_MASK != 0) t0_ = __builtin_amdgcn_s_memrealtime(); } while (0)
struct Args { const float* in[21]; float* out; float* modp; float* SS; bf16_t* Wgu[2]; bf16_t* Wd[2]; bf16_t* Win; bf16_t* Wsb; bf16_t* Wda; bf16_t* Wout; bf16_t* U; bf16_t* Y; bf16_t* BIG; bf16_t* Qsb; bf16_t* KVsb; bf16_t* Qda; bf16_t* KVda; bf16_t* Gt; bf16_t* ya; bf16_t* yd; unsigned* ctr; unsigned* kmax2; unsigned* bar; bf16_t* Mg; bf16_t* Y2; bf16_t* Y3; };

template <bool HAS_Y, bool HAS_NEXT, bool HIN_BF16, bool HOUT_BF16>
__device__ __forceinline__ void rowwise_phase(LAS unsigned char* lds, int vcu, int G, const void* hin_, void* hout_, const bf16_t* Y, const float* SS,
                                              const float* modp, const float* npost, const float* npre, int isub, float rw, bf16_t* U) {
    int tid_ = threadIdx.x; asm volatile("" : "+v"(tid_));
    const int tid = tid_, lane = tid & 63, wave = __builtin_amdgcn_readfirstlane(tid >> 6);
    LAS float* vA = (LAS float*)lds; LAS float* vB = vA + 1024; LAS float* vC = vB + 1024;
    for (int rb = vcu; rb < MT / 256; rb += G) {
        const int b = rb >> 5;
        for (int n = tid; n < DM; n += NTHREADS) {
            if (HAS_Y) { float gsum = 0.f;
#pragma unroll
                for (int kc = 0; kc < 16; ++kc) gsum += modp[(size_t)(kc * 8 + b) * NMOD + (isub * 3 + 2) * DM + n];
                vA[n] = rw * gsum * npost[isub * DM + n]; }
            if (HAS_NEXT) { const int jn = isub + 1; float sc = 0.f, sh = 0.f;
#pragma unroll
                for (int kc = 0; kc < 16; ++kc) { sh += modp[(size_t)(kc * 8 + b) * NMOD + (jn * 3 + 0) * DM + n]; sc += modp[(size_t)(kc * 8 + b) * NMOD + (jn * 3 + 1) * DM + n]; }
                vB[n] = npre[jn * DM + n] * (1.0f + sc); vC[n] = sh; }
        }
        __syncthreads();
        f32x4 a[4], bb[4], cc[4];
#pragma unroll
        for (int j = 0; j < 4; ++j) { const int c0 = 4 * lane + 256 * j;
            a[j] = HAS_Y ? *(const LAS f32x4*)(vA + c0) : (f32x4){0.f, 0.f, 0.f, 0.f};
            bb[j] = HAS_NEXT ? *(const LAS f32x4*)(vB + c0) : (f32x4){0.f, 0.f, 0.f, 0.f};
            cc[j] = HAS_NEXT ? *(const LAS f32x4*)(vC + c0) : (f32x4){0.f, 0.f, 0.f, 0.f}; }
        for (int rr = 0; rr < 32; rr += 2) {
            f32x4 hv[2][4]; u32x2 yv[2][4]; float rsy[2];
#pragma unroll
            for (int u = 0; u < 2; ++u) { const size_t row = (size_t)rb * 256 + wave * 32 + rr + u;
#pragma unroll
                for (int j = 0; j < 4; ++j) {
                    if (HIN_BF16) { const u32x2 t = *(const u32x2*)((const bf16_t*)hin_ + row * DM + 4 * lane + 256 * j); hv[u][j] = (f32x4){bf_lo(t.x), bf_hi(t.x), bf_lo(t.y), bf_hi(t.y)}; }
                    else hv[u][j] = *(const f32x4*)((const float*)hin_ + row * DM + 4 * lane + 256 * j);
                    if (HAS_Y) yv[u][j] = *(const u32x2*)(Y + row * DM + 4 * lane + 256 * j); }
                if (HAS_Y) { const f32x4 s0 = *(const f32x4*)(SS + row * 16), s1 = *(const f32x4*)(SS + row * 16 + 4), s2 = *(const f32x4*)(SS + row * 16 + 8), s3 = *(const f32x4*)(SS + row * 16 + 12);
                    const float ssum = ((s0[0] + s0[1]) + (s0[2] + s0[3])) + ((s1[0] + s1[1]) + (s1[2] + s1[3])) + ((s2[0] + s2[1]) + (s2[2] + s2[3])) + ((s3[0] + s3[1]) + (s3[2] + s3[3]));
                    rsy[u] = 1.0f / sqrtf(ssum * (1.0f / DM) + EPS); } }
            asm volatile("" ::: "memory");
#pragma unroll
            for (int u = 0; u < 2; ++u) { const size_t row = (size_t)rb * 256 + wave * 32 + rr + u;
                if (HAS_Y) {
#pragma unroll
                    for (int j = 0; j < 4; ++j) { hv[u][j][0] += a[j][0] * (bf_lo(yv[u][j].x) * rsy[u]); hv[u][j][1] += a[j][1] * (bf_hi(yv[u][j].x) * rsy[u]);
                        hv[u][j][2] += a[j][2] * (bf_lo(yv[u][j].y) * rsy[u]); hv[u][j][3] += a[j][3] * (bf_hi(yv[u][j].y) * rsy[u]);
                        if (HOUT_BF16) { u32x2 o; o.x = cvt_pk_bf16(hv[u][j][0], hv[u][j][1]); o.y = cvt_pk_bf16(hv[u][j][2], hv[u][j][3]);
                            *(u32x2*)((bf16_t*)hout_ + row * DM + 4 * lane + 256 * j) = o;
                            hv[u][j] = (f32x4){bf_lo(o.x), bf_hi(o.x), bf_lo(o.y), bf_hi(o.y)}; }
                        else *(f32x4*)((float*)hout_ + row * DM + 4 * lane + 256 * j) = hv[u][j]; }
                }
                if (HAS_NEXT) {
                    float s = 0.f;
#pragma unroll
                    for (int j = 0; j < 4; ++j) s += (hv[u][j][0] * hv[u][j][0] + hv[u][j][1] * hv[u][j][1]) + (hv[u][j][2] * hv[u][j][2] + hv[u][j][3] * hv[u][j][3]);
                    const float rs = 1.0f / sqrtf(wave_sum(s) * (1.0f / DM) + EPS);
#pragma unroll
                    for (int j = 0; j < 4; ++j) { u32x2 o; o.x = cvt_pk_bf16(hv[u][j][0] * rs * bb[j][0] + cc[j][0], hv[u][j][1] * rs * bb[j][1] + cc[j][1]);
                        o.y = cvt_pk_bf16(hv[u][j][2] * rs * bb[j][2] + cc[j][2], hv[u][j][3] * rs * bb[j][3] + cc[j][3]);
                        *(u32x2*)(U + row * DM + 4 * lane + 256 * j) = o; }
                }
            }
        }
        __syncthreads();
    }
}

#define XB_TMO      128
#define XB_XCNT(j)  (256  + 64 * (j))
#define XB_XSUB(j)  (1280 + 64 * (j))
#define XB_XGEN(j)  (2304 + 64 * (j))
#define XB_TOP      3328
#define XB_TOPGEN   3392
#define XCD_BAR_WORDS 3456
#define XB_SPIN_CAP (1u << 18)

__device__ __forceinline__ unsigned xb_ld(unsigned* p)              { return __hip_atomic_load(p, __ATOMIC_RELAXED, __HIP_MEMORY_SCOPE_AGENT); }
__device__ __forceinline__ unsigned xb_add(unsigned* p, unsigned v) { return __hip_atomic_fetch_add(p, v, __ATOMIC_RELAXED, __HIP_MEMORY_SCOPE_AGENT); }
__device__ __forceinline__ unsigned xb_xcc_id() { return (unsigned)__builtin_amdgcn_s_getreg((3 << 11) | 20) & 0xFu; }
#define XB_SPIN(cond, bar) do { unsigned _sp = 0; while (cond) { __builtin_amdgcn_s_sleep(1); \
    if ((++_sp & 255u) == 0u) { if (xb_ld(&(bar)[XB_TMO])) break; if (_sp > XB_SPIN_CAP) { atomicAdd(&(bar)[XB_TMO], 1u); break; } } } } while (0)

struct XcdBarrier {
    unsigned* bar; unsigned x;
    volatile LAS unsigned* st;
};

__device__ __forceinline__ XcdBarrier xcd_barrier_post(unsigned* bar, volatile LAS unsigned* st) {
    XcdBarrier b; b.bar = bar; b.x = xb_xcc_id(); b.st = st;
    if (threadIdx.x == 0) (void)xb_add(&bar[XB_XCNT(b.x)], 1u);
    return b;
}
__device__ __forceinline__ void xcd_barrier_complete(unsigned* bar, unsigned x, unsigned& nloc, unsigned& nx) {
    const unsigned G = gridDim.x * gridDim.y * gridDim.z;
    unsigned sum, cnt, mine, sp = 0u;
    for (;;) {
        sum = 0u; cnt = 0u; mine = 0u;
#pragma unroll
        for (unsigned j = 0; j < 16; ++j) { const unsigned c = xb_ld(&bar[XB_XCNT(j)]); sum += c; cnt += (c > 0u) ? 1u : 0u; mine = (j == x) ? c : mine; }
        if (sum == G) break;
        __builtin_amdgcn_s_sleep(1);
        if ((++sp & 255u) == 0u) { if (xb_ld(&bar[XB_TMO])) break; if (sp > XB_SPIN_CAP) { atomicAdd(&bar[XB_TMO], 1u); break; } }
    }
    nloc = mine > 0u ? mine : 1u; nx = cnt > 0u ? cnt : 1u;
}

__device__ __forceinline__ void xcd_barrier(const XcdBarrier& b) {
    asm volatile("s_waitcnt vmcnt(0)" ::: "memory");
    __syncthreads();
    if (threadIdx.x == 0) {
        unsigned* bar = b.bar;
        __builtin_amdgcn_s_waitcnt(0);
        unsigned nloc = b.st[0], nx = b.st[1];
        if (nloc == 0u) { xcd_barrier_complete(bar, b.x, nloc, nx); b.st[0] = nloc; b.st[1] = nx; }
        const unsigned old = xb_add(&bar[XB_XSUB(b.x)], 1u);
        const unsigned gen = old / nloc;
        if (old + 1u == (gen + 1u) * nloc) {
            __builtin_amdgcn_fence(__ATOMIC_RELEASE, "agent");
            asm volatile("s_waitcnt vmcnt(0)" ::: "memory");
            const unsigned og = xb_add(&bar[XB_TOP], 1u);
            const unsigned tg = og / nx;
            if (og + 1u == (tg + 1u) * nx) xb_add(&bar[XB_TOPGEN], 1u);
            else XB_SPIN(xb_ld(&bar[XB_TOPGEN]) == tg, bar);
            __builtin_amdgcn_fence(__ATOMIC_ACQUIRE, "agent");
            xb_add(&bar[XB_XGEN(b.x)], 1u);
            asm volatile("s_waitcnt vmcnt(0)" ::: "memory");
        } else {
            XB_SPIN(xb_ld(&bar[XB_XGEN(b.x)]) == gen, bar);
            __builtin_amdgcn_fence(__ATOMIC_ACQUIRE, "agent");
            asm volatile("s_waitcnt vmcnt(0)" ::: "memory");
        }
    }
    __syncthreads();
}


__global__ void __launch_bounds__(NTHREADS, 2) fwd_megakernel(Args args) {
    extern __shared__ __attribute__((aligned(16))) unsigned char lds_raw[];
    LAS unsigned char* lds = (LAS unsigned char*)lds_raw;
    cg::grid_group grid = cg::this_grid();
    const int tid = threadIdx.x, lane = tid & 63, wave = __builtin_amdgcn_readfirstlane(tid >> 6);
    const int G = gridDim.x, bx = blockIdx.x; const int vcu = (G % 8 == 0) ? (bx % 8) * (G / 8) + bx / 8 : bx;
    TSTART();
    volatile LAS unsigned* xst = (volatile LAS unsigned*)(lds + (LDS_BYTES - 32));
    if (tid < 2) xst[tid] = 0u;
    if (bx == 0) for (int i = tid; i < XCD_BAR_WORDS; i += NTHREADS) __hip_atomic_store(args.bar + i, 0u, __ATOMIC_RELAXED, __HIP_MEMORY_SCOPE_AGENT);
    if (bx == 0 && tid == 0) __hip_atomic_store(args.ctr, 0u, __ATOMIC_RELAXED, __HIP_MEMORY_SCOPE_AGENT);
    if (bx == 0 && tid < 128) __hip_atomic_store(args.kmax2 + tid, 0u, __ATOMIC_RELAXED, __HIP_MEMORY_SCOPE_AGENT);
    {
        LAS float* scr = (LAS float*)(lds + wave * 8448);
        const int gw = vcu * NWAVES + wave, NGW = G * NWAVES;
        constexpr int I_G = (DM / 64) * (DFF / 32), I_D = (DFF / 64) * (DM / 32), I_IN = (DM / 64) * (INW / 32), I_BR = (512 / 64) * (DM / 32), I_O = (DM / 64) * (DM / 32);
        constexpr int NITEMS = 4 * I_G + 2 * I_D + I_IN + 2 * I_BR + I_O;
        for (int it = gw; it < NITEMS; it += NGW) {
            int r = it;
            if (r < I_G) { p0_transpose_item(args.in[6], DM, DFF, args.Wgu[0], 1, scr, r, lane); continue; } r -= I_G;
            if (r < I_G) { p0_transpose_item(args.in[7], DM, DFF, args.Wgu[0], 2, scr, r, lane); continue; } r -= I_G;
            if (r < I_G) { p0_transpose_item(args.in[18], DM, DFF, args.Wgu[1], 1, scr, r, lane); continue; } r -= I_G;
            if (r < I_G) { p0_transpose_item(args.in[19], DM, DFF, args.Wgu[1], 2, scr, r, lane); continue; } r -= I_G;
            if (r < I_D) { p0_transpose_item(args.in[8], DFF, DM, args.Wd[0], 0, scr, r, lane); continue; } r -= I_D;
            if (r < I_D) { p0_transpose_item(args.in[20], DFF, DM, args.Wd[1], 0, scr, r, lane); continue; } r -= I_D;
            if (r < I_IN) { p0_transpose_item(args.in[9], DM, INW, args.Win, 0, scr, r, lane); continue; } r -= I_IN;
            if (r < I_BR) { p0_transpose_item(args.in[15], 512, DM, args.Wsb, 0, scr, r, lane); continue; } r -= I_BR;
            if (r < I_BR) { p0_transpose_item(args.in[16], 512, DM, args.Wda, 0, scr, r, lane); continue; } r -= I_BR;
            p0_transpose_item(args.in[17], DM, DM, args.Wout, 0, scr, r, lane);
        }
        LAS float* sc = (LAS float*)(lds + 69632);
        for (int i = tid; i < NB * DM; i += NTHREADS) { const float cv = args.in[1][i]; sc[i] = cv * sigmoidf_(cv); }
        __syncthreads();
        for (int task = bx * NTHREADS + tid; task < 16 * NMOD; task += G * NTHREADS) {
            const int kc = task / NMOD, n = task % NMOD;
            float acc[8];
#pragma unroll
            for (int b = 0; b < 8; ++b) acc[b] = 0.f;
            for (int k = kc * 64; k < kc * 64 + 64; ++k) { const float wv = args.in[2][(size_t)k * NMOD + n];
#pragma unroll
                for (int b = 0; b < 8; ++b) acc[b] += sc[b * DM + k] * wv; }
            if (kc == 0) { const float bv = args.in[3][n];
#pragma unroll
                for (int b = 0; b < 8; ++b) acc[b] += bv; }
#pragma unroll
            for (int b = 0; b < 8; ++b) args.modp[(size_t)(kc * 8 + b) * NMOD + n] = acc[b];
        }
    }
    TEND(0);
    grid.sync();
    (void)xcd_barrier_post(args.bar, xst);
#define GSYNC() do { XcdBarrier b_; b_.bar = args.bar; b_.x = xb_xcc_id(); b_.st = (volatile LAS unsigned*)(lds + (LDS_BYTES - 32)); xcd_barrier(b_); } while (0)

    TEND(10);
    rowwise_phase<false, true, false, false>(lds, vcu, G, args.in[0], nullptr, nullptr, nullptr, args.modp, args.in[5], args.in[4], -1, 0.f, args.U);
    TEND(1);
    GSYNC();
    TEND(10);

    for (int f = 0; f < 2; ++f) {
        { pg8::Gemm g{args.U, args.Wgu[f], MT, NGU, DM, DM}; pg8::StaticOrder S; S.init(MT, NGU, G, bx); pg8::EpiSwiGLU E{args.BIG}; pg8::gemm_phase(lds, g, S, E); }
        TEND(2);
        GSYNC();
        TEND(10);
        { pg8::Gemm g{args.BIG, args.Wd[f], MT, DM, DFF, DFF}; pg8::StaticOrder S; S.init(MT, DM, G, bx); pg8::EpiY E{f ? args.Y3 : args.Y, args.SS}; pg8::gemm_phase(lds, g, S, E); }
        TEND(3);
        GSYNC();
        TEND(10);
        if (f == 0) {
            rowwise_phase<true, true, false, true>(lds, vcu, G, args.in[0], args.Y, args.Y, args.SS, args.modp, args.in[5], args.in[4], 0, 0.5f, args.U);
            TEND(1);
            GSYNC();
            TEND(10);
            { pg8::Gemm g{args.U, args.Win, MT, INW, DM, DM}; pg8::StaticOrder S; S.init(MT, INW, G, bx); pg8::EpiProj E{args.Qsb, args.KVsb, args.Qda, args.KVda, args.Gt, args.kmax2}; pg8::gemm_phase(lds, g, S, E); }
            TEND(4);
            GSYNC();
            TEND(10);
            {
                float d1 = 0.f, d2 = 0.f;
                for (int i = 0; i < 64; ++i) { d1 += args.in[10][i] * args.in[11][i]; d2 += args.in[12][i] * args.in[13][i]; }
                const float lam = expf(d1) - expf(d2) + LAMBDA_INIT;
                LAS unsigned* slot = (LAS unsigned*)(lds + (LDS_BYTES - 16));
                for (;;) {
                    if (tid == 0) *slot = __hip_atomic_fetch_add(args.ctr, 1u, __ATOMIC_RELAXED, __HIP_MEMORY_SCOPE_AGENT);
                    __syncthreads();
                    const unsigned u = *slot;
                    __syncthreads();
                    if (u >= 3072u) break;
                    if (u < 1024u) { const int hh = 3 - (int)(u >> 8), rem = (int)(u & 255u), qb = 31 - (rem >> 3), bh = (rem & 7) * 4 + hh;
                        const float slope = exp2f(-2.0f * (float)(hh + 1));
                        att::da_unit(lds, args.Qda + (size_t)bh * SEQ * 128, args.KVda + (size_t)bh * SEQ * 256, args.yd + (size_t)(bh >> 2) * SEQ * 512 + 128 * hh, qb, lam, args.in[14], slope, args.kmax2 + bh * 4);
                    } else { const int v = (int)u - 1024, bh = v >> 5, qb = 31 - (v & 31);
                        att::sb_unit(lds, args.Qsb + (size_t)bh * SEQ * 64, args.KVsb + (size_t)bh * SEQ * 128, args.ya + (size_t)(bh >> 3) * SEQ * 512 + 64 * (bh & 7), qb); }
                }
            }
            TEND(5);
            GSYNC();
            TEND(10);
            { pg8::Gemm g{args.ya, args.Wsb, MT, DM, 512, 512}; pg8::StaticOrder S; S.init(MT, DM, G, bx); pg8::EpiGate<true> E{args.Mg, args.Gt, args.Y2}; pg8::gemm_phase(lds, g, S, E); }
            __syncthreads();
            { pg8::Gemm g{args.yd, args.Wda, MT, DM, 512, 512}; pg8::StaticOrder S; S.init(MT, DM, G, bx); pg8::EpiGate<false> E{args.Mg, args.Gt + (size_t)MT * 1024, args.Y2}; pg8::gemm_phase(lds, g, S, E); }
            TEND(6);
            GSYNC();
            TEND(10);
            { pg8::Gemm g{args.Mg, args.Wout, MT, DM, DM, DM}; pg8::StaticOrder S; S.init(MT, DM, G, bx); pg8::EpiY E{args.Y2, args.SS}; pg8::gemm_phase(lds, g, S, E); }
            TEND(7);
            GSYNC();
            TEND(10);
            rowwise_phase<true, true, true, true>(lds, vcu, G, args.Y, args.Y, args.Y2, args.SS, args.modp, args.in[5], args.in[4], 1, 1.0f, args.U);
            TEND(1);
            GSYNC();
            TEND(10);
        } else {
            rowwise_phase<true, false, true, false>(lds, vcu, G, args.Y, args.out, args.Y3, args.SS, args.modp, args.in[5], args.in[4], 2, 0.5f, nullptr);
            TEND(1);
        }
    }
}

extern "C" void kernel_launch(void* const* d_in, const int* in_sizes, int n_in, void* d_out, int out_size, void* d_ws, size_t ws_size, hipStream_t stream) {
    static int grid = 0;
    if (grid == 0) {
        if (n_in != 21 || in_sizes[0] != MT * DM || out_size != MT * DM || ws_size < WS_END) {
            fprintf(stderr, "kernel_launch: unexpected shapes (n_in %d in0 %d out %d ws %zu); nothing launched\n", n_in, n_in > 0 ? in_sizes[0] : -1, out_size, ws_size); grid = -1; return; }
        int dev = 0, cus = 0, per_cu = 0;
        hipGetDevice(&dev);
        hipDeviceGetAttribute(&cus, hipDeviceAttributeMultiprocessorCount, dev);
        if (hipFuncSetAttribute((const void*)fwd_megakernel, hipFuncAttributeMaxDynamicSharedMemorySize, LDS_BYTES) != hipSuccess) fprintf(stderr, "kernel_launch: hipFuncSetAttribute failed\n");
        if (hipOccupancyMaxActiveBlocksPerMultiprocessor(&per_cu, (const void*)fwd_megakernel, NTHREADS, LDS_BYTES) != hipSuccess || per_cu < 1) { fprintf(stderr, "kernel_launch: occupancy query gave %d\n", per_cu); per_cu = 1; }
        (void)hipGetLastError();
        grid = cus * 1;
        if (grid <= 0) grid = 256;
    }
    if (grid < 0) return;
    Args a{};
    for (int i = 0; i < 21; ++i) a.in[i] = (const float*)d_in[i];
    unsigned char* ws = (unsigned char*)d_ws;
    a.out = (float*)d_out; a.modp = (float*)(ws + WS_MODP); a.SS = (float*)(ws + WS_SS);
    a.Wgu[0] = (bf16_t*)(ws + WS_WGU1); a.Wgu[1] = (bf16_t*)(ws + WS_WGU2); a.Wd[0] = (bf16_t*)(ws + WS_WD1); a.Wd[1] = (bf16_t*)(ws + WS_WD2);
    a.Win = (bf16_t*)(ws + WS_WIN); a.Wsb = (bf16_t*)(ws + WS_WSB); a.Wda = (bf16_t*)(ws + WS_WDA); a.Wout = (bf16_t*)(ws + WS_WOUT);
    a.U = (bf16_t*)(ws + WS_U); a.Y = (bf16_t*)(ws + WS_Y); a.BIG = (bf16_t*)(ws + WS_BIG);
    a.Qsb = (bf16_t*)(ws + WS_BIG); a.KVsb = (bf16_t*)(ws + WS_BIG + 64 * MiB); a.Qda = (bf16_t*)(ws + WS_BIG + 192 * MiB); a.KVda = (bf16_t*)(ws + WS_BIG + 256 * MiB); a.Gt = (bf16_t*)(ws + WS_BIG + 384 * MiB);
    a.ctr = (unsigned*)ws; a.kmax2 = (unsigned*)(ws + 4096); a.bar = (unsigned*)(ws + 16384);
    a.ya = (bf16_t*)(ws + WS_U); a.yd = (bf16_t*)(ws + WS_U + 64 * MiB);
    a.Mg = (bf16_t*)(ws + WS_BIG + 256 * MiB); a.Y2 = (bf16_t*)(ws + WS_BIG + 64 * MiB); a.Y3 = (bf16_t*)(ws + WS_BIG + 384 * MiB);
    void* kargs[] = {&a};
    hipError_t e = hipLaunchCooperativeKernel((const void*)fwd_megakernel, dim3(grid), dim3(NTHREADS), kargs, LDS_BYTES, stream);
    if (e != hipSuccess) fprintf(stderr, "cooperative launch failed: %s (grid %d)\n", hipGetErrorString(e), grid);
}
```

```cpp
#include <hip/hip_runtime.h>
#include <hip/hip_cooperative_groups.h>
#include <cstdio>
#include <cstdint>
namespace cg = cooperative_groups;

#define LAS __attribute__((address_space(3)))
typedef unsigned short bf16_t;
typedef short bf16x8 __attribute__((ext_vector_type(8)));
typedef short s16x4 __attribute__((ext_vector_type(4)));
typedef float f32x4 __attribute__((ext_vector_type(4)));
typedef float f32x16 __attribute__((ext_vector_type(16)));
typedef unsigned u32x4 __attribute__((ext_vector_type(4)));
typedef unsigned u32x2 __attribute__((ext_vector_type(2)));

constexpr int DM = 1024, NB = 8, SEQ = 8192, MT = NB * SEQ, DFF = 2816, NGU = 2 * DFF, INW = 5120, NMOD = 9216;
constexpr float EPS = 1e-6f, LOG2E = 1.4426950408889634f, LN2 = 0.6931471805599453f;
constexpr float LAMBDA_INIT = 0.2f;

constexpr size_t MiB = 1u << 20;
constexpr size_t WS_MODP = 1 * MiB;
constexpr size_t WS_SS = 6 * MiB;
constexpr size_t WS_WGU1 = 10 * MiB, WS_WD1 = 21 * MiB, WS_WIN = 27 * MiB, WS_WSB = 37 * MiB, WS_WDA = 38 * MiB, WS_WOUT = 39 * MiB, WS_WGU2 = 41 * MiB, WS_WD2 = 52 * MiB;
constexpr size_t WS_U = 64 * MiB;
constexpr size_t WS_Y = 192 * MiB;
constexpr size_t WS_BIG = 320 * MiB;
constexpr size_t WS_END = 960 * MiB;

typedef float f32x2_t __attribute__((ext_vector_type(2))); typedef __bf16 bf16x2_t __attribute__((ext_vector_type(2)));
__device__ __forceinline__ unsigned cvt_pk_bf16(float lo, float hi) { const f32x2_t v = {lo, hi}; const bf16x2_t b = __builtin_convertvector(v, bf16x2_t); return __builtin_bit_cast(unsigned, b); }
__device__ __forceinline__ float bf_lo(unsigned u) { return __uint_as_float(u << 16); }
__device__ __forceinline__ float bf_hi(unsigned u) { return __uint_as_float(u & 0xffff0000u); }
__device__ __forceinline__ float fast_exp2(float x) { return __builtin_amdgcn_exp2f(x); }
__device__ __forceinline__ float fast_log2(float x) { return __builtin_amdgcn_logf(x); }
__device__ __forceinline__ float fast_rcp(float x) { return __builtin_amdgcn_rcpf(x); }
__device__ __forceinline__ float sigmoidf_(float x) { return fast_rcp(1.0f + fast_exp2(-x * LOG2E)); }
__device__ __forceinline__ float wave_sum(float v) {
#pragma unroll
    for (int o = 1; o < 64; o <<= 1) v += __shfl_xor(v, o);
    return v;
}

__device__ __forceinline__ void glds_s(const void* sbase, unsigned voff, unsigned lds_dst) {
    unsigned keep;
    asm volatile("s_mov_b32 %0, m0\n\ts_mov_b32 m0, %3\n\ts_nop 0\n\tglobal_load_lds_dwordx4 %1, %2\n\ts_mov_b32 m0, %0" : "=&s"(keep) : "v"(voff), "s"(sbase), "s"(lds_dst) : "memory");
}

namespace pg8 {
constexpr int BM = 256, BK = 64, HALF = 128, HTB = HALF * BK * 2, STAGE_BYTES = 8 * HTB, NXCD = 8, WGM = 8;
__host__ __device__ __forceinline__ int lds_byte(int r, int c) { const int st = (r >> 4) * 2 + (c >> 5), rr = r & 15, cc = c & 31, ob = rr * 64 + cc * 2; return st * 1024 + (ob ^ (((ob >> 9) & 1) << 5)); }
__host__ __device__ __forceinline__ void stage_rc(int b, int& R, int& C) { const int st = b / 1024, sb = b % 1024, swz = sb ^ (((sb >> 9) & 1) << 5); R = (st >> 1) * 16 + swz / 64; C = (st & 1) * 32 + (swz % 64) / 2; }
__host__ __device__ __forceinline__ int perm32(int rho) { const int n = rho >> 4, i = rho & 15; return 8 * (i >> 2) + 4 * n + (i & 3); }

struct Unit { int pm, pn; };
__device__ __forceinline__ size_t native_off(int pm, int pn, int ai, int m, int bj, int wr, int wc, int fr, int fq) {
    return ((((((size_t)pm * 4 + pn) * 2 + ai) * 4 + m) * 2 + bj) * 512 + (size_t)((wr * 4 + wc) * 64 + fq * 16 + fr)) * 8; }
struct Gemm { const bf16_t* A; const bf16_t* Bt; int M, N, K, lda; };

struct StaticOrder {
    int nM, nN, nwg, G, c;
    __device__ void init(int M, int N, int G_, int c_) { nM = M / BM; nN = N / BM; nwg = nM * nN; G = G_; c = c_; }
    __device__ bool next(int i, Unit& u) const {
        const long L = (long)i * G + c; if (L >= nwg) return false;
        int wgid = (int)L; { const int q = nwg / NXCD, r = nwg % NXCD, xcd = wgid % NXCD, off = wgid / NXCD; wgid = (xcd < r ? xcd * (q + 1) : r * (q + 1) + (xcd - r) * q) + off; }
        const int nig = WGM * nN, gid = wgid / nig, fm = gid * WGM, gsz = (nM - fm) < WGM ? (nM - fm) : WGM;
        u.pm = fm + ((wgid % nig) % gsz); u.pn = (wgid % nig) / gsz; return true;
    }
};

template <class Epi>
__device__ __forceinline__ void gemm_phase(LAS unsigned char* lds, const Gemm g, const StaticOrder& S, const Epi& E) {
    int tid_ = threadIdx.x; asm volatile("" : "+v"(tid_));
    const int tid = tid_, wid = __builtin_amdgcn_readfirstlane(tid >> 6), lane = tid & 63, wr = wid >> 2, wc = wid & 3, fr = lane & 15, fq = lane >> 4;
    const int K = g.K, nt = K / BK, lda = g.lda;
    unsigned voffA[2], voffB[2];
#pragma unroll
    for (int i = 0; i < 2; ++i) { int R, C; stage_rc(tid * 16 + i * 8192, R, C); const int Rb = (R & ~31) + perm32(R & 31);
        voffA[i] = (unsigned)(R * lda + C) * 2u; (void)Rb; voffB[i] = (unsigned)(tid * 16 + i * 8192); }
    const size_t kstep = (size_t)(BK * 2);
    const size_t hstepA = (size_t)HALF * lda * 2, hstepB = (size_t)HTB, kstepB = (size_t)(2 * HTB);
    const size_t tstepA = 2 * hstepA, tstepB = (size_t)nt * kstepB;
    const unsigned ldsbase = (unsigned)(uintptr_t)lds + (unsigned)wid * 1024u;
    const int aoff = lds_byte(wr * 64 + fr, fq * 8), boff = lds_byte(wc * 32 + fr, fq * 8);
#define PG8_SA(b, h) (((b) * 2 + (h)) * HTB)
#define PG8_SB(b, h) ((4 + (b) * 2 + (h)) * HTB)
#define PG8_STAGE(bufoff, gbase, voff) do { _Pragma("unroll") for (int _i = 0; _i < 2; ++_i) \
        glds_s((const void*)(gbase), (voff)[_i], ldsbase + (unsigned)((bufoff) + _i * 8192)); } while (0)
#define PG8_LDA(dst, b, h) do { _Pragma("unroll") for (int m = 0; m < 4; ++m) _Pragma("unroll") for (int k = 0; k < 2; ++k) dst[m][k] = *(const LAS bf16x8*)(lds + PG8_SA(b, h) + aoff + m * 2048 + k * 1024); } while (0)
#define PG8_LDB(dst, b, h) do { _Pragma("unroll") for (int n = 0; n < 2; ++n) _Pragma("unroll") for (int k = 0; k < 2; ++k) dst[n][k] = *(const LAS bf16x8*)(lds + PG8_SB(b, h) + boff + n * 2048 + k * 1024); } while (0)
#define PG8_MMA(ai, bj, At, Bt) do { __builtin_amdgcn_s_setprio(1); _Pragma("unroll") for (int m = 0; m < 4; ++m) _Pragma("unroll") for (int n = 0; n < 2; ++n) _Pragma("unroll") for (int k = 0; k < 2; ++k) \
        acc[ai][bj][m][n] = __builtin_amdgcn_mfma_f32_16x16x32_bf16(Bt[n][k], At[m][k], acc[ai][bj][m][n], 0, 0, 0); __builtin_amdgcn_s_setprio(0); } while (0)
#define PG8_WAIT_V(n) asm volatile("s_waitcnt vmcnt(" #n ")" ::: "memory")
#define PG8_WAIT_L(n) asm volatile("s_waitcnt lgkmcnt(" #n ")" ::: "memory")
#define PG8_BAR __builtin_amdgcn_s_barrier()
#define PG8_SCHED __builtin_amdgcn_sched_barrier(0)
    Unit cur, nxt; int ui = 0;
    if (!S.next(0, cur)) return;
    f32x4 acc[2][2][4][2];
#pragma unroll
    for (int a = 0; a < 2; ++a)
#pragma unroll
        for (int b = 0; b < 2; ++b)
#pragma unroll
            for (int m = 0; m < 4; ++m)
#pragma unroll
                for (int n = 0; n < 2; ++n) acc[a][b][m][n] = (f32x4){0.f, 0.f, 0.f, 0.f};
    bf16x8 At[4][2], B0[2][2], B1[2][2];
    const char* cA = (const char*)g.A + (size_t)cur.pm * tstepA; const char* cB = (const char*)g.Bt + (size_t)cur.pn * tstepB;
    PG8_STAGE(PG8_SB(0, 0), cB, voffB); PG8_STAGE(PG8_SB(0, 1), cB + hstepB, voffB); PG8_STAGE(PG8_SA(0, 0), cA, voffA); PG8_STAGE(PG8_SA(0, 1), cA + hstepA, voffA);
    if (wr == 1) PG8_BAR;
    PG8_WAIT_V(2); PG8_BAR;
    PG8_STAGE(PG8_SB(1, 0), cB + kstepB, voffB); PG8_STAGE(PG8_SA(1, 0), cA + kstep, voffA); PG8_STAGE(PG8_SB(1, 1), cB + hstepB + kstepB, voffB);
    PG8_WAIT_V(6); PG8_BAR;
    for (;;) {
        const bool has_next = S.next(ui + 1, nxt);
        const char* nA = has_next ? (const char*)g.A + (size_t)nxt.pm * tstepA : cA; const char* nB = has_next ? (const char*)g.Bt + (size_t)nxt.pn * tstepB : cB;
        for (int t = 0; t < nt; t += 2) {
            const bool last = (t == nt - 2);
            const char* a1 = cA + (size_t)(t + 1) * kstep;
            const char* a2 = last ? nA : cA + (size_t)(t + 2) * kstep; const char* b2 = last ? nB : cB + (size_t)(t + 2) * kstepB;
            const char* a3 = a2 + kstep; const char* b3 = b2 + kstepB;
            PG8_LDB(B0, 0, 0); PG8_LDB(B1, 0, 1); PG8_SCHED; PG8_LDA(At, 0, 0); PG8_STAGE(PG8_SA(1, 1), a1 + hstepA, voffA);
            PG8_WAIT_V(8); PG8_WAIT_L(0); PG8_BAR; PG8_MMA(0, 0, At, B0); PG8_MMA(0, 1, At, B1); PG8_BAR; PG8_SCHED;
            PG8_LDA(At, 0, 1); PG8_STAGE(PG8_SB(0, 0), b2, voffB); PG8_STAGE(PG8_SB(0, 1), b2 + hstepB, voffB); PG8_STAGE(PG8_SA(0, 0), a2, voffA);
            PG8_WAIT_V(8); PG8_WAIT_L(0); PG8_BAR; PG8_MMA(1, 0, At, B0); PG8_MMA(1, 1, At, B1); PG8_BAR; PG8_SCHED;
            PG8_LDB(B0, 1, 0); PG8_LDB(B1, 1, 1); PG8_SCHED; PG8_LDA(At, 1, 0); PG8_STAGE(PG8_SA(0, 1), a2 + hstepA, voffA);
            PG8_WAIT_V(8); PG8_WAIT_L(0); PG8_BAR; PG8_MMA(0, 0, At, B0); PG8_MMA(0, 1, At, B1); PG8_BAR; PG8_SCHED;
            PG8_LDA(At, 1, 1); PG8_STAGE(PG8_SB(1, 0), b3, voffB); PG8_STAGE(PG8_SB(1, 1), b3 + hstepB, voffB); PG8_STAGE(PG8_SA(1, 0), a3, voffA);
            PG8_WAIT_V(8); PG8_WAIT_L(0); PG8_BAR; PG8_MMA(1, 0, At, B0); PG8_MMA(1, 1, At, B1); PG8_BAR; PG8_SCHED;
        }
        if (wr == 0) PG8_BAR;
        E(acc, cur, wr, wc, fr, fq);
        if (!has_next) break;
#pragma unroll
        for (int a = 0; a < 2; ++a)
#pragma unroll
            for (int b = 0; b < 2; ++b)
#pragma unroll
                for (int m = 0; m < 4; ++m)
#pragma unroll
                    for (int n = 0; n < 2; ++n) acc[a][b][m][n] = (f32x4){0.f, 0.f, 0.f, 0.f};
        cur = nxt; cA = nA; cB = nB; ++ui;
        if (wr == 1) PG8_BAR;
    }
    PG8_WAIT_V(0);
    PG8_BAR;
#undef PG8_SA
#undef PG8_SB
#undef PG8_STAGE
#undef PG8_LDA
#undef PG8_LDB
#undef PG8_MMA
#undef PG8_WAIT_V
#undef PG8_WAIT_L
#undef PG8_BAR
#undef PG8_SCHED
}

struct EpiSwiGLU {
    bf16_t* H;
    __device__ __forceinline__ void operator()(const f32x4 (&acc)[2][2][4][2], const Unit& u, int wr, int wc, int fr, int fq) const {
        const int row0 = u.pm * BM + wr * 64 + fr, col0 = u.pn * HALF + wc * 32 + 8 * fq;
#pragma unroll
        for (int ai = 0; ai < 2; ++ai)
#pragma unroll
            for (int m = 0; m < 4; ++m) {
                float o[8];
#pragma unroll
                for (int n = 0; n < 2; ++n)
#pragma unroll
                    for (int e = 0; e < 4; ++e) { const float gv = acc[ai][0][m][n][e], uv = acc[ai][1][m][n][e]; o[n * 4 + e] = gv * sigmoidf_(gv) * uv; }
                u32x4 w; w.x = cvt_pk_bf16(o[0], o[1]); w.y = cvt_pk_bf16(o[2], o[3]); w.z = cvt_pk_bf16(o[4], o[5]); w.w = cvt_pk_bf16(o[6], o[7]);
                *(u32x4*)(H + (size_t)(row0 + ai * HALF + m * 16) * DFF + col0) = w;
                asm volatile("" ::: "memory");
            }
    }
};
struct EpiProj {
    bf16_t *Qsb, *KVsb, *Qda, *KVda, *Gt; unsigned* kmax2;
    __device__ __forceinline__ void operator()(const f32x4 (&acc)[2][2][4][2], const Unit& u, int wr, int wc, int fr, int fq) const {
        const int row0 = u.pm * BM + wr * 64 + fr; const int cbase = u.pn * BM; const bool sg = (cbase >= 3072); const bool kdt = (cbase == 2048 || cbase == 2304);
        float mxk[2] = {0.f, 0.f};
#pragma unroll
        for (int ai = 0; ai < 2; ++ai)
#pragma unroll
            for (int m = 0; m < 4; ++m) { const int row = row0 + ai * HALF + m * 16; const int b = row >> 13, t = row & (SEQ - 1);
#pragma unroll
                for (int bj = 0; bj < 2; ++bj) { f32x4 v0 = acc[ai][bj][m][0], v1 = acc[ai][bj][m][1];
                    const int c = cbase + bj * HALF + wc * 32 + 8 * fq;
                    bf16_t* dst;
                    if (cbase < 1536) { const int sec = c >> 9, cc = c & 511, h = cc >> 6, wv = cc & 63; const size_t ri = (size_t)(b * 8 + h) * SEQ + t;
                        dst = (sec == 0) ? Qsb + ri * 64 + wv : KVsb + ri * 128 + (sec == 2 ? 64 : 0) + wv; }
                    else if (cbase < 3072) { const int c2 = c - 1536, sec = c2 >> 9, cc = c2 & 511, h = cc >> 7, wv = cc & 127; const size_t ri = (size_t)(b * 4 + h) * SEQ + t;
                        dst = (sec == 0) ? Qda + ri * 128 + wv : KVda + ri * 256 + (sec == 2 ? 128 : 0) + wv; }
                    else { const int gc = cbase - 3072; dst = Gt + (size_t)(gc >> 10) * ((size_t)MT * 1024) + native_off(u.pm, (gc & 1023) >> 8, ai, m, bj, wr, wc, fr, fq); }
                    if (sg) {
#pragma unroll
                        for (int e = 0; e < 4; ++e) { v0[e] = sigmoidf_(v0[e]); v1[e] = sigmoidf_(v1[e]); } }
                    u32x4 w; w.x = cvt_pk_bf16(v0[0], v0[1]); w.y = cvt_pk_bf16(v0[2], v0[3]); w.z = cvt_pk_bf16(v1[0], v1[1]); w.w = cvt_pk_bf16(v1[2], v1[3]);
                    *(u32x4*)dst = w;
                    if (kdt) { float sq = (bf_lo(w.x) * bf_lo(w.x) + bf_hi(w.x) * bf_hi(w.x)) + (bf_lo(w.y) * bf_lo(w.y) + bf_hi(w.y) * bf_hi(w.y)) + (bf_lo(w.z) * bf_lo(w.z) + bf_hi(w.z) * bf_hi(w.z)) + (bf_lo(w.w) * bf_lo(w.w) + bf_hi(w.w) * bf_hi(w.w));
                        sq += __shfl_xor(sq, 16); sq += __shfl_xor(sq, 32); mxk[bj] = fmaxf(mxk[bj], sq); } }
                asm volatile("" ::: "memory"); }
        if (kdt) {
#pragma unroll
            for (int bj = 0; bj < 2; ++bj) { float v = mxk[bj];
#pragma unroll
                for (int o = 1; o < 16; o <<= 1) v = fmaxf(v, __shfl_xor(v, o));
                const int b = (u.pm * BM) >> 13, h = ((cbase - 2048) >> 7) + bj, idx = ((b * 4 + h) * 2 + (wc >> 1)) * 2 + (wc & 1);
                if ((threadIdx.x & 63) == 0) atomicMax(kmax2 + idx, __float_as_uint(v)); }
        }
    }
};
struct EpiY {
    bf16_t* Y; float* SS;
    __device__ __forceinline__ void operator()(const f32x4 (&acc)[2][2][4][2], const Unit& u, int wr, int wc, int fr, int fq) const {
        const int row0 = u.pm * BM + wr * 64 + fr, col0 = u.pn * BM + wc * 32 + 8 * fq;
#pragma unroll
        for (int ai = 0; ai < 2; ++ai)
#pragma unroll
            for (int m = 0; m < 4; ++m) { const int row = row0 + ai * HALF + m * 16; bf16_t* rowp = Y + (size_t)row * DM + col0; float s = 0.f;
#pragma unroll
                for (int bj = 0; bj < 2; ++bj) { const f32x4 v0 = acc[ai][bj][m][0], v1 = acc[ai][bj][m][1];
                    s += (v0[0] * v0[0] + v0[1] * v0[1]) + (v0[2] * v0[2] + v0[3] * v0[3]) + (v1[0] * v1[0] + v1[1] * v1[1]) + (v1[2] * v1[2] + v1[3] * v1[3]);
                    u32x4 w; w.x = cvt_pk_bf16(v0[0], v0[1]); w.y = cvt_pk_bf16(v0[2], v0[3]); w.z = cvt_pk_bf16(v1[0], v1[1]); w.w = cvt_pk_bf16(v1[2], v1[3]);
                    *(u32x4*)(rowp + bj * HALF) = w; }
                s += __shfl_xor(s, 16); s += __shfl_xor(s, 32);
                if (fq == 0) SS[(size_t)row * 16 + u.pn * 4 + wc] = s;
                asm volatile("" ::: "memory"); }
    }
};
template <bool FIRST> struct EpiGate {
    static constexpr bool PANEL = false;
    bf16_t* Mg; const bf16_t* Gt  ; bf16_t* Tn  ;
    __device__ __forceinline__ void operator()(const f32x4 (&acc)[2][2][4][2], const Unit& u, int wr, int wc, int fr, int fq) const {
        const int row0 = u.pm * BM + wr * 64 + fr, col0 = u.pn * BM + wc * 32 + 8 * fq;
#pragma unroll
        for (int ai = 0; ai < 2; ++ai) {
            u32x4 sg[4][2], tt[4][2];
#pragma unroll
            for (int m = 0; m < 4; ++m)
#pragma unroll
                for (int bj = 0; bj < 2; ++bj) { const size_t no = native_off(u.pm, u.pn, ai, m, bj, wr, wc, fr, fq);
                    sg[m][bj] = *(const u32x4*)(Gt + no);
                    if (!FIRST) tt[m][bj] = *(const u32x4*)(Tn + no); }
#pragma unroll
            for (int m = 0; m < 4; ++m)
#pragma unroll
                for (int bj = 0; bj < 2; ++bj) { const size_t row = (size_t)(row0 + ai * HALF + m * 16);
                    const f32x4 v0 = acc[ai][bj][m][0], v1 = acc[ai][bj][m][1]; const u32x4 sgv = sg[m][bj];
                    float o[8];
                    o[0] = bf_lo(sgv.x) * v0[0]; o[1] = bf_hi(sgv.x) * v0[1]; o[2] = bf_lo(sgv.y) * v0[2]; o[3] = bf_hi(sgv.y) * v0[3];
                    o[4] = bf_lo(sgv.z) * v1[0]; o[5] = bf_hi(sgv.z) * v1[1]; o[6] = bf_lo(sgv.w) * v1[2]; o[7] = bf_hi(sgv.w) * v1[3];
                    if (!FIRST) { const u32x4 t = tt[m][bj];
                        o[0] += bf_lo(t.x); o[1] += bf_hi(t.x); o[2] += bf_lo(t.y); o[3] += bf_hi(t.y); o[4] += bf_lo(t.z); o[5] += bf_hi(t.z); o[6] += bf_lo(t.w); o[7] += bf_hi(t.w); }
                    u32x4 w; w.x = cvt_pk_bf16(o[0], o[1]); w.y = cvt_pk_bf16(o[2], o[3]); w.z = cvt_pk_bf16(o[4], o[5]); w.w = cvt_pk_bf16(o[6], o[7]);
                    if (FIRST) *(u32x4*)(Tn + native_off(u.pm, u.pn, ai, m, bj, wr, wc, fr, fq)) = w;
                    else *(u32x4*)(Mg + row * DM + col0 + bj * HALF) = w; }
            asm volatile("" ::: "memory");
        }
    }
};
}

namespace att {
__device__ __forceinline__ int crow(int r, int hi) { return (r & 3) + 8 * (r >> 2) + 4 * hi; }

#define DS_RD128(dst, addr, imm) asm volatile("ds_read_b128 %0, %1 offset:%c2" : "=&v"(dst) : "v"(addr), "i"(imm) : "memory")
#define DS_RDTR(dst, addr, imm) asm volatile("ds_read_b64_tr_b16 %0, %1 offset:%c2" : "=&v"(dst) : "v"(addr), "i"(imm) : "memory")
constexpr int DA_KB = 0, DA_VB = 32768, DA_Q = 65536, DA_QP = 272, DA_QBUF = 32 * DA_QP, DA_TOTAL = DA_Q + 8 * DA_QBUF;
typedef short v4i16_t __attribute__((ext_vector_type(4)));
__device__ __forceinline__ s16x4 vtr(const LAS unsigned char* p) { return __builtin_bit_cast(s16x4, __builtin_amdgcn_ds_read_tr16_b64_v4i16((LAS v4i16_t*)p)); }
__device__ __forceinline__ float max3f(float a, float b, float c) { return fmaxf(fmaxf(a, b), c); }

__device__ __forceinline__ void da_unit(LAS unsigned char* lds, const bf16_t* Qp  , const bf16_t* KVp  , bf16_t* Op  , int qb, float lam, const float* subln, float slope, const unsigned* kmax2  ) {
    int tid_ = threadIdx.x; asm volatile("" : "+v"(tid_));
    const int tid = tid_, lane = tid & 63, q = lane & 31, hi = lane >> 5; const int w = __builtin_amdgcn_readfirstlane(tid >> 6);
    LAS unsigned char* Qw = lds + DA_Q + w * DA_QBUF;
    const unsigned ldsb = (unsigned)(uintptr_t)lds;
    unsigned voff[2];
#pragma unroll
    for (int i = 0; i < 2; ++i) { const int row = 8 * w + 4 * i + (lane >> 4); const int f = ((row & 3) << 2) | ((row >> 2) & 3); voff[i] = (unsigned)(row * 512 + 16 * ((lane & 15) ^ f)); }
    const char* const Pb = (const char*)KVp;
#define DA_DMA(kt, buf) do { const char* tb_ = Pb + (size_t)(kt) * (64 * 512); \
        _Pragma("unroll") for (int i_ = 0; i_ < 2; ++i_) { glds_s(tb_, voff[i_], ldsb + (unsigned)(DA_KB + (buf) * 16384 + (2 * w + i_) * 1024)); \
            glds_s(tb_ + 256, voff[i_], ldsb + (unsigned)(DA_VB + (buf) * 16384 + (2 * w + i_) * 1024)); } } while (0)
    const int nt = 4 * (qb + 1);
    DA_DMA(nt - 1, 0);
    {
        const float c1 = 0.125f * LOG2E;
#pragma unroll
        for (int i = 0; i < 8; ++i) { const int cid = lane + 64 * i, r = cid >> 4, ch = cid & 15;
            u32x4 v = *(const u32x4*)(Qp + (size_t)(qb * 256 + w * 32 + r) * 128 + 8 * ch);
            v.x = cvt_pk_bf16(bf_lo(v.x) * c1, bf_hi(v.x) * c1); v.y = cvt_pk_bf16(bf_lo(v.y) * c1, bf_hi(v.y) * c1);
            v.z = cvt_pk_bf16(bf_lo(v.z) * c1, bf_hi(v.z) * c1); v.w = cvt_pk_bf16(bf_lo(v.w) * c1, bf_hi(v.w) * c1);
            *(LAS u32x4*)(Qw + r * DA_QP + 16 * ch) = v; }
    }
    f32x16 o1[4], o2[4];
#pragma unroll
    for (int d = 0; d < 4; ++d) { o1[d] = (f32x16){}; o2[d] = (f32x16){}; }
    float m1 = -INFINITY, m2 = -INFINITY, l1 = 0.f, l2 = 0.f;
    const int tpos = qb * 256 + w * 32 + q;
    const float c2 = slope * LOG2E;
    const int F16 = 16 * (((q & 3) << 2) | ((q >> 2) & 3));
    const int kq = 256 * q;
    const int qq = (lane & 15) >> 2, g1 = (lane >> 4) & 1, pp = lane & 3;
    const int A0 = 256 * (4 * hi + qq) + 8 * (pp & 1);
    const int vbase0 = A0 + 16 * ((2 * g1 + (pp >> 1)) ^ hi), vbase1 = A0 + 2048 + 16 * ((2 * g1 + (pp >> 1)) ^ (hi + 2));
    asm volatile("s_waitcnt vmcnt(0)" ::: "memory");
    __syncthreads();
    float qb_[2];
#pragma unroll
    for (int mp = 0; mp < 2; ++mp) { float sq = 0.f;
#pragma unroll
        for (int d0 = 0; d0 < 4; ++d0) { const u32x4 f = *(const LAS u32x4*)(Qw + q * DA_QP + (64 * mp + 16 * d0 + 8 * hi) * 2);
            sq += (bf_lo(f.x) * bf_lo(f.x) + bf_hi(f.x) * bf_hi(f.x)) + (bf_lo(f.y) * bf_lo(f.y) + bf_hi(f.y) * bf_hi(f.y)) + (bf_lo(f.z) * bf_lo(f.z) + bf_hi(f.z) * bf_hi(f.z)) + (bf_lo(f.w) * bf_lo(f.w) + bf_hi(f.w) * bf_hi(f.w)); }
        sq += __shfl_xor(sq, 32);
        const float k2 = __uint_as_float(kmax2[2 * mp]) + __uint_as_float(kmax2[2 * mp + 1]);
        qb_[mp] = sqrtf(sq) * sqrtf(k2) * 1.001f + 0.01f; }
    const unsigned FH = (unsigned)(F16 ^ (16 * hi));
    const unsigned qaddr = (unsigned)(uintptr_t)Qw + (unsigned)(q * DA_QP + 16 * hi);
    const unsigned xq = 64u * (unsigned)qq;
#define DA_ISSUE_KQ(mp, kh) do { _Pragma("unroll") for (int d0_ = 0; d0_ < 4; ++d0_) { const unsigned ka_ = kcur + ((unsigned)(128 * (mp) + 32 * d0_) ^ FH); \
        DS_RD128(kf[d0_], ka_, 8192 * (kh)); DS_RD128(qf[d0_], qaddr, 128 * (mp) + 32 * d0_); } } while (0)
    for (int it = 0; it < nt; ++it) {
        const int kt = nt - 1 - it, cur = it & 1;
        if (kt > 0) DA_DMA(kt - 1, cur ^ 1);
        if ((kt - 4 * qb) <= (w >> 1)) {
            const bool band = kt >= 4 * qb;
            const unsigned kcur = ldsb + (unsigned)(DA_KB + cur * 16384 + kq);
            const unsigned vcur = ldsb + (unsigned)(DA_VB + cur * 16384);
#pragma unroll
            for (int kh = 1; kh >= 0; --kh) {
                f32x16 s[2];
#pragma unroll
                for (int mp = 0; mp < 2; ++mp) {
                    bf16x8 kf[4], qf[4];
                    DA_ISSUE_KQ(mp, kh);
                    asm volatile("s_waitcnt lgkmcnt(0)" : "+v"(kf[0]), "+v"(kf[1]), "+v"(kf[2]), "+v"(kf[3]), "+v"(qf[0]), "+v"(qf[1]), "+v"(qf[2]), "+v"(qf[3]) :: "memory");
                    s[mp] = (f32x16){};
#pragma unroll
                    for (int d0 = 0; d0 < 4; ++d0) s[mp] = __builtin_amdgcn_mfma_f32_32x32x16_bf16(kf[d0], qf[d0], s[mp], 0, 0, 0);
                }
                float off, mx[2]; bool doit[2];
                if (band) off = 0.f; else off = c2 * (float)(kt * 64 + 32 * kh + 4 * hi - tpos);
#pragma unroll
                for (int mp = 0; mp < 2; ++mp) {
                    if (band) { const float dbase = (float)(tpos - kt * 64 - 32 * kh - 4 * hi);
#pragma unroll
                        for (int r = 0; r < 16; ++r) s[mp][r] = s[mp][r] - c2 * fabsf(dbase - (float)crow(r, 0));
                    } else {
#pragma unroll
                        for (int r = 0; r < 16; ++r) s[mp][r] = fmaf(c2, (float)crow(r, 0), s[mp][r]);
                    }
                    float m_ = max3f(s[mp][0], s[mp][1], s[mp][2]);
#pragma unroll
                    for (int r = 3; r < 15; r += 2) m_ = max3f(m_, s[mp][r], s[mp][r + 1]);
                    m_ = fmaxf(m_, s[mp][15]) + off;
                    { auto rr = __builtin_amdgcn_permlane32_swap(__float_as_uint(m_), __float_as_uint(m_), false, false); m_ = fmaxf(__uint_as_float(rr[0]), __uint_as_float(rr[1])); }
                    mx[mp] = m_;
                    doit[mp] = !__all(m_ - (mp ? m2 : m1) < -160.0f);
                }
                if (doit[0] || doit[1]) {
                    s16x4 va_lo[4], va_hi[4], vb_lo[4], vb_hi[4];
#define DA_ISSUE_V(lo_, hi_, dbase_) do { _Pragma("unroll") for (int d_ = 0; d_ < 2; ++d_) { const unsigned xd_ = vcur + ((unsigned)(64 * ((dbase_) + d_)) ^ xq); const unsigned a0_ = xd_ + (unsigned)vbase0, a1_ = xd_ + (unsigned)vbase1; \
                        _Pragma("unroll") for (int j_ = 0; j_ < 2; ++j_) { DS_RDTR(lo_[2 * d_ + j_], a0_, 8192 * kh + 4096 * j_); DS_RDTR(hi_[2 * d_ + j_], a1_, 8192 * kh + 4096 * j_); } } } while (0)
                    DA_ISSUE_V(va_lo, va_hi, 0); DA_ISSUE_V(vb_lo, vb_hi, 2);
                    float dd[2];
#pragma unroll
                    for (int mp = 0; mp < 2; ++mp) {
                        float& mref = mp ? m2 : m1; float& lref = mp ? l2 : l1;
                        if (doit[mp]) {
                            if (__any(mx[mp] - mref > 8.0f)) { const float mnew = fmaxf(mref, mx[mp]); const float alpha = fast_exp2(mref - mnew); lref *= alpha;
#pragma unroll
                                for (int d = 0; d < 4; ++d) { if (mp) o2[d] *= alpha; else o1[d] *= alpha; }
                                mref = mnew; }
                            dd[mp] = off - mref;
                        } else dd[mp] = -INFINITY;
                    }
                    bf16x8 pk[2][2];
                    typedef float f32x8 __attribute__((ext_vector_type(8))); typedef float f32x2v __attribute__((ext_vector_type(2)));
#define DA_SOFTMAX(mp_, lref_) do { s[mp_] = s[mp_] + dd[mp_]; \
                        _Pragma("unroll") for (int r = 0; r < 16; ++r) s[mp_][r] = fast_exp2(s[mp_][r]); \
                        { const f32x8 h8 = __builtin_shufflevector(s[mp_], s[mp_], 0, 1, 2, 3, 4, 5, 6, 7) + __builtin_shufflevector(s[mp_], s[mp_], 8, 9, 10, 11, 12, 13, 14, 15); \
                          const f32x4 h4 = __builtin_shufflevector(h8, h8, 0, 1, 2, 3) + __builtin_shufflevector(h8, h8, 4, 5, 6, 7); \
                          const f32x2v h2 = __builtin_shufflevector(h4, h4, 0, 1) + __builtin_shufflevector(h4, h4, 2, 3); lref_ += h2[0] + h2[1]; } \
                        _Pragma("unroll") for (int j = 0; j < 2; ++j) { u32x4 pw; pw.x = cvt_pk_bf16(s[mp_][8 * j + 0], s[mp_][8 * j + 1]); pw.y = cvt_pk_bf16(s[mp_][8 * j + 2], s[mp_][8 * j + 3]); \
                            pw.z = cvt_pk_bf16(s[mp_][8 * j + 4], s[mp_][8 * j + 5]); pw.w = cvt_pk_bf16(s[mp_][8 * j + 6], s[mp_][8 * j + 7]); pk[mp_][j] = __builtin_bit_cast(bf16x8, pw); } } while (0)
                    DA_SOFTMAX(0, l1);
                    asm volatile("s_waitcnt lgkmcnt(0)" : "+v"(va_lo[0]), "+v"(va_lo[1]), "+v"(va_lo[2]), "+v"(va_lo[3]), "+v"(va_hi[0]), "+v"(va_hi[1]), "+v"(va_hi[2]), "+v"(va_hi[3]),
                                 "+v"(vb_lo[0]), "+v"(vb_lo[1]), "+v"(vb_lo[2]), "+v"(vb_lo[3]), "+v"(vb_hi[0]), "+v"(vb_hi[1]), "+v"(vb_hi[2]), "+v"(vb_hi[3]) :: "memory");
                    bf16x8 vf[4][2];
#pragma unroll
                    for (int d = 0; d < 4; ++d)
#pragma unroll
                        for (int j = 0; j < 2; ++j) { const s16x4 lo = (d < 2) ? va_lo[2 * d + j] : vb_lo[2 * (d - 2) + j], hh = (d < 2) ? va_hi[2 * d + j] : vb_hi[2 * (d - 2) + j];
                            vf[d][j] = (bf16x8){lo[0], lo[1], lo[2], lo[3], hh[0], hh[1], hh[2], hh[3]}; }
#pragma unroll
                    for (int d = 0; d < 4; ++d)
#pragma unroll
                        for (int j = 0; j < 2; ++j) o1[d] = __builtin_amdgcn_mfma_f32_32x32x16_bf16(vf[d][j], pk[0][j], o1[d], 0, 0, 0);
                    DA_SOFTMAX(1, l2);
#pragma unroll
                    for (int g = 0; g < 8; ++g) { __builtin_amdgcn_sched_group_barrier(0x8, 1, 0); __builtin_amdgcn_sched_group_barrier(0x2, 6, 0); }
#pragma unroll
                    for (int d = 0; d < 4; ++d)
#pragma unroll
                        for (int j = 0; j < 2; ++j) o2[d] = __builtin_amdgcn_mfma_f32_32x32x16_bf16(vf[d][j], pk[1][j], o2[d], 0, 0, 0);
#undef DA_SOFTMAX
#undef DA_ISSUE_V
                }
                __builtin_amdgcn_sched_barrier(0);
            }
        }
        asm volatile("s_waitcnt vmcnt(0)" ::: "memory");
        bool okw = false;
        if (kt >= 1 && kt - 1 < 4 * qb) { const float bias = -c2 * (float)(tpos - (64 * (kt - 1) + 63));
            okw = __all((qb_[0] + bias - m1 < -160.0f) && (qb_[1] + bias - m2 < -160.0f)); }
        if (__syncthreads_and(okw ? 1 : 0)) break;
    }
#undef DA_ISSUE_KQ
#undef DA_DMA
    bf16_t* orow = Op + (size_t)(qb * 256 + w * 32 + q) * 512;
    l1 += __shfl_xor(l1, 32); l2 += __shfl_xor(l2, 32);
    const float i1 = 1.0f / l1, i2 = lam / l2; float ss = 0.f;
#pragma unroll
    for (int d = 0; d < 4; ++d)
#pragma unroll
        for (int r = 0; r < 16; ++r) { const float v = o1[d][r] * i1 - o2[d][r] * i2; o1[d][r] = v; ss += v * v; }
    ss += __shfl_xor(ss, 32);
    const float rs = (1.0f / sqrtf(ss * (1.0f / 128.0f) + EPS)) * (1.0f - LAMBDA_INIT);
#pragma unroll
    for (int d = 0; d < 4; ++d)
#pragma unroll
        for (int gq = 0; gq < 4; ++gq) { const int dd = 32 * d + 8 * gq + 4 * hi; const f32x4 sl = *(const f32x4*)(subln + dd);
            u32x2 wv; wv.x = cvt_pk_bf16(o1[d][4 * gq] * rs * sl[0], o1[d][4 * gq + 1] * rs * sl[1]); wv.y = cvt_pk_bf16(o1[d][4 * gq + 2] * rs * sl[2], o1[d][4 * gq + 3] * rs * sl[3]);
            *(u32x2*)(orow + dd) = wv; }
}

__device__ __forceinline__ void sb_unit(LAS unsigned char* lds, const bf16_t* Qp  , const bf16_t* KVp  , bf16_t* Op  , int qb) {
    int tid_ = threadIdx.x; asm volatile("" : "+v"(tid_));
    const int tid = tid_, lane = tid & 63, q = lane & 31, hi = lane >> 5; const int w = __builtin_amdgcn_readfirstlane(tid >> 6);
    const int t0 = qb * 256 + w * 32, tpos = t0 + q;
    const unsigned vbuf = (unsigned)(uintptr_t)lds + (unsigned)w * 16384u;
    bf16x8 qf[4];
#pragma unroll
    for (int d0 = 0; d0 < 4; ++d0) { u32x4 v = *(const u32x4*)(Qp + (size_t)tpos * 64 + 16 * d0 + 8 * hi);
        v.x = cvt_pk_bf16(bf_lo(v.x) * 0.125f, bf_hi(v.x) * 0.125f); v.y = cvt_pk_bf16(bf_lo(v.y) * 0.125f, bf_hi(v.y) * 0.125f);
        v.z = cvt_pk_bf16(bf_lo(v.z) * 0.125f, bf_hi(v.z) * 0.125f); v.w = cvt_pk_bf16(bf_lo(v.w) * 0.125f, bf_hi(v.w) * 0.125f);
        qf[d0] = __builtin_bit_cast(bf16x8, v); }
    const unsigned voffV = (unsigned)((lane >> 3) * 256 + 16 * ((lane & 7) ^ (lane >> 3)));
    const unsigned voffK = (unsigned)(q * 256 + 16 * hi);
    const char* const Pb = (const char*)KVp;
#define SB_DMA_V(kt, buf) do { const char* tb_ = Pb + (size_t)(kt) * (64 * 256) + 128; \
        _Pragma("unroll") for (int I_ = 0; I_ < 8; ++I_) glds_s(tb_ + 2048 * I_, voffV, vbuf + (unsigned)((buf) * 8192 + 1024 * I_)); } while (0)
#define SB_LOAD_K(dst, kt) do { const char* tb_ = Pb + (size_t)(kt) * (64 * 256); \
        _Pragma("unroll") for (int kh_ = 0; kh_ < 2; ++kh_) _Pragma("unroll") for (int d0_ = 0; d0_ < 4; ++d0_) dst[kh_ * 4 + d0_] = *(const u32x4*)(tb_ + voffK + 8192 * kh_ + 32 * d0_); } while (0)
    const int kt_first = t0 >> 6;
    int kt = kt_first, buf = 0;
    u32x4 kf[8], kfn[8];
    SB_LOAD_K(kf, kt); SB_DMA_V(kt, 0);
#pragma unroll
    for (int i = 0; i < 8; ++i) kfn[i] = kf[i];
    f32x16 o[2]; o[0] = (f32x16){}; o[1] = (f32x16){};
    float carry = 0.f;
    const int qq = (lane & 15) >> 2, g1 = (lane >> 4) & 1, pp = lane & 3;
    const unsigned vb = (unsigned)(128 * (4 * hi + qq) + 16 * ((2 * g1 + (pp >> 1)) ^ qq) + 8 * (pp & 1));
    const unsigned vb0 = vb + 64u * (unsigned)hi, vb1 = vb + 64u - 64u * (unsigned)hi;
    for (;;) {
        asm volatile("s_waitcnt vmcnt(0)" ::: "memory");
        if (kt > 0) { SB_LOAD_K(kfn, kt - 1); SB_DMA_V(kt - 1, buf ^ 1); }
        const unsigned vcur = vbuf + (unsigned)(buf * 8192);
#pragma unroll
        for (int kh = 1; kh >= 0; --kh) {
            if (kh == 1 && kt == kt_first && !(t0 & 32)) continue;
            f32x16 s = (f32x16){};
#pragma unroll
            for (int d0 = 0; d0 < 4; ++d0) s = __builtin_amdgcn_mfma_f32_32x32x16_bf16(__builtin_bit_cast(bf16x8, kf[kh * 4 + d0]), qf[d0], s, 0, 0, 0);
            s16x4 vlo[4], vhi[4];
#pragma unroll
            for (int d = 0; d < 2; ++d) { const unsigned a_ = vcur + (d ? vb1 : vb0);
#pragma unroll
                for (int j = 0; j < 2; ++j) { DS_RDTR(vlo[2 * d + j], a_, 4096 * kh + 2048 * j); DS_RDTR(vhi[2 * d + j], a_, 4096 * kh + 2048 * j + 1024); } }
            float sp[16];
#pragma unroll
            for (int r = 0; r < 16; ++r) { const float z = s[r]; const bool valid = (kt * 64 + 32 * kh + crow(r, hi)) < tpos;
                const float a = fabsf(z); const float e = fast_exp2(-a * LOG2E); const float spv = fmaxf(z, 0.f) + fast_log2(1.0f + e) * LN2; sp[r] = valid ? spv : 0.f; }
            float G[4], Gp[4];
#pragma unroll
            for (int i = 0; i < 4; ++i) { G[i] = (sp[4 * i] + sp[4 * i + 1]) + (sp[4 * i + 2] + sp[4 * i + 3]); Gp[i] = __shfl_xor(G[i], 32); }
            float after = 0.f;
#pragma unroll
            for (int i = 3; i >= 0; --i) { float run = carry + after + (hi == 0 ? Gp[i] : 0.f);
#pragma unroll
                for (int j = 3; j >= 0; --j) { const int r = 4 * i + j; run += sp[r]; const bool valid = (kt * 64 + 32 * kh + crow(r, hi)) < tpos;
                    const float wv = fast_exp2((s[r] - run) * LOG2E); s[r] = valid ? wv : 0.f; }
                after += G[i] + Gp[i]; }
            carry += after;
            bf16x8 pk[2];
#pragma unroll
            for (int j = 0; j < 2; ++j) { u32x4 pw; pw.x = cvt_pk_bf16(s[8 * j + 0], s[8 * j + 1]); pw.y = cvt_pk_bf16(s[8 * j + 2], s[8 * j + 3]);
                pw.z = cvt_pk_bf16(s[8 * j + 4], s[8 * j + 5]); pw.w = cvt_pk_bf16(s[8 * j + 6], s[8 * j + 7]);
                pk[j] = __builtin_bit_cast(bf16x8, pw); }
            asm volatile("s_waitcnt lgkmcnt(0)" : "+v"(vlo[0]), "+v"(vlo[1]), "+v"(vlo[2]), "+v"(vlo[3]), "+v"(vhi[0]), "+v"(vhi[1]), "+v"(vhi[2]), "+v"(vhi[3]) :: "memory");
#pragma unroll
            for (int d = 0; d < 2; ++d)
#pragma unroll
                for (int j = 0; j < 2; ++j) { const s16x4 lo = vlo[2 * d + j], hh = vhi[2 * d + j];
                    const bf16x8 vf = (bf16x8){lo[0], lo[1], lo[2], lo[3], hh[0], hh[1], hh[2], hh[3]};
                    o[d] = __builtin_amdgcn_mfma_f32_32x32x16_bf16(vf, pk[j], o[d], 0, 0, 0); }
        }
        if (kt == 0 || __all(carry > 110.0f)) break;
#pragma unroll
        for (int i = 0; i < 8; ++i) kf[i] = kfn[i];
        --kt; buf ^= 1;
    }
    asm volatile("s_waitcnt vmcnt(0)" ::: "memory");
#undef SB_DMA_V
#undef SB_LOAD_K
    bf16_t* orow = Op + (size_t)tpos * 512;
#pragma unroll
    for (int d = 0; d < 2; ++d)
#pragma unroll
        for (int gq = 0; gq < 4; ++gq) { const int dd = 32 * d + 8 * gq + 4 * hi;
            u32x2 wv; wv.x = cvt_pk_bf16(o[d][4 * gq], o[d][4 * gq + 1]); wv.y = cvt_pk_bf16(o[d][4 * gq + 2], o[d][4 * gq + 3]);
            *(u32x2*)(orow + dd) = wv; }
}
}

constexpr int NWAVES = 8, NTHREADS = 512;
constexpr int LDS_BYTES = 143360;
static_assert(att::DA_TOTAL <= LDS_BYTES - 64 && pg8::STAGE_BYTES <= LDS_BYTES - 64, "LDS map");

__device__ __forceinline__ void p0_transpose_item(const float* W, int K, int N, bf16_t* WT, int il  , LAS float* scr, int item, int lane) {
    const int nblk = N / 32, kb = item / nblk, nb = item % nblk, k0 = 64 * kb, n0 = 32 * nb;
    f32x4 v[8];
#pragma unroll
    for (int i = 0; i < 8; ++i) v[i] = *(const f32x4*)(W + (size_t)(k0 + 8 * i + (lane >> 3)) * N + n0 + 4 * (lane & 7));
#pragma unroll
    for (int i = 0; i < 8; ++i) { LAS float* d = scr + (8 * i + (lane >> 3)) * 33 + 4 * (lane & 7); d[0] = v[i][0]; d[1] = v[i][1]; d[2] = v[i][2]; d[3] = v[i][3]; }
    asm volatile("s_waitcnt lgkmcnt(0)" ::: "memory");
    const int c = lane & 7;
    const int rbase = il ? (256 * (n0 / 128) + 128 * (il - 1) + (n0 % 128)) : n0;
#pragma unroll
    for (int j = 0; j < 4; ++j) { const int n = (lane >> 3) + 8 * j; const LAS float* s = scr + (8 * c) * 33 + n;
        u32x4 o; o.x = cvt_pk_bf16(s[0 * 33], s[1 * 33]); o.y = cvt_pk_bf16(s[2 * 33], s[3 * 33]); o.z = cvt_pk_bf16(s[4 * 33], s[5 * 33]); o.w = cvt_pk_bf16(s[6 * 33], s[7 * 33]);
        const int row = rbase + n, pn = row >> 8, h = (row >> 7) & 1, rr = row & 127, x = rr & 31, R = (rr & ~31) + 16 * ((x >> 2) & 1) + 4 * (x >> 3) + (x & 3);
        const size_t blk = ((size_t)pn * (K / 64) + kb) * 2 + h;
        *(u32x4*)((char*)WT + blk * 16384 + pg8::lds_byte(R, 8 * c)) = o; }
    asm volatile("s_waitcnt lgkmcnt(0)" ::: "memory");
}

#ifndef PROBE_MASK
#define PROBE_MASK 0
#endif
#define TSTART() unsigned long long t0_ = (PROBE_MASK != 0) ? __builtin_amdgcn_s_memrealtime() : 0ull
#define TEND(k) do { if (PROBE_MASK & (1 << (k))) { const unsigned long long t1_ = __builtin_amdgcn_s_memrealtime(); const unsigned long long dt_ = t1_ - t0_; while (__builtin_amdgcn_s_memrealtime() - t1_ < dt_) __builtin_amdgcn_s_sleep(8); } if (PROBE_MASK != 0) t0_ = __builtin_amdgcn_s_memrealtime(); } while (0)
struct Args { const float* in[21]; float* out; float* modp; float* SS; bf16_t* Wgu[2]; bf16_t* Wd[2]; bf16_t* Win; bf16_t* Wsb; bf16_t* Wda; bf16_t* Wout; bf16_t* U; bf16_t* Y; bf16_t* BIG; bf16_t* Qsb; bf16_t* KVsb; bf16_t* Qda; bf16_t* KVda; bf16_t* Gt; bf16_t* ya; bf16_t* yd; unsigned* ctr; unsigned* kmax2; unsigned* bar; bf16_t* Mg; bf16_t* Y2; bf16_t* Y3; };

template <bool HAS_Y, bool HAS_NEXT, bool HIN_BF16, bool HOUT_BF16>
__device__ __forceinline__ void rowwise_phase(LAS unsigned char* lds, int vcu, int G, const void* hin_, void* hout_, const bf16_t* Y, const float* SS,
                                              const float* modp, const float* npost, const float* npre, int isub, float rw, bf16_t* U) {
    int tid_ = threadIdx.x; asm volatile("" : "+v"(tid_));
    const int tid = tid_, lane = tid & 63, wave = __builtin_amdgcn_readfirstlane(tid >> 6);
    LAS float* vA = (LAS float*)lds; LAS float* vB = vA + 1024; LAS float* vC = vB + 1024;
    for (int rb = vcu; rb < MT / 256; rb += G) {
        const int b = rb >> 5;
        for (int n = tid; n < DM; n += NTHREADS) {
            if (HAS_Y) { float gsum = 0.f;
#pragma unroll
                for (int kc = 0; kc < 16; ++kc) gsum += modp[(size_t)(kc * 8 + b) * NMOD + (isub * 3 + 2) * DM + n];
                vA[n] = rw * gsum * npost[isub * DM + n]; }
            if (HAS_NEXT) { const int jn = isub + 1; float sc = 0.f, sh = 0.f;
#pragma unroll
                for (int kc = 0; kc < 16; ++kc) { sh += modp[(size_t)(kc * 8 + b) * NMOD + (jn * 3 + 0) * DM + n]; sc += modp[(size_t)(kc * 8 + b) * NMOD + (jn * 3 + 1) * DM + n]; }
                vB[n] = npre[jn * DM + n] * (1.0f + sc); vC[n] = sh; }
        }
        __syncthreads();
        f32x4 a[4], bb[4], cc[4];
#pragma unroll
        for (int j = 0; j < 4; ++j) { const int c0 = 4 * lane + 256 * j;
            a[j] = HAS_Y ? *(const LAS f32x4*)(vA + c0) : (f32x4){0.f, 0.f, 0.f, 0.f};
            bb[j] = HAS_NEXT ? *(const LAS f32x4*)(vB + c0) : (f32x4){0.f, 0.f, 0.f, 0.f};
            cc[j] = HAS_NEXT ? *(const LAS f32x4*)(vC + c0) : (f32x4){0.f, 0.f, 0.f, 0.f}; }
        for (int rr = 0; rr < 32; rr += 2) {
            f32x4 hv[2][4]; u32x2 yv[2][4]; float rsy[2];
#pragma unroll
            for (int u = 0; u < 2; ++u) { const size_t row = (size_t)rb * 256 + wave * 32 + rr + u;
#pragma unroll
                for (int j = 0; j < 4; ++j) {
                    if (HIN_BF16) { const u32x2 t = *(const u32x2*)((const bf16_t*)hin_ + row * DM + 4 * lane + 256 * j); hv[u][j] = (f32x4){bf_lo(t.x), bf_hi(t.x), bf_lo(t.y), bf_hi(t.y)}; }
                    else hv[u][j] = *(const f32x4*)((const float*)hin_ + row * DM + 4 * lane + 256 * j);
                    if (HAS_Y) yv[u][j] = *(const u32x2*)(Y + row * DM + 4 * lane + 256 * j); }
                if (HAS_Y) { const f32x4 s0 = *(const f32x4*)(SS + row * 16), s1 = *(const f32x4*)(SS + row * 16 + 4), s2 = *(const f32x4*)(SS + row * 16 + 8), s3 = *(const f32x4*)(SS + row * 16 + 12);
                    const float ssum = ((s0[0] + s0[1]) + (s0[2] + s0[3])) + ((s1[0] + s1[1]) + (s1[2] + s1[3])) + ((s2[0] + s2[1]) + (s2[2] + s2[3])) + ((s3[0] + s3[1]) + (s3[2] + s3[3]));
                    rsy[u] = 1.0f / sqrtf(ssum * (1.0f / DM) + EPS); } }
            asm volatile("" ::: "memory");
#pragma unroll
            for (int u = 0; u < 2; ++u) { const size_t row = (size_t)rb * 256 + wave * 32 + rr + u;
                if (HAS_Y) {
#pragma unroll
                    for (int j = 0; j < 4; ++j) { hv[u][j][0] += a[j][0] * (bf_lo(yv[u][j].x) * rsy[u]); hv[u][j][1] += a[j][1] * (bf_hi(yv[u][j].x) * rsy[u]);
                        hv[u][j][2] += a[j][2] * (bf_lo(yv[u][j].y) * rsy[u]); hv[u][j][3] += a[j][3] * (bf_hi(yv[u][j].y) * rsy[u]);
                        if (HOUT_BF16) { u32x2 o; o.x = cvt_pk_bf16(hv[u][j][0], hv[u][j][1]); o.y = cvt_pk_bf16(hv[u][j][2], hv[u][j][3]);
                            *(u32x2*)((bf16_t*)hout_ + row * DM + 4 * lane + 256 * j) = o;
                            hv[u][j] = (f32x4){bf_lo(o.x), bf_hi(o.x), bf_lo(o.y), bf_hi(o.y)}; }
                        else *(f32x4*)((float*)hout_ + row * DM + 4 * lane + 256 * j) = hv[u][j]; }
                }
                if (HAS_NEXT) {
                    float s = 0.f;
#pragma unroll
                    for (int j = 0; j < 4; ++j) s += (hv[u][j][0] * hv[u][j][0] + hv[u][j][1] * hv[u][j][1]) + (hv[u][j][2] * hv[u][j][2] + hv[u][j][3] * hv[u][j][3]);
                    const float rs = 1.0f / sqrtf(wave_sum(s) * (1.0f / DM) + EPS);
#pragma unroll
                    for (int j = 0; j < 4; ++j) { u32x2 o; o.x = cvt_pk_bf16(hv[u][j][0] * rs * bb[j][0] + cc[j][0], hv[u][j][1] * rs * bb[j][1] + cc[j][1]);
                        o.y = cvt_pk_bf16(hv[u][j][2] * rs * bb[j][2] + cc[j][2], hv[u][j][3] * rs * bb[j][3] + cc[j][3]);
                        *(u32x2*)(U + row * DM + 4 * lane + 256 * j) = o; }
                }
            }
        }
        __syncthreads();
    }
}

#define XB_TMO      128
#define XB_XCNT(j)  (256  + 64 * (j))
#define XB_XSUB(j)  (1280 + 64 * (j))
#define XB_XGEN(j)  (2304 + 64 * (j))
#define XB_TOP      3328
#define XB_TOPGEN   3392
#define XCD_BAR_WORDS 3456
#define XB_SPIN_CAP (1u << 18)

__device__ __forceinline__ unsigned xb_ld(unsigned* p)              { return __hip_atomic_load(p, __ATOMIC_RELAXED, __HIP_MEMORY_SCOPE_AGENT); }
__device__ __forceinline__ unsigned xb_add(unsigned* p, unsigned v) { return __hip_atomic_fetch_add(p, v, __ATOMIC_RELAXED, __HIP_MEMORY_SCOPE_AGENT); }
__device__ __forceinline__ unsigned xb_xcc_id() { return (unsigned)__builtin_amdgcn_s_getreg((3 << 11) | 20) & 0xFu; }
#define XB_SPIN(cond, bar) do { unsigned _sp = 0; while (cond) { __builtin_amdgcn_s_sleep(1); \
    if ((++_sp & 255u) == 0u) { if (xb_ld(&(bar)[XB_TMO])) break; if (_sp > XB_SPIN_CAP) { atomicAdd(&(bar)[XB_TMO], 1u); break; } } } } while (0)

struct XcdBarrier {
    unsigned* bar; unsigned x;
    volatile LAS unsigned* st;
};

__device__ __forceinline__ XcdBarrier xcd_barrier_post(unsigned* bar, volatile LAS unsigned* st) {
    XcdBarrier b; b.bar = bar; b.x = xb_xcc_id(); b.st = st;
    if (threadIdx.x == 0) (void)xb_add(&bar[XB_XCNT(b.x)], 1u);
    return b;
}
__device__ __forceinline__ void xcd_barrier_complete(unsigned* bar, unsigned x, unsigned& nloc, unsigned& nx) {
    const unsigned G = gridDim.x * gridDim.y * gridDim.z;
    unsigned sum, cnt, mine, sp = 0u;
    for (;;) {
        sum = 0u; cnt = 0u; mine = 0u;
#pragma unroll
        for (unsigned j = 0; j < 16; ++j) { const unsigned c = xb_ld(&bar[XB_XCNT(j)]); sum += c; cnt += (c > 0u) ? 1u : 0u; mine = (j == x) ? c : mine; }
        if (sum == G) break;
        __builtin_amdgcn_s_sleep(1);
        if ((++sp & 255u) == 0u) { if (xb_ld(&bar[XB_TMO])) break; if (sp > XB_SPIN_CAP) { atomicAdd(&bar[XB_TMO], 1u); break; } }
    }
    nloc = mine > 0u ? mine : 1u; nx = cnt > 0u ? cnt : 1u;
}

__device__ __forceinline__ void xcd_barrier(const XcdBarrier& b) {
    asm volatile("s_waitcnt vmcnt(0)" ::: "memory");
    __syncthreads();
    if (threadIdx.x == 0) {
        unsigned* bar = b.bar;
        __builtin_amdgcn_s_waitcnt(0);
        unsigned nloc = b.st[0], nx = b.st[1];
        if (nloc == 0u) { xcd_barrier_complete(bar, b.x, nloc, nx); b.st[0] = nloc; b.st[1] = nx; }
        const unsigned old = xb_add(&bar[XB_XSUB(b.x)], 1u);
        const unsigned gen = old / nloc;
        if (old + 1u == (gen + 1u) * nloc) {
            __builtin_amdgcn_fence(__ATOMIC_RELEASE, "agent");
            asm volatile("s_waitcnt vmcnt(0)" ::: "memory");
            const unsigned og = xb_add(&bar[XB_TOP], 1u);
            const unsigned tg = og / nx;
            if (og + 1u == (tg + 1u) * nx) xb_add(&bar[XB_TOPGEN], 1u);
            else XB_SPIN(xb_ld(&bar[XB_TOPGEN]) == tg, bar);
            __builtin_amdgcn_fence(__ATOMIC_ACQUIRE, "agent");
            xb_add(&bar[XB_XGEN(b.x)], 1u);
            asm volatile("s_waitcnt vmcnt(0)" ::: "memory");
        } else {
            XB_SPIN(xb_ld(&bar[XB_XGEN(b.x)]) == gen, bar);
            __builtin_amdgcn_fence(__ATOMIC_ACQUIRE, "agent");
            asm volatile("s_waitcnt vmcnt(0)" ::: "memory");
        }
    }
    __syncthreads();
}


__global__ void __launch_bounds__(NTHREADS, 2) fwd_megakernel(Args args) {
    extern __shared__ __attribute__((aligned(16))) unsigned char lds_raw[];
    LAS unsigned char* lds = (LAS unsigned char*)lds_raw;
    cg::grid_group grid = cg::this_grid();
    const int tid = threadIdx.x, lane = tid & 63, wave = __builtin_amdgcn_readfirstlane(tid >> 6);
    const int G = gridDim.x, bx = blockIdx.x; const int vcu = (G % 8 == 0) ? (bx % 8) * (G / 8) + bx / 8 : bx;
    TSTART();
    volatile LAS unsigned* xst = (volatile LAS unsigned*)(lds + (LDS_BYTES - 32));
    if (tid < 2) xst[tid] = 0u;
    if (bx == 0) for (int i = tid; i < XCD_BAR_WORDS; i += NTHREADS) __hip_atomic_store(args.bar + i, 0u, __ATOMIC_RELAXED, __HIP_MEMORY_SCOPE_AGENT);
    if (bx == 0 && tid == 0) __hip_atomic_store(args.ctr, 0u, __ATOMIC_RELAXED, __HIP_MEMORY_SCOPE_AGENT);
    if (bx == 0 && tid < 128) __hip_atomic_store(args.kmax2 + tid, 0u, __ATOMIC_RELAXED, __HIP_MEMORY_SCOPE_AGENT);
    {
        LAS float* scr = (LAS float*)(lds + wave * 8448);
        const int gw = vcu * NWAVES + wave, NGW = G * NWAVES;
        constexpr int I_G = (DM / 64) * (DFF / 32), I_D = (DFF / 64) * (DM / 32), I_IN = (DM / 64) * (INW / 32), I_BR = (512 / 64) * (DM / 32), I_O = (DM / 64) * (DM / 32);
        constexpr int NITEMS = 4 * I_G + 2 * I_D + I_IN + 2 * I_BR + I_O;
        for (int it = gw; it < NITEMS; it += NGW) {
            int r = it;
            if (r < I_G) { p0_transpose_item(args.in[6], DM, DFF, args.Wgu[0], 1, scr, r, lane); continue; } r -= I_G;
            if (r < I_G) { p0_transpose_item(args.in[7], DM, DFF, args.Wgu[0], 2, scr, r, lane); continue; } r -= I_G;
            if (r < I_G) { p0_transpose_item(args.in[18], DM, DFF, args.Wgu[1], 1, scr, r, lane); continue; } r -= I_G;
            if (r < I_G) { p0_transpose_item(args.in[19], DM, DFF, args.Wgu[1], 2, scr, r, lane); continue; } r -= I_G;
            if (r < I_D) { p0_transpose_item(args.in[8], DFF, DM, args.Wd[0], 0, scr, r, lane); continue; } r -= I_D;
            if (r < I_D) { p0_transpose_item(args.in[20], DFF, DM, args.Wd[1], 0, scr, r, lane); continue; } r -= I_D;
            if (r < I_IN) { p0_transpose_item(args.in[9], DM, INW, args.Win, 0, scr, r, lane); continue; } r -= I_IN;
            if (r < I_BR) { p0_transpose_item(args.in[15], 512, DM, args.Wsb, 0, scr, r, lane); continue; } r -= I_BR;
            if (r < I_BR) { p0_transpose_item(args.in[16], 512, DM, args.Wda, 0, scr, r, lane); continue; } r -= I_BR;
            p0_transpose_item(args.in[17], DM, DM, args.Wout, 0, scr, r, lane);
        }
        LAS float* sc = (LAS float*)(lds + 69632);
        for (int i = tid; i < NB * DM; i += NTHREADS) { const float cv = args.in[1][i]; sc[i] = cv * sigmoidf_(cv); }
        __syncthreads();
        for (int task = bx * NTHREADS + tid; task < 16 * NMOD; task += G * NTHREADS) {
            const int kc = task / NMOD, n = task % NMOD;
            float acc[8];
#pragma unroll
            for (int b = 0; b < 8; ++b) acc[b] = 0.f;
            for (int k = kc * 64; k < kc * 64 + 64; ++k) { const float wv = args.in[2][(size_t)k * NMOD + n];
#pragma unroll
                for (int b = 0; b < 8; ++b) acc[b] += sc[b * DM + k] * wv; }
            if (kc == 0) { const float bv = args.in[3][n];
#pragma unroll
                for (int b = 0; b < 8; ++b) acc[b] += bv; }
#pragma unroll
            for (int b = 0; b < 8; ++b) args.modp[(size_t)(kc * 8 + b) * NMOD + n] = acc[b];
        }
    }
    TEND(0);
    grid.sync();
    (void)xcd_barrier_post(args.bar, xst);
#define GSYNC() do { XcdBarrier b_; b_.bar = args.bar; b_.x = xb_xcc_id(); b_.st = (volatile LAS unsigned*)(lds + (LDS_BYTES - 32)); xcd_barrier(b_); } while (0)

    TEND(10);
    rowwise_phase<false, true, false, false>(lds, vcu, G, args.in[0], nullptr, nullptr, nullptr, args.modp, args.in[5], args.in[4], -1, 0.f, args.U);
    TEND(1);
    GSYNC();
    TEND(10);

    for (int f = 0; f < 2; ++f) {
        { pg8::Gemm g{args.U, args.Wgu[f], MT, NGU, DM, DM}; pg8::StaticOrder S; S.init(MT, NGU, G, bx); pg8::EpiSwiGLU E{args.BIG}; pg8::gemm_phase(lds, g, S, E); }
        TEND(2);
        GSYNC();
        TEND(10);
        { pg8::Gemm g{args.BIG, args.Wd[f], MT, DM, DFF, DFF}; pg8::StaticOrder S; S.init(MT, DM, G, bx); pg8::EpiY E{f ? args.Y3 : args.Y, args.SS}; pg8::gemm_phase(lds, g, S, E); }
        TEND(3);
        GSYNC();
        TEND(10);
        if (f == 0) {
            rowwise_phase<true, true, false, true>(lds, vcu, G, args.in[0], args.Y, args.Y, args.SS, args.modp, args.in[5], args.in[4], 0, 0.5f, args.U);
            TEND(1);
            GSYNC();
            TEND(10);
            { pg8::Gemm g{args.U, args.Win, MT, INW, DM, DM}; pg8::StaticOrder S; S.init(MT, INW, G, bx); pg8::EpiProj E{args.Qsb, args.KVsb, args.Qda, args.KVda, args.Gt, args.kmax2}; pg8::gemm_phase(lds, g, S, E); }
            TEND(4);
            GSYNC();
            TEND(10);
            {
                float d1 = 0.f, d2 = 0.f;
                for (int i = 0; i < 64; ++i) { d1 += args.in[10][i] * args.in[11][i]; d2 += args.in[12][i] * args.in[13][i]; }
                const float lam = expf(d1) - expf(d2) + LAMBDA_INIT;
                LAS unsigned* slot = (LAS unsigned*)(lds + (LDS_BYTES - 16));
                for (;;) {
                    if (tid == 0) *slot = __hip_atomic_fetch_add(args.ctr, 1u, __ATOMIC_RELAXED, __HIP_MEMORY_SCOPE_AGENT);
                    __syncthreads();
                    const unsigned u = *slot;
                    __syncthreads();
                    if (u >= 3072u) break;
                    if (u < 1024u) { const int hh = 3 - (int)(u >> 8), rem = (int)(u & 255u), qb = 31 - (rem >> 3), bh = (rem & 7) * 4 + hh;
                        const float slope = exp2f(-2.0f * (float)(hh + 1));
                        att::da_unit(lds, args.Qda + (size_t)bh * SEQ * 128, args.KVda + (size_t)bh * SEQ * 256, args.yd + (size_t)(bh >> 2) * SEQ * 512 + 128 * hh, qb, lam, args.in[14], slope, args.kmax2 + bh * 4);
                    } else { const int v = (int)u - 1024, bh = v >> 5, qb = 31 - (v & 31);
                        att::sb_unit(lds, args.Qsb + (size_t)bh * SEQ * 64, args.KVsb + (size_t)bh * SEQ * 128, args.ya + (size_t)(bh >> 3) * SEQ * 512 + 64 * (bh & 7), qb); }
                }
            }
            TEND(5);
            GSYNC();
            TEND(10);
            { pg8::Gemm g{args.ya, args.Wsb, MT, DM, 512, 512}; pg8::StaticOrder S; S.init(MT, DM, G, bx); pg8::EpiGate<true> E{args.Mg, args.Gt, args.Y2}; pg8::gemm_phase(lds, g, S, E); }
            __syncthreads();
            { pg8::Gemm g{args.yd, args.Wda, MT, DM, 512, 512}; pg8::StaticOrder S; S.init(MT, DM, G, bx); pg8::EpiGate<false> E{args.Mg, args.Gt + (size_t)MT * 1024, args.Y2}; pg8::gemm_phase(lds, g, S, E); }
            TEND(6);
            GSYNC();
            TEND(10);
            { pg8::Gemm g{args.Mg, args.Wout, MT, DM, DM, DM}; pg8::StaticOrder S; S.init(MT, DM, G, bx); pg8::EpiY E{args.Y2, args.SS}; pg8::gemm_phase(lds, g, S, E); }
            TEND(7);
            GSYNC();
            TEND(10);
            rowwise_phase<true, true, true, true>(lds, vcu, G, args.Y, args.Y, args.Y2, args.SS, args.modp, args.in[5], args.in[4], 1, 1.0f, args.U);
            TEND(1);
            GSYNC();
            TEND(10);
        } else {
            rowwise_phase<true, false, true, false>(lds, vcu, G, args.Y, args.out, args.Y3, args.SS, args.modp, args.in[5], args.in[4], 2, 0.5f, nullptr);
            TEND(1);
        }
    }
}

extern "C" void kernel_launch(void* const* d_in, const int* in_sizes, int n_in, void* d_out, int out_size, void* d_ws, size_t ws_size, hipStream_t stream) {
    static int grid = 0;
    if (grid == 0) {
        if (n_in != 21 || in_sizes[0] != MT * DM || out_size != MT * DM || ws_size < WS_END) {
            fprintf(stderr, "kernel_launch: unexpected shapes (n_in %d in0 %d out %d ws %zu); nothing launched\n", n_in, n_in > 0 ? in_sizes[0] : -1, out_size, ws_size); grid = -1; return; }
        int dev = 0, cus = 0, per_cu = 0;
        hipGetDevice(&dev);
        hipDeviceGetAttribute(&cus, hipDeviceAttributeMultiprocessorCount, dev);
        if (hipFuncSetAttribute((const void*)fwd_megakernel, hipFuncAttributeMaxDynamicSharedMemorySize, LDS_BYTES) != hipSuccess) fprintf(stderr, "kernel_launch: hipFuncSetAttribute failed\n");
        if (hipOccupancyMaxActiveBlocksPerMultiprocessor(&per_cu, (const void*)fwd_megakernel, NTHREADS, LDS_BYTES) != hipSuccess || per_cu < 1) { fprintf(stderr, "kernel_launch: occupancy query gave %d\n", per_cu); per_cu = 1; }
        (void)hipGetLastError();
        grid = cus * 1;
        if (grid <= 0) grid = 256;
    }
    if (grid < 0) return;
    Args a{};
    for (int i = 0; i < 21; ++i) a.in[i] = (const float*)d_in[i];
    unsigned char* ws = (unsigned char*)d_ws;
    a.out = (float*)d_out; a.modp = (float*)(ws + WS_MODP); a.SS = (float*)(ws + WS_SS);
    a.Wgu[0] = (bf16_t*)(ws + WS_WGU1); a.Wgu[1] = (bf16_t*)(ws + WS_WGU2); a.Wd[0] = (bf16_t*)(ws + WS_WD1); a.Wd[1] = (bf16_t*)(ws + WS_WD2);
    a.Win = (bf16_t*)(ws + WS_WIN); a.Wsb = (bf16_t*)(ws + WS_WSB); a.Wda = (bf16_t*)(ws + WS_WDA); a.Wout = (bf16_t*)(ws + WS_WOUT);
    a.U = (bf16_t*)(ws + WS_U); a.Y = (bf16_t*)(ws + WS_Y); a.BIG = (bf16_t*)(ws + WS_BIG);
    a.Qsb = (bf16_t*)(ws + WS_BIG); a.KVsb = (bf16_t*)(ws + WS_BIG + 64 * MiB); a.Qda = (bf16_t*)(ws + WS_BIG + 192 * MiB); a.KVda = (bf16_t*)(ws + WS_BIG + 256 * MiB); a.Gt = (bf16_t*)(ws + WS_BIG + 384 * MiB);
    a.ctr = (unsigned*)ws; a.kmax2 = (unsigned*)(ws + 4096); a.bar = (unsigned*)(ws + 16384);
    a.ya = (bf16_t*)(ws + WS_U); a.yd = (bf16_t*)(ws + WS_U + 64 * MiB);
    a.Mg = (bf16_t*)(ws + WS_BIG + 256 * MiB); a.Y2 = (bf16_t*)(ws + WS_BIG + 64 * MiB); a.Y3 = (bf16_t*)(ws + WS_BIG + 384 * MiB);
    void* kargs[] = {&a};
    hipError_t e = hipLaunchCooperativeKernel((const void*)fwd_megakernel, dim3(grid), dim3(NTHREADS), kargs, LDS_BYTES, stream);
    if (e != hipSuccess) fprintf(stderr, "cooperative launch failed: %s (grid %d)\n", hipGetErrorString(e), grid);
}
```
